# Optimizing an MI355X kernel written in HIP

```python
import math
import jax, jax.numpy as jnp
from jax import lax
import numpy as np

D_MODEL = 1024
BATCH = 1
SEQ = 16384
DEPTH = 1
DEC_BATCH = 32
DEC_SEQ = 2048
PAST_LEN = 128

MIX_WIDTH = D_MODEL
GLA_HEADS = 4
GLA_DV = MIX_WIDTH // 2 // GLA_HEADS
GLA_DK = GLA_DV // 2
GLA_QK = GLA_HEADS * GLA_DK
GLA_V = GLA_HEADS * GLA_DV
GLA_GATE_RANK = 16
GLA_GATE_NORMALIZER = 16.0
GLA_CHUNK = 64
DIFF_HEADS = 4
DIFF_DH = MIX_WIDTH // 2 // DIFF_HEADS // 2
DIFF_QK = DIFF_HEADS * 2 * DIFF_DH
DIFF_V = DIFF_HEADS * 2 * DIFF_DH
ROT_DIM = DIFF_DH // 4
ROPE_THETA = 500000.0
Q_BLOCK = 128
MEM_LEN = 256
XATTN_HEADS = 4
XATTN_DH = D_MODEL // XATTN_HEADS
D_FF = ((8 * D_MODEL + 3 * 256 - 1) // (3 * 256)) * 256
RMS_EPS = 1e-6
IN_SPLIT_SIZES = (GLA_QK, GLA_QK, GLA_V, GLA_GATE_RANK, GLA_GATE_RANK, GLA_V, DIFF_QK, DIFF_QK, DIFF_V)
IN_COLS = GLA_QK * 2 + GLA_V * 2 + GLA_GATE_RANK * 2 + DIFF_QK * 2 + DIFF_V

kernel_name = "hybrid_gla_diffattn_encoder"


def rmsnorm(x, w):
    xf = x.astype(jnp.float32)
    y = xf * lax.rsqrt(jnp.mean(xf * xf, axis=-1, keepdims=True) + RMS_EPS)
    return (y * w.astype(jnp.float32)).astype(x.dtype)


def rope_partial(t, pos):
    inv = ROPE_THETA ** (-jnp.arange(0, ROT_DIM, 2, dtype=jnp.float32) / ROT_DIM)
    ang = pos.astype(jnp.float32)[:, None] * inv[None, :]
    cos = jnp.cos(ang)[:, None, None, :]
    sin = jnp.sin(ang)[:, None, None, :]
    tf = t.astype(jnp.float32)
    half = ROT_DIM // 2
    x1 = tf[..., :half]
    x2 = tf[..., half:ROT_DIM]
    rest = tf[..., ROT_DIM:]
    return jnp.concatenate([x1 * cos - x2 * sin, x2 * cos + x1 * sin, rest], axis=-1).astype(t.dtype)


def gla_chunk_scan(q, k, v, g):
    B, S, H, dk = q.shape
    dv = v.shape[-1]
    C = GLA_CHUNK
    N = S // C

    def to_chunks(t):
        return t.reshape(B, N, C, H, t.shape[-1]).transpose(0, 3, 1, 2, 4)

    q, k, v, g = to_chunks(q), to_chunks(k), to_chunks(v), to_chunks(g)
    b = jnp.cumsum(g, axis=3)
    b_last = b[:, :, :, -1:, :]
    q_e = q * jnp.exp(b)
    k_e = k * jnp.exp(-b)
    k_d = k * jnp.exp(b_last - b)
    mask = jnp.tril(jnp.ones((C, C), dtype=bool))
    A = jnp.where(mask, jnp.einsum('bhnid,bhnjd->bhnij', q_e, k_e), 0.0)
    o_intra = jnp.einsum('bhnij,bhnjv->bhniv', A, v)
    U = jnp.einsum('bhncd,bhncv->bhndv', k_d, v)
    decay = jnp.exp(b_last[:, :, :, 0, :])

    def step(state, inp):
        dec, u = inp
        return dec[..., None] * state + u, state

    _, s_prev = lax.scan(step, jnp.zeros((B, H, dk, dv), jnp.float32),
                         (decay.transpose(2, 0, 1, 3), U.transpose(2, 0, 1, 3, 4)))
    s_prev = s_prev.transpose(1, 2, 0, 3, 4)
    o_inter = jnp.einsum('bhncd,bhndv->bhncv', q_e, s_prev)
    return (o_intra + o_inter).transpose(0, 2, 3, 1, 4).reshape(B, S, H, dv)


def gla_mixer(q, k, v, gf, gb, og, w_gate_up_f, b_gate_f, w_gate_up_b, b_gate_b, gla_norm_w):
    B, S, _ = q.shape
    dt = q.dtype
    f32 = jnp.float32
    q = q.astype(f32).reshape(B, S, GLA_HEADS, GLA_DK) * (GLA_DK ** -0.5)
    k = k.astype(f32).reshape(B, S, GLA_HEADS, GLA_DK)
    v = v.astype(f32).reshape(B, S, GLA_HEADS, GLA_DV)
    g_f = jax.nn.log_sigmoid(gf.astype(f32) @ w_gate_up_f.astype(f32) + b_gate_f.astype(f32)) / GLA_GATE_NORMALIZER
    g_b = jax.nn.log_sigmoid(gb.astype(f32) @ w_gate_up_b.astype(f32) + b_gate_b.astype(f32)) / GLA_GATE_NORMALIZER
    g_f = g_f.reshape(B, S, GLA_HEADS, GLA_DK)
    g_b = g_b.reshape(B, S, GLA_HEADS, GLA_DK)
    o_f = gla_chunk_scan(q, k, v, g_f)
    flip = lambda t: jnp.flip(t, axis=1)
    o_b = flip(gla_chunk_scan(flip(q), flip(k), flip(v), flip(g_b)))
    o = rmsnorm(o_f + o_b, gla_norm_w)
    o = o * jax.nn.silu(og.astype(f32).reshape(B, S, GLA_HEADS, GLA_DV))
    return o.reshape(B, S, GLA_V).astype(dt)


def diff_attention(q, k, v, lam, lam_init, subln_w, pos):
    B, S, _ = q.shape
    q = rope_partial(q.reshape(B, S, DIFF_HEADS, 2, DIFF_DH), pos) * (DIFF_DH ** -0.5)
    k = rope_partial(k.reshape(B, S, DIFF_HEADS, 2, DIFF_DH), pos)
    v = v.reshape(B, S, DIFF_HEADS, 2 * DIFF_DH)
    nb = S // Q_BLOCK
    qb = q.reshape(B, nb, Q_BLOCK, DIFF_HEADS, 2, DIFF_DH).transpose(1, 0, 2, 3, 4, 5)

    def block(qi):
        s = jnp.einsum('bqhcd,bkhcd->bhcqk', qi, k).astype(jnp.float32)
        p = jax.nn.softmax(s, axis=-1)
        p = p[:, :, 0] - lam * p[:, :, 1]
        return jnp.einsum('bhqk,bkhe->bqhe', p.astype(v.dtype), v)

    o = lax.map(block, qb)
    o = o.transpose(1, 0, 2, 3, 4).reshape(B, S, DIFF_HEADS, 2 * DIFF_DH)
    o = rmsnorm(o, subln_w) * (1.0 - lam_init)
    return o.reshape(B, S, DIFF_V)


def memory_cross_attention(h, m, w_xq, w_xkv, w_xo):
    B, S, _ = h.shape
    M = m.shape[1]
    q = (h @ w_xq).reshape(B, S, XATTN_HEADS, XATTN_DH)
    kv = m @ w_xkv
    k = kv[..., :D_MODEL].reshape(B, M, XATTN_HEADS, XATTN_DH)
    v = kv[..., D_MODEL:].reshape(B, M, XATTN_HEADS, XATTN_DH)
    s = jnp.einsum('bshd,bmhd->bhsm', q, k).astype(jnp.float32) * (XATTN_DH ** -0.5)
    p = jax.nn.softmax(s, axis=-1)
    o = jnp.einsum('bhsm,bmhd->bshd', p.astype(v.dtype), v).reshape(B, S, D_MODEL)
    return o @ w_xo


def swiglu(h, w_gate, w_up, w_down):
    return (jax.nn.silu(h @ w_gate) * (h @ w_up)) @ w_down


def encoder_layer(x, mem, p, lam_init):
    B, S, _ = x.shape
    pos = jnp.arange(S)
    h = rmsnorm(x, p['norm_mix_pre'])
    proj = h @ p['w_in']
    idx = []
    acc = 0
    for sz in IN_SPLIT_SIZES[:-1]:
        acc += sz
        idx.append(acc)
    gq, gk, gv, gf, gb, og, dq, dk, dv = jnp.split(proj, idx, axis=-1)
    o_gla = gla_mixer(gq, gk, gv, gf, gb, og, p['w_gate_up_f'], p['b_gate_f'],
                      p['w_gate_up_b'], p['b_gate_b'], p['gla_norm_w'])
    f32 = jnp.float32
    lam = (jnp.exp(jnp.sum(p['lambda_q1'].astype(f32) * p['lambda_k1'].astype(f32)))
           - jnp.exp(jnp.sum(p['lambda_q2'].astype(f32) * p['lambda_k2'].astype(f32))) + lam_init)
    o_diff = diff_attention(dq, dk, dv, lam, lam_init, p['diff_subln_w'], pos)
    mix = jnp.concatenate([o_gla, o_diff], axis=-1) @ p['w_out']
    x = x + rmsnorm(mix, p['norm_mix_post'])
    h = rmsnorm(x, p['norm_xattn_pre'])
    m = rmsnorm(mem, p['norm_mem'])
    x = x + rmsnorm(memory_cross_attention(h, m, p['w_xq'], p['w_xkv'], p['w_xo']), p['norm_xattn_post'])
    h = rmsnorm(x, p['norm_ffn_pre'])
    x = x + rmsnorm(swiglu(h, p['w_ffn_gate'], p['w_ffn_up'], p['w_ffn_down']), p['norm_ffn_post'])
    return x


def setup_inputs(seed: int = 0) -> dict:
    key = jax.random.key(seed)
    keys = jax.random.split(key, 40)
    it = iter(range(40))
    L = DEPTH

    def nrm(shape, scale):
        return scale * jax.random.normal(keys[next(it)], shape, jnp.float32)

    def gain(shape):
        return 1.0 + 0.02 * jax.random.normal(keys[next(it)], shape, jnp.float32)

    return {
        "x_prompt": nrm((BATCH, SEQ, D_MODEL), 1.0),
        "x_sample": nrm((DEC_BATCH, DEC_SEQ, D_MODEL), 1.0),
        "mem_prompt": nrm((BATCH, MEM_LEN, D_MODEL), 1.0),
        "mem_sample": nrm((DEC_BATCH, MEM_LEN, D_MODEL), 1.0),
        "norm_mix_pre": gain((L, D_MODEL)),
        "w_in": nrm((L, D_MODEL, IN_COLS), D_MODEL ** -0.5),
        "w_gate_up_f": nrm((L, GLA_GATE_RANK, GLA_QK), GLA_GATE_RANK ** -0.5),
        "b_gate_f": nrm((L, GLA_QK), 0.1),
        "w_gate_up_b": nrm((L, GLA_GATE_RANK, GLA_QK), GLA_GATE_RANK ** -0.5),
        "b_gate_b": nrm((L, GLA_QK), 0.1),
        "gla_norm_w": gain((L, GLA_DV)),
        "lambda_q1": nrm((L, DIFF_DH), 0.1),
        "lambda_k1": nrm((L, DIFF_DH), 0.1),
        "lambda_q2": nrm((L, DIFF_DH), 0.1),
        "lambda_k2": nrm((L, DIFF_DH), 0.1),
        "diff_subln_w": gain((L, 2 * DIFF_DH)),
        "w_out": nrm((L, MIX_WIDTH, D_MODEL), MIX_WIDTH ** -0.5),
        "norm_mix_post": gain((L, D_MODEL)),
        "norm_xattn_pre": gain((L, D_MODEL)),
        "norm_mem": gain((L, D_MODEL)),
        "w_xq": nrm((L, D_MODEL, D_MODEL), D_MODEL ** -0.5),
        "w_xkv": nrm((L, D_MODEL, 2 * D_MODEL), D_MODEL ** -0.5),
        "w_xo": nrm((L, D_MODEL, D_MODEL), D_MODEL ** -0.5),
        "norm_xattn_post": gain((L, D_MODEL)),
        "norm_ffn_pre": gain((L, D_MODEL)),
        "w_ffn_gate": nrm((L, D_MODEL, D_FF), D_MODEL ** -0.5),
        "w_ffn_up": nrm((L, D_MODEL, D_FF), D_MODEL ** -0.5),
        "w_ffn_down": nrm((L, D_FF, D_MODEL), D_FF ** -0.5),
        "norm_ffn_post": gain((L, D_MODEL)),
    }


def reference(x_prompt, x_sample, mem_prompt, mem_sample, norm_mix_pre, w_in, w_gate_up_f, b_gate_f,
              w_gate_up_b, b_gate_b, gla_norm_w, lambda_q1, lambda_k1, lambda_q2, lambda_k2, diff_subln_w,
              w_out, norm_mix_post, norm_xattn_pre, norm_mem, w_xq, w_xkv, w_xo, norm_xattn_post,
              norm_ffn_pre, w_ffn_gate, w_ffn_up, w_ffn_down, norm_ffn_post):
    y_prompt = x_prompt
    y_sample = x_sample
    for l in range(DEPTH):
        lam_init = 0.8 - 0.6 * math.exp(-0.3 * l)
        p = {
            'norm_mix_pre': norm_mix_pre[l], 'w_in': w_in[l],
            'w_gate_up_f': w_gate_up_f[l], 'b_gate_f': b_gate_f[l],
            'w_gate_up_b': w_gate_up_b[l], 'b_gate_b': b_gate_b[l],
            'gla_norm_w': gla_norm_w[l],
            'lambda_q1': lambda_q1[l], 'lambda_k1': lambda_k1[l],
            'lambda_q2': lambda_q2[l], 'lambda_k2': lambda_k2[l],
            'diff_subln_w': diff_subln_w[l], 'w_out': w_out[l], 'norm_mix_post': norm_mix_post[l],
            'norm_xattn_pre': norm_xattn_pre[l], 'norm_mem': norm_mem[l],
            'w_xq': w_xq[l], 'w_xkv': w_xkv[l], 'w_xo': w_xo[l], 'norm_xattn_post': norm_xattn_post[l],
            'norm_ffn_pre': norm_ffn_pre[l], 'w_ffn_gate': w_ffn_gate[l], 'w_ffn_up': w_ffn_up[l],
            'w_ffn_down': w_ffn_down[l], 'norm_ffn_post': norm_ffn_post[l],
        }
        y_prompt = encoder_layer(y_prompt, mem_prompt, p, lam_init)
        y_sample = encoder_layer(y_sample, mem_sample, p, lam_init)
    return (y_prompt, y_sample)
```

```cpp
#include <hip/hip_runtime.h>
#include <hip/hip_cooperative_groups.h>
#include <stdint.h>
#include <cstdio>
namespace cg = cooperative_groups;

#ifndef MEGA
#define MEGA 1
#endif
#ifndef PHSEL
#define PHSEL -1
#endif
#ifndef REPMASK
#define REPMASK 0
#endif
#ifndef REPG3
#define REPG3 1
#endif
#ifndef REPG1
#define REPG1 1
#endif
#ifndef XSYNC
#define XSYNC 0
#endif
#ifndef REPCMB
#define REPCMB 1
#endif

typedef unsigned short bf16_t;
using bf16x8 = __attribute__((ext_vector_type(8))) short;
using bf16x4 = __attribute__((ext_vector_type(4))) short;
using f32x4 = __attribute__((ext_vector_type(4))) float;
using u4 = __attribute__((ext_vector_type(4))) unsigned;
using u2 = __attribute__((ext_vector_type(2))) unsigned;
using f4 = __attribute__((ext_vector_type(4))) float;
using f32x16 = __attribute__((ext_vector_type(16))) float;
typedef __attribute__((ext_vector_type(2))) __bf16 bf2_t;
#define DI __device__ __forceinline__
#define VT ((int)(threadIdx.x & 255))
#define VB ((int)(blockIdx.x * 2 + (threadIdx.x >> 8)))
#define VN ((int)(gridDim.x * 2))

DI unsigned pk2(float a, float b) { bf2_t v; v[0] = (__bf16)a; v[1] = (__bf16)b; return __builtin_bit_cast(unsigned, v); }
DI bf16_t f2b(float a) { return __builtin_bit_cast(unsigned short, (__bf16)a); }
DI float b2f(unsigned b) { return __uint_as_float(b << 16); }
DI float blo(unsigned u) { return __uint_as_float(u << 16); }
DI float bhi(unsigned u) { return __uint_as_float(u & 0xffff0000u); }
DI float half_swap_max(float x) {
  auto rr = __builtin_amdgcn_permlane32_swap(__float_as_uint(x), __float_as_uint(x), false, false);
  return fmaxf(__uint_as_float(rr[0]), __uint_as_float(rr[1]));
}
DI float half_swap_sum(float x) {
  auto rr = __builtin_amdgcn_permlane32_swap(__float_as_uint(x), __float_as_uint(x), false, false);
  return __uint_as_float(rr[0]) + __uint_as_float(rr[1]);
}
DI float wave_sum(float v) {
#pragma unroll
  for (int o = 32; o > 0; o >>= 1) v += __shfl_xor(v, o);
  return v;
}

constexpr int T = 81920, TP = 16384, SS = 2048, D = 1024, MT = 8448, DFF = 2816;
constexpr int NCHUNK = T / 64;
constexpr int NIN = 3328;
constexpr float EPS = 1e-6f;
constexpr float LOG2E = 1.4426950408889634f;

constexpr size_t OFF_WIN = 0;
constexpr size_t OFF_WOUT = OFF_WIN + (size_t)NIN * 1024 * 2;
constexpr size_t OFF_WXQ = OFF_WOUT + 1024 * 1024 * 2;
constexpr size_t OFF_WXO = OFF_WXQ + 1024 * 1024 * 2;
constexpr size_t OFF_WXKV = OFF_WXO + 1024 * 1024 * 2;
constexpr size_t OFF_WGU = OFF_WXKV + 2048 * 1024 * 2;
constexpr size_t OFF_WDN = OFF_WGU + (size_t)5632 * 1024 * 2;
constexpr size_t OFF_HBUF = OFF_WDN + (size_t)1024 * 2816 * 2;
constexpr size_t OFF_GQ = OFF_HBUF + (size_t)T * 1024 * 2;
constexpr size_t OFF_GK = OFF_GQ + (size_t)T * 256 * 2;
constexpr size_t OFF_GV = OFF_GK + (size_t)T * 256 * 2;
constexpr size_t OFF_OG = OFF_GV + (size_t)T * 512 * 2;
constexpr size_t OFF_DQ = OFF_OG + (size_t)T * 512 * 2;
constexpr size_t OFF_DK = OFF_DQ + (size_t)T * 512 * 2;
constexpr size_t OFF_DVT = OFF_DK + (size_t)T * 512 * 2;
constexpr size_t OFF_GATES = OFF_DVT + (size_t)T * 512 * 2;
constexpr size_t OFF_UBUF = OFF_GATES + (size_t)T * 32 * 4;
constexpr size_t OFF_DEC = OFF_UBUF + (size_t)NCHUNK * 4 * 2 * 8192 * 2;
constexpr size_t OFF_MBUF = OFF_DEC + (size_t)NCHUNK * 4 * 2 * 64 * 4;
constexpr size_t OFF_KX = OFF_MBUF + (size_t)MT * 1024 * 2;
constexpr size_t OFF_VXT = OFF_KX + (size_t)MT * 1024 * 2;
constexpr size_t OFF_BAR = OFF_VXT + (size_t)MT * 1024 * 2;
constexpr size_t WS_END = OFF_BAR + 16384;
constexpr size_t OUT_QEF = 0;
constexpr size_t OUT_KEF = OUT_QEF + (size_t)T * 256 * 2;
constexpr size_t OUT_QEB = OUT_KEF + (size_t)T * 256 * 2;
constexpr size_t OUT_KEB = OUT_QEB + (size_t)T * 256 * 2;
constexpr size_t OFF_ODIFF = OFF_HBUF;
constexpr size_t OFF_MIXIN = OFF_DQ;
constexpr size_t OFF_MIX = OFF_UBUF;
constexpr size_t OFF_QX = OFF_MIXIN;
constexpr size_t OFF_XOIN = OFF_GQ;
constexpr size_t OFF_ACT = OFF_GQ;

struct P {
  const float *xp, *xs, *memp, *mems;
  const float *norm_mix_pre, *w_in, *w_gu_f, *b_g_f, *w_gu_b, *b_g_b, *gla_norm_w;
  const float *lq1, *lk1, *lq2, *lk2, *subln_w, *w_out, *norm_mix_post, *norm_x_pre, *norm_mem;
  const float *w_xq, *w_xkv, *w_xo, *norm_x_post, *norm_f_pre, *w_fg, *w_fu, *w_fd, *norm_f_post;
  float* out;
  char* ws;
};

DI int seq_start(int s) { return s == 0 ? 0 : TP + (s - 1) * SS; }
DI int seq_of_token(int t) { return t < TP ? 0 : 1 + (t - TP) / SS; }

DI void row_norm_bf16(const float* __restrict__ x, const float* __restrict__ w, bf16_t* __restrict__ out, int lane) {
  f4 v[4];
  float ss = 0.f;
#pragma unroll
  for (int i = 0; i < 4; ++i) {
    v[i] = ((const f4*)x)[i * 64 + lane];
    ss += v[i].x * v[i].x + v[i].y * v[i].y + v[i].z * v[i].z + v[i].w * v[i].w;
  }
  ss = wave_sum(ss);
  float rs = rsqrtf(ss * (1.f / 1024.f) + EPS);
#pragma unroll
  for (int i = 0; i < 4; ++i) {
    f4 ww = ((const f4*)w)[i * 64 + lane];
    u2 pk;
    pk.x = pk2(v[i].x * rs * ww.x, v[i].y * rs * ww.y);
    pk.y = pk2(v[i].z * rs * ww.z, v[i].w * rs * ww.w);
    ((u2*)out)[i * 64 + lane] = pk;
  }
}

template <bool XIN_F32, bool LAST>
DI void row_resid(const void* xin, const bf16_t* __restrict__ mix, const float* __restrict__ wpost,
                  const float* __restrict__ wnext, void* xout, bf16_t* __restrict__ hout, int lane) {
  f4 x[4], m[4];
  float ss = 0.f;
#pragma unroll
  for (int i = 0; i < 4; ++i) {
    if (XIN_F32) x[i] = ((const f4*)xin)[i * 64 + lane];
    else { u2 xu = ((const u2*)xin)[i * 64 + lane]; x[i].x = blo(xu.x); x[i].y = bhi(xu.x); x[i].z = blo(xu.y); x[i].w = bhi(xu.y); }
    u2 u = ((const u2*)mix)[i * 64 + lane];
    m[i].x = blo(u.x); m[i].y = bhi(u.x); m[i].z = blo(u.y); m[i].w = bhi(u.y);
    ss += m[i].x * m[i].x + m[i].y * m[i].y + m[i].z * m[i].z + m[i].w * m[i].w;
  }
  ss = wave_sum(ss);
  float rs = rsqrtf(ss * (1.f / 1024.f) + EPS);
  float ss1 = 0.f;
#pragma unroll
  for (int i = 0; i < 4; ++i) {
    f4 ww = ((const f4*)wpost)[i * 64 + lane];
    x[i].x += m[i].x * rs * ww.x; x[i].y += m[i].y * rs * ww.y;
    x[i].z += m[i].z * rs * ww.z; x[i].w += m[i].w * rs * ww.w;
    ss1 += x[i].x * x[i].x + x[i].y * x[i].y + x[i].z * x[i].z + x[i].w * x[i].w;
  }
  if (LAST) {
#pragma unroll
    for (int i = 0; i < 4; ++i) ((f4*)xout)[i * 64 + lane] = x[i];
  } else {
#pragma unroll
    for (int i = 0; i < 4; ++i) {
      u2 pk; pk.x = pk2(x[i].x, x[i].y); pk.y = pk2(x[i].z, x[i].w);
      ((u2*)xout)[i * 64 + lane] = pk;
    }
    ss1 = wave_sum(ss1);
    float rs1 = rsqrtf(ss1 * (1.f / 1024.f) + EPS);
#pragma unroll
    for (int i = 0; i < 4; ++i) {
      f4 ww = ((const f4*)wnext)[i * 64 + lane];
      u2 pk;
      pk.x = pk2(x[i].x * rs1 * ww.x, x[i].y * rs1 * ww.y);
      pk.y = pk2(x[i].z * rs1 * ww.z, x[i].w * rs1 * ww.w);
      ((u2*)hout)[i * 64 + lane] = pk;
    }
  }
}

constexpr int NR = 4;
DI void row_norm_bf16_xn(const float* __restrict__ x, const float* __restrict__ w, bf16_t* __restrict__ out, int lane) {
  f4 v[NR][4];
#pragma unroll
  for (int q = 0; q < NR; ++q)
#pragma unroll
    for (int i = 0; i < 4; ++i) v[q][i] = ((const f4*)(x + q * 1024))[i * 64 + lane];
  __builtin_amdgcn_sched_barrier(0);
#pragma unroll
  for (int q = 0; q < NR; ++q) {
    float ss = 0.f;
#pragma unroll
    for (int i = 0; i < 4; ++i) ss += v[q][i].x * v[q][i].x + v[q][i].y * v[q][i].y + v[q][i].z * v[q][i].z + v[q][i].w * v[q][i].w;
    ss = wave_sum(ss);
    float rs = rsqrtf(ss * (1.f / 1024.f) + EPS);
#pragma unroll
    for (int i = 0; i < 4; ++i) {
      f4 ww = ((const f4*)w)[i * 64 + lane];
      u2 pk;
      pk.x = pk2(v[q][i].x * rs * ww.x, v[q][i].y * rs * ww.y);
      pk.y = pk2(v[q][i].z * rs * ww.z, v[q][i].w * rs * ww.w);
      ((u2*)(out + q * 1024))[i * 64 + lane] = pk;
    }
  }
}

template <bool XIN_F32, bool LAST>
DI void row_resid_xn(const char* xin, int xin_stride, const bf16_t* __restrict__ mix, const float* __restrict__ wpost,
                     const float* __restrict__ wnext, char* xout, int xout_stride, bf16_t* __restrict__ hout, int lane) {
  f4 x[NR][4]; u2 mu[NR][4];
#pragma unroll
  for (int q = 0; q < NR; ++q) {
#pragma unroll
    for (int i = 0; i < 4; ++i) {
      if (XIN_F32) x[q][i] = ((const f4*)(xin + (long)q * xin_stride))[i * 64 + lane];
      else { u2 xu = ((const u2*)(xin + (long)q * xin_stride))[i * 64 + lane]; x[q][i].x = blo(xu.x); x[q][i].y = bhi(xu.x); x[q][i].z = blo(xu.y); x[q][i].w = bhi(xu.y); }
      mu[q][i] = ((const u2*)(mix + q * 1024))[i * 64 + lane];
    }
  }
  __builtin_amdgcn_sched_barrier(0);
#pragma unroll
  for (int q = 0; q < NR; ++q) {
    f4 m[4];
    float ss = 0.f;
#pragma unroll
    for (int i = 0; i < 4; ++i) {
      m[i].x = blo(mu[q][i].x); m[i].y = bhi(mu[q][i].x); m[i].z = blo(mu[q][i].y); m[i].w = bhi(mu[q][i].y);
      ss += m[i].x * m[i].x + m[i].y * m[i].y + m[i].z * m[i].z + m[i].w * m[i].w;
    }
    ss = wave_sum(ss);
    float rs = rsqrtf(ss * (1.f / 1024.f) + EPS);
    float ss1 = 0.f;
#pragma unroll
    for (int i = 0; i < 4; ++i) {
      f4 ww = ((const f4*)wpost)[i * 64 + lane];
      x[q][i].x += m[i].x * rs * ww.x; x[q][i].y += m[i].y * rs * ww.y;
      x[q][i].z += m[i].z * rs * ww.z; x[q][i].w += m[i].w * rs * ww.w;
      ss1 += x[q][i].x * x[q][i].x + x[q][i].y * x[q][i].y + x[q][i].z * x[q][i].z + x[q][i].w * x[q][i].w;
    }
    if (LAST) {
#pragma unroll
      for (int i = 0; i < 4; ++i) ((f4*)(xout + (long)q * xout_stride))[i * 64 + lane] = x[q][i];
    } else {
#pragma unroll
      for (int i = 0; i < 4; ++i) {
        u2 pk; pk.x = pk2(x[q][i].x, x[q][i].y); pk.y = pk2(x[q][i].z, x[q][i].w);
        ((u2*)(xout + (long)q * xout_stride))[i * 64 + lane] = pk;
      }
      ss1 = wave_sum(ss1);
      float rs1 = rsqrtf(ss1 * (1.f / 1024.f) + EPS);
#pragma unroll
      for (int i = 0; i < 4; ++i) {
        f4 ww = ((const f4*)wnext)[i * 64 + lane];
        u2 pk;
        pk.x = pk2(x[q][i].x * rs1 * ww.x, x[q][i].y * rs1 * ww.y);
        pk.y = pk2(x[q][i].z * rs1 * ww.z, x[q][i].w * rs1 * ww.w);
        ((u2*)(hout + q * 1024))[i * 64 + lane] = pk;
      }
    }
  }
}

template <class F>
DI void wt_conv(bf16_t* __restrict__ dst, int K, int N, int tile0, int& tile_base, char* smem, F src4) {
  float* tl = (float*)smem;
  const int tid = VT;
  const int ntn = N >> 6, ntk = K >> 6, nt = ntn * ntk;
  int first = (tile0 & ~1) - tile_base;
  const int stride = VN;
  if (first < 0) first += ((-first + stride - 1) / stride) * stride;
  for (int te = first; te < nt; te += stride) {
    const int t = te + (tile0 & 1);
    const bool live = t < nt;
    const int tn = live ? t % ntn : 0, tk = live ? t / ntn : 0;
    const int n0 = tn * 64, k0 = tk * 64;
    __syncthreads();
    if (live) {
      const int kk = tid >> 4, n4 = (tid & 15) * 4;
#pragma unroll
      for (int it = 0; it < 4; ++it) {
        const int k = kk + 16 * it;
        const float* sp = src4(k0 + k, n0 + n4);
        f4 v = sp ? *(const f4*)sp : f4{0.f, 0.f, 0.f, 0.f};
        tl[k * 65 + n4 + 0] = v.x; tl[k * 65 + n4 + 1] = v.y; tl[k * 65 + n4 + 2] = v.z; tl[k * 65 + n4 + 3] = v.w;
      }
    }
    __syncthreads();
    if (live) {
      const int n = tid >> 2, kq = (tid & 3) * 16;
      unsigned pk[8];
#pragma unroll
      for (int j = 0; j < 8; ++j) pk[j] = pk2(tl[(kq + 2 * j) * 65 + n], tl[(kq + 2 * j + 1) * 65 + n]);
      bf16_t* d = dst + (long)(n0 + n) * K + k0 + kq;
      *(u4*)d = u4{pk[0], pk[1], pk[2], pk[3]};
      *(u4*)(d + 8) = u4{pk[4], pk[5], pk[6], pk[7]};
    }
  }
  tile_base += nt;
}

DI void phase_prep(const P& p, char* smem) {
  char* ws = p.ws;
  int tb = 0;
  const int vb = VB;
  {
    const float* w = p.w_in;
    wt_conv((bf16_t*)(ws + OFF_WIN), 1024, NIN, vb, tb, smem, [=](int k, int n) -> const float* {
      int sc = n < 1024 ? n : (n < 3072 ? n + 32 : (n < 3104 ? n - 3072 + 1024 : -1));
      return sc < 0 ? nullptr : w + (long)k * 3104 + sc;
    });
  }
  { const float* w = p.w_out; wt_conv((bf16_t*)(ws + OFF_WOUT), 1024, 1024, vb, tb, smem, [=](int k, int n) -> const float* { return w + (long)k * 1024 + n; }); }
  { const float* w = p.w_xq;  wt_conv((bf16_t*)(ws + OFF_WXQ), 1024, 1024, vb, tb, smem, [=](int k, int n) -> const float* { return w + (long)k * 1024 + n; }); }
  { const float* w = p.w_xo;  wt_conv((bf16_t*)(ws + OFF_WXO), 1024, 1024, vb, tb, smem, [=](int k, int n) -> const float* { return w + (long)k * 1024 + n; }); }
  { const float* w = p.w_xkv; wt_conv((bf16_t*)(ws + OFF_WXKV), 1024, 2048, vb, tb, smem, [=](int k, int n) -> const float* { return w + (long)k * 2048 + n; }); }
  {
    const float* wg = p.w_fg; const float* wu = p.w_fu;
    wt_conv((bf16_t*)(ws + OFF_WGU), 1024, 5632, vb, tb, smem, [=](int k, int n) -> const float* {
      int pr = n >> 5, which = (n >> 4) & 1, j = n & 15;
      int sc = pr * 16 + j;
      return (which ? wu : wg) + (long)k * DFF + sc;
    });
  }
  { const float* w = p.w_fd; wt_conv((bf16_t*)(ws + OFF_WDN), DFF, 1024, vb, tb, smem, [=](int k, int n) -> const float* { return w + (long)k * 1024 + n; }); }
  const long gtid = (long)VB * 256 + VT;
  (void)gtid;
  const int lane = VT & 63;
  const int gw = VB * 4 + (VT >> 6);
  const int nw = VN * 4;
  for (int rg = gw; rg < MT / NR; rg += nw) {
    const int r = rg * NR;
    const float* src = r < 256 ? p.memp + (long)r * 1024 : p.mems + (long)(r - 256) * 1024;
    row_norm_bf16_xn(src, p.norm_mem, (bf16_t*)(ws + OFF_MBUF) + (long)r * 1024, lane);
  }
  for (int rg = gw; rg < T / NR; rg += nw) {
    const int r = rg * NR;
    const float* src = r < TP ? p.xp + (long)r * 1024 : p.xs + (long)(r - TP) * 1024;
    row_norm_bf16_xn(src, p.norm_mix_pre, (bf16_t*)(ws + OFF_HBUF) + (long)r * 1024, lane);
  }
}

constexpr int GROW = 144;
constexpr int G8_BM = 256, G8_BK = 64, G8_HALF = 128, G8_HT = G8_HALF * G8_BK;

DI int g8_lds_byte(int r, int c) {
  int st = (r >> 4) * 2 + (c >> 5), rr = r & 15, cc = c & 31, ob = rr * 64 + cc * 2;
  return st * 1024 + (ob ^ (((ob >> 9) & 1) << 5));
}
DI void g8_stage_rc(int b, int& R, int& C) {
  int st = b / 1024, sb = b % 1024, swz = sb ^ (((sb >> 9) & 1) << 5);
  R = (st >> 1) * 16 + swz / 64; C = (st & 1) * 32 + (swz % 64) / 2;
}

template <bool SWAP>
DI void g8_tile(const bf16_t* __restrict__ Ag, const bf16_t* __restrict__ Bg, int K, int brow, int bcol, bf16_t* shm,
                f32x4 (&acc)[2][2][4][2], const int tidx, const bool prestaged) {
#define SA(b, h) (shm + ((b) * 2 + (h)) * G8_HT)
#define SB(b, h) (shm + (4 + (b) * 2 + (h)) * G8_HT)
#define STAGE(Pp, BASE, br, kt) do { const char* _gb = (const char*)(BASE + (long)(br) * K + (long)(kt) * G8_BK); \
    __builtin_amdgcn_global_load_lds((const unsigned*)(_gb + voff0), \
        (__attribute__((address_space(3))) unsigned*)((char*)(Pp) + tidx * 16), 16, 0, 0); \
    __builtin_amdgcn_global_load_lds((const unsigned*)(_gb + (long)K * 128 + voff0), \
        (__attribute__((address_space(3))) unsigned*)((char*)(Pp) + tidx * 16 + 8192), 16, 0, 0); } while (0)
#define LDA(dst, b, h) for (int m = 0; m < 4; ++m) for (int k = 0; k < 2; ++k) \
    dst[m][k] = *reinterpret_cast<const bf16x8*>((char*)SA(b, h) + g8_lds_byte(wr * 64 + m * 16 + fr, k * 32 + fq * 8))
#define LDB(dst, b, h) for (int n = 0; n < 2; ++n) for (int k = 0; k < 2; ++k) \
    dst[n][k] = *reinterpret_cast<const bf16x8*>((char*)SB(b, h) + g8_lds_byte(wc * 32 + n * 16 + fr, k * 32 + fq * 8))
#define MMA(ai, bj, Af, Bf) do { __builtin_amdgcn_s_setprio(1); \
    for (int m = 0; m < 4; ++m) for (int n = 0; n < 2; ++n) for (int k = 0; k < 2; ++k) \
      acc[ai][bj][m][n] = SWAP ? __builtin_amdgcn_mfma_f32_16x16x32_bf16(Bf[n][k], Af[m][k], acc[ai][bj][m][n], 0, 0, 0) \
                               : __builtin_amdgcn_mfma_f32_16x16x32_bf16(Af[m][k], Bf[n][k], acc[ai][bj][m][n], 0, 0, 0); \
    __builtin_amdgcn_s_setprio(0); } while (0)
#define WAIT_V(n) asm volatile("s_waitcnt vmcnt(" #n ")" ::: "memory")
#define WAIT_L(n) asm volatile("s_waitcnt lgkmcnt(" #n ")" ::: "memory")
#define BAR __builtin_amdgcn_s_barrier()
#define SCHED __builtin_amdgcn_sched_barrier(0)
  const int wid = __builtin_amdgcn_readfirstlane(tidx >> 6), lane = tidx & 63, wr = wid >> 2, wc = wid & 3, fr = lane & 15, fq = lane >> 4;
#pragma unroll
  for (int a = 0; a < 2; ++a)
#pragma unroll
    for (int b = 0; b < 2; ++b)
#pragma unroll
      for (int m = 0; m < 4; ++m)
#pragma unroll
        for (int n = 0; n < 2; ++n) acc[a][b][m][n] = f32x4{0.f, 0.f, 0.f, 0.f};
  bf16x8 At[4][2], B0[2][2], B1[2][2];
  const int nt = K / G8_BK;
  unsigned voff0;
  { int _r, _c; g8_stage_rc(tidx * 16, _r, _c); voff0 = (unsigned)(_r * K + _c) * 2u; }
  if (!prestaged) {
    STAGE(SB(0, 0), Bg, bcol, 0); STAGE(SA(0, 0), Ag, brow, 0);
    STAGE(SB(0, 1), Bg, bcol + G8_HALF, 0); STAGE(SA(0, 1), Ag, brow + G8_HALF, 0);
    if (wr == 1) BAR;
    WAIT_V(4); BAR;
  } else {
    if (wr == 1) BAR;
    WAIT_V(0); BAR;
  }
  STAGE(SB(1, 0), Bg, bcol, 1); STAGE(SA(1, 0), Ag, brow, 1); STAGE(SB(1, 1), Bg, bcol + G8_HALF, 1);
  WAIT_V(6); BAR;
  for (int t = 0; t < nt - 2; t += 2) {
    LDB(B0, 0, 0); SCHED; LDA(At, 0, 0); STAGE(SA(1, 1), Ag, brow + G8_HALF, t + 1);
    WAIT_L(8); BAR; WAIT_L(0); MMA(0, 0, At, B0); BAR; SCHED;
    LDB(B1, 0, 1); STAGE(SB(0, 0), Bg, bcol, t + 2);
    BAR; WAIT_L(0); MMA(0, 1, At, B1); BAR;
    LDA(At, 0, 1); STAGE(SA(0, 0), Ag, brow, t + 2);
    BAR; WAIT_L(0); MMA(1, 0, At, B0); BAR; SCHED;
    STAGE(SB(0, 1), Bg, bcol + G8_HALF, t + 2);
    WAIT_V(6); BAR; MMA(1, 1, At, B1); BAR;
    LDB(B0, 1, 0); SCHED; LDA(At, 1, 0); STAGE(SA(0, 1), Ag, brow + G8_HALF, t + 2);
    WAIT_L(8); BAR; WAIT_L(0); MMA(0, 0, At, B0); BAR; SCHED;
    LDB(B1, 1, 1); STAGE(SB(1, 0), Bg, bcol, t + 3);
    BAR; WAIT_L(0); MMA(0, 1, At, B1); BAR;
    LDA(At, 1, 1); STAGE(SA(1, 0), Ag, brow, t + 3);
    BAR; WAIT_L(0); MMA(1, 0, At, B0); BAR; SCHED;
    STAGE(SB(1, 1), Bg, bcol + G8_HALF, t + 3);
    WAIT_V(6); BAR; MMA(1, 1, At, B1); BAR;
  }
  { LDB(B0, 0, 0); LDA(At, 0, 0); STAGE(SA(1, 1), Ag, brow + G8_HALF, nt - 1);
    BAR; WAIT_L(0); MMA(0, 0, At, B0); BAR;
    LDB(B1, 0, 1); BAR; WAIT_L(0); MMA(0, 1, At, B1); BAR;
    LDA(At, 0, 1); WAIT_V(4); BAR; WAIT_L(0); MMA(1, 0, At, B0); MMA(1, 1, At, B1); BAR; }
  { LDB(B0, 1, 0); LDA(At, 1, 0); WAIT_V(2); BAR; WAIT_L(0); MMA(0, 0, At, B0); BAR;
    LDB(B1, 1, 1); WAIT_V(0); BAR; WAIT_L(0); MMA(0, 1, At, B1); BAR;
    LDA(At, 1, 1); BAR; WAIT_L(0); MMA(1, 0, At, B0); MMA(1, 1, At, B1); BAR; }
  if (wr == 0) BAR;
#undef SA
#undef SB
#undef STAGE
#undef LDA
#undef LDB
#undef MMA
}

DI void g8_stage0(const bf16_t* __restrict__ Ag, const bf16_t* __restrict__ Bg, int K, int brow, int bcol, bf16_t* shm, const int tidx) {
  unsigned voff0;
  { int _r, _c; g8_stage_rc(tidx * 16, _r, _c); voff0 = (unsigned)(_r * K + _c) * 2u; }
#define SA(b, h) (shm + ((b) * 2 + (h)) * G8_HT)
#define SB(b, h) (shm + (4 + (b) * 2 + (h)) * G8_HT)
#define STAGE(Pp, BASE, br, kt) do { const char* _gb = (const char*)(BASE + (long)(br) * K + (long)(kt) * G8_BK); \
    __builtin_amdgcn_global_load_lds((const unsigned*)(_gb + voff0), \
        (__attribute__((address_space(3))) unsigned*)((char*)(Pp) + tidx * 16), 16, 0, 0); \
    __builtin_amdgcn_global_load_lds((const unsigned*)(_gb + (long)K * 128 + voff0), \
        (__attribute__((address_space(3))) unsigned*)((char*)(Pp) + tidx * 16 + 8192), 16, 0, 0); } while (0)
  STAGE(SB(0, 0), Bg, bcol, 0); STAGE(SA(0, 0), Ag, brow, 0);
  STAGE(SB(0, 1), Bg, bcol + G8_HALF, 0); STAGE(SA(0, 1), Ag, brow + G8_HALF, 0);
#undef SA
#undef SB
#undef STAGE
}

struct Job {
  const bf16_t* A; const bf16_t* B; bf16_t* dst;
  int K, mtiles, ntiles, mode;
};

DI void g8_unit(int L, int nM, int nN, int& pm, int& pn) {
  const int nwg = nM * nN;
  int wgid = L;
  { const int q = nwg / 8, r = nwg % 8, xcd = wgid % 8, off = wgid / 8; wgid = (xcd < r ? xcd * (q + 1) : r * (q + 1) + (xcd - r) * q) + off; }
  const int nig = 8 * nN, gid = wgid / nig, fm = gid * 8, gsz = (nM - fm) < 8 ? (nM - fm) : 8;
  pm = fm + ((wgid % nig) % gsz); pn = (wgid % nig) / gsz;
}

DI void run_gemm_unit(const P& p, const Job& jb, int L, char* smem, const bool prestaged, const bool hasnext, const Job& jn, int Ln) {
  char* ws = p.ws;
  int tidx = threadIdx.x;
  asm volatile("" : "+v"(tidx));
  const int wid = __builtin_amdgcn_readfirstlane(tidx >> 6), lane = tidx & 63, wr = wid >> 2, wc = wid & 3;
  int fr = lane & 15, fq = lane >> 4;
  int pm, pn;
  g8_unit(L, jb.mtiles, jb.ntiles, pm, pn);
  const int m0 = pm * 256, n0 = pn * 256;
  f32x4 acc[2][2][4][2];
  const bool transposed = (jb.mode == 0 && ((n0 >= 2560 && n0 < 3072) || (n0 >= 512 && n0 < 1024))) || (jb.mode == 1 && n0 >= 1024);
  g8_tile<true>(jb.A, jb.B, jb.K, m0, n0, (bf16_t*)smem, acc, tidx, prestaged);
  const bool early = hasnext && (jb.mode == 3);
  if (early) {
    int pm2, pn2;
    g8_unit(Ln, jn.mtiles, jn.ntiles, pm2, pn2);
    g8_stage0(jn.A, jn.B, jn.K, pm2 * 256, pn2 * 256, (bf16_t*)smem, tidx);
  }
  asm volatile("" : "+v"(fr), "+v"(fq));
  const bool gates = (jb.mode == 0 && n0 >= 3072);
  u4 outv[16];
  bf16_t* gdst = nullptr;
  long istride = 0;
  int nch = 16;
  if (gates) {
    if (wc == 0) {
      float* g = (float*)(ws + OFF_GATES);
#pragma unroll
      for (int ai = 0; ai < 2; ++ai)
#pragma unroll
        for (int m = 0; m < 4; ++m)
#pragma unroll
          for (int n = 0; n < 2; ++n) {
            int row = m0 + ai * 128 + wr * 64 + m * 16 + fr;
            *(f32x4*)(g + (long)row * 32 + n * 16 + fq * 4) = acc[ai][0][m][n];
          }
    }
    nch = 0;
  } else if (transposed) {
    bf16_t* dstT; long ldT; int nb;
    if (jb.mode == 0 && n0 < 1024) { dstT = (bf16_t*)(ws + OFF_GV); ldT = T; nb = 512; }
    else if (jb.mode == 0) { dstT = (bf16_t*)(ws + OFF_DVT); ldT = T; nb = 2560; }
    else { dstT = (bf16_t*)(ws + OFF_VXT); ldT = MT; nb = 1024; }
#pragma unroll
    for (int ai = 0; ai < 2; ++ai)
#pragma unroll
      for (int bj = 0; bj < 2; ++bj)
#pragma unroll
        for (int m = 0; m < 4; ++m)
#pragma unroll
          for (int n = 0; n < 2; ++n) {
            const int rowm = ai * 128 + wr * 64 + m * 16 + fr;
            f32x4 v = acc[ai][bj][m][n];
#pragma unroll
            for (int j = 0; j < 4; ++j) {
              const int colL = bj * 128 + wc * 32 + n * 16 + fq * 4 + j;
              *(bf16_t*)(smem + colL * 512 + (((rowm >> 3) ^ (colL & 31)) << 4) + (rowm & 7) * 2) = f2b(v[j]);
            }
          }
    __syncthreads();
#pragma unroll
    for (int i = 0; i < 16; ++i) {
      const int colL = (tidx >> 5) + 16 * i, c = tidx & 31;
      outv[i] = *(const u4*)(smem + colL * 512 + ((c ^ (colL & 31)) << 4));
    }
    gdst = dstT + (long)(n0 - nb + (tidx >> 5)) * ldT + m0 + (tidx & 31) * 8;
    istride = 16 * ldT;
  } else if (jb.mode == 3) {
#pragma unroll
    for (int ai = 0; ai < 2; ++ai)
#pragma unroll
      for (int bj = 0; bj < 2; ++bj)
#pragma unroll
        for (int m = 0; m < 4; ++m) {
          const int row = ai * 128 + wr * 64 + m * 16 + fr;
          f32x4 g = acc[ai][bj][m][0], u = acc[ai][bj][m][1];
          float o[4];
#pragma unroll
          for (int r = 0; r < 4; ++r) o[r] = g[r] * u[r] * __builtin_amdgcn_rcpf(1.f + __builtin_amdgcn_exp2f(-g[r] * LOG2E));
          u2 pk; pk.x = pk2(o[0], o[1]); pk.y = pk2(o[2], o[3]);
          const int chunk = bj * 8 + wc * 2 + (fq >> 1);
          *(u2*)(smem + row * 256 + (row >= 128 ? 65536 : 32768) + ((chunk ^ (row & 15)) << 4) + (fq & 1) * 8) = pk;
        }
    __syncthreads();
#pragma unroll
    for (int i = 0; i < 8; ++i) {
      const int row = (tidx >> 4) + 32 * i, c = tidx & 15;
      outv[i] = *(const u4*)(smem + row * 256 + (row >= 128 ? 65536 : 32768) + ((c ^ (row & 15)) << 4));
    }
    gdst = jb.dst + (long)(m0 + (tidx >> 4)) * DFF + (n0 >> 1) + (tidx & 15) * 8;
    istride = 32L * DFF;
    nch = 8;
  } else {
    bf16_t* dst; int ld; int nb;
    if (jb.mode == 2) { dst = jb.dst; ld = 1024; nb = 0; }
    else if (jb.mode == 1) { dst = (bf16_t*)(ws + OFF_KX); ld = 1024; nb = 0; }
    else {
      if (n0 < 256) { dst = (bf16_t*)(ws + OFF_GQ); ld = 256; nb = 0; }
      else if (n0 < 512) { dst = (bf16_t*)(ws + OFF_GK); ld = 256; nb = 256; }
      else if (n0 < 1536) { dst = (bf16_t*)(ws + OFF_OG); ld = 512; nb = 1024; }
      else if (n0 < 2048) { dst = (bf16_t*)(ws + OFF_DQ); ld = 512; nb = 1536; }
      else { dst = (bf16_t*)(ws + OFF_DK); ld = 512; nb = 2048; }
    }
    const bool rope = (jb.mode == 0) && (n0 >= 1536) && (n0 < 2560) && ((wc & 1) == 0);
    const float l2t = log2f(500000.f) * (1.f / 8.f);
#pragma unroll
    for (int ai = 0; ai < 2; ++ai)
#pragma unroll
      for (int bj = 0; bj < 2; ++bj)
#pragma unroll
        for (int m = 0; m < 4; ++m)
#pragma unroll
          for (int n = 0; n < 2; ++n) {
            const int row = ai * 128 + wr * 64 + m * 16 + fr;
            f32x4 v = acc[ai][bj][m][n];
            if (rope && n == 0) {
              const int grow = m0 + row;
              const int pos = grow < TP ? grow : ((grow - TP) & (SS - 1));
#pragma unroll
              for (int j = 0; j < 4; ++j) {
                auto rr = __builtin_amdgcn_permlane32_swap(__float_as_uint(v[j]), __float_as_uint(v[j]), false, false);
                const float pv = __uint_as_float(fq < 2 ? rr[1] : rr[0]);
                const int i = (fq & 1) * 4 + j;
                const float inv = exp2f(-(float)i * l2t);
                const float ang = (float)pos * inv;
                const float kk = rintf(ang * 0.15915494309189535f);
                const float frv = fmaf(ang, 0.15915494309189535f, -kk) + ang * 6.4206383e-9f;
                const float sn = __builtin_amdgcn_sinf(frv), cs = __builtin_amdgcn_cosf(frv);
                v[j] = fq < 2 ? v[j] * cs - pv * sn : v[j] * cs + pv * sn;
              }
            }
            u2 pk; pk.x = pk2(v[0], v[1]); pk.y = pk2(v[2], v[3]);
            const int chunk = bj * 16 + wc * 4 + n * 2 + (fq >> 1);
            *(u2*)(smem + row * 512 + ((chunk ^ (row & 31)) << 4) + (fq & 1) * 8) = pk;
          }
    __syncthreads();
#pragma unroll
    for (int i = 0; i < 16; ++i) {
      const int row = (tidx >> 5) + 16 * i, c = tidx & 31;
      outv[i] = *(const u4*)(smem + row * 512 + ((c ^ (row & 31)) << 4));
    }
    gdst = dst + (long)(m0 + (tidx >> 5)) * ld + (n0 - nb) + (tidx & 31) * 8;
    istride = 16L * ld;
  }
  __syncthreads();
  if (hasnext && !early) {
    int pm2, pn2;
    g8_unit(Ln, jn.mtiles, jn.ntiles, pm2, pn2);
    g8_stage0(jn.A, jn.B, jn.K, pm2 * 256, pn2 * 256, (bf16_t*)smem, tidx);
  }
#pragma unroll
  for (int i = 0; i < 16; ++i)
    if (i < nch) *(u4*)(gdst + (long)i * istride) = outv[i];
  if (!hasnext) asm volatile("s_waitcnt vmcnt(0)" ::: "memory");
}

DI void run_gemm_job(const P& p, const Job& jb, char* smem) {
  const int nu = jb.mtiles * jb.ntiles;
  const int G = gridDim.x;
  bool pre = false;
  for (int L = blockIdx.x; L < nu; L += G) {
    const bool hn = L + G < nu;
    run_gemm_unit(p, jb, L, smem, pre, hn, jb, L + G);
    pre = hn;
  }
}

constexpr int VROW = 136;

template <int DQK, bool PF>
DI void flash_item(const bf16_t* __restrict__ Q, int ldq, const bf16_t* __restrict__ Kp, int ldk,
                   const bf16_t* __restrict__ Vt, long ldvt, int nkeys, float c, bf16_t* __restrict__ O, int ldo,
                   char* smem) {
  constexpr int KROW = (DQK + 8) * 2;
  constexpr int KCH = 64 * DQK * 2 / 16 / 256;
  constexpr int CPR = DQK / 8;
  char* Ks = smem;
  char* Vs = smem + 64 * KROW;
  const int tid = VT, lane = tid & 63, w = tid >> 6, r = lane & 31, h = lane >> 5;
  bf16x8 qf[DQK / 16];
  {
    const bf16_t* qrow = Q + (long)(w * 32 + r) * ldq + 8 * h;
#pragma unroll
    for (int ks = 0; ks < DQK / 16; ++ks) qf[ks] = *(const bf16x8*)(qrow + 16 * ks);
  }
  f32x16 o[4];
#pragma unroll
  for (int i = 0; i < 4; ++i)
#pragma unroll
    for (int j = 0; j < 16; ++j) o[i][j] = 0.f;
  float m_run = -1e30f, l_run = 0.f;
  u4 kreg[KCH], vreg[4];
#define FL_GLOAD(kt_) \
  _Pragma("unroll") for (int i = 0; i < KCH; ++i) { \
    int cc = tid + 256 * i, row = cc / CPR, kc = cc % CPR; \
    kreg[i] = *(const u4*)(Kp + (long)((kt_) * 64 + row) * ldk + kc * 8); \
  } \
  _Pragma("unroll") for (int i = 0; i < 4; ++i) { \
    int cc = tid + 256 * i, row = cc >> 3, kc = cc & 7; \
    vreg[i] = *(const u4*)(Vt + (long)row * ldvt + (kt_) * 64 + kc * 8); \
  }
#define FL_LSTORE() \
  _Pragma("unroll") for (int i = 0; i < KCH; ++i) { \
    int cc = tid + 256 * i, row = cc / CPR, kc = cc % CPR; \
    *(u4*)(Ks + row * KROW + kc * 16) = kreg[i]; \
  } \
  _Pragma("unroll") for (int i = 0; i < 4; ++i) { \
    int cc = tid + 256 * i, row = cc >> 3, kc = cc & 7; \
    *(u2*)(Vs + row * VROW + kc * 16) = u2{vreg[i].x, vreg[i].y}; \
    *(u2*)(Vs + row * VROW + kc * 16 + 8) = u2{vreg[i].z, vreg[i].w}; \
  }
  const int nt = nkeys >> 6;
  if (PF) { FL_GLOAD(0) }
  for (int kt = 0; kt < nt; ++kt) {
    __syncthreads();
    if (PF) {
      FL_LSTORE()
    } else {
#pragma unroll
      for (int g = 0; g < KCH / 4; ++g) {
        u4 tmp[4];
#pragma unroll
        for (int i = 0; i < 4; ++i) {
          int cc = tid + 256 * (g * 4 + i), row = cc / CPR, kc = cc % CPR;
          tmp[i] = *(const u4*)(Kp + (long)(kt * 64 + row) * ldk + kc * 8);
        }
#pragma unroll
        for (int i = 0; i < 4; ++i) {
          int cc = tid + 256 * (g * 4 + i), row = cc / CPR, kc = cc % CPR;
          *(u4*)(Ks + row * KROW + kc * 16) = tmp[i];
        }
        __builtin_amdgcn_sched_barrier(0);
      }
      {
        u4 tmp[4];
#pragma unroll
        for (int i = 0; i < 4; ++i) {
          int cc = tid + 256 * i, row = cc >> 3, kc = cc & 7;
          tmp[i] = *(const u4*)(Vt + (long)row * ldvt + kt * 64 + kc * 8);
        }
#pragma unroll
        for (int i = 0; i < 4; ++i) {
          int cc = tid + 256 * i, row = cc >> 3, kc = cc & 7;
          *(u2*)(Vs + row * VROW + kc * 16) = u2{tmp[i].x, tmp[i].y};
          *(u2*)(Vs + row * VROW + kc * 16 + 8) = u2{tmp[i].z, tmp[i].w};
        }
      }
    }
    __syncthreads();
    if (PF && kt + 1 < nt) { FL_GLOAD(kt + 1) }
    f32x16 s[2];
#pragma unroll
    for (int kb = 0; kb < 2; ++kb)
#pragma unroll
      for (int j = 0; j < 16; ++j) s[kb][j] = 0.f;
#pragma unroll
    for (int kg = 0; kg < DQK / 64; ++kg) {
      bf16x8 kf[4][2];
#pragma unroll
      for (int k4 = 0; k4 < 4; ++k4)
#pragma unroll
        for (int kb = 0; kb < 2; ++kb)
          kf[k4][kb] = *(const bf16x8*)(Ks + (32 * kb + r) * KROW + (16 * (kg * 4 + k4) + 8 * h) * 2);
#pragma unroll
      for (int k4 = 0; k4 < 4; ++k4)
#pragma unroll
        for (int kb = 0; kb < 2; ++kb)
          s[kb] = __builtin_amdgcn_mfma_f32_32x32x16_bf16(kf[k4][kb], qf[kg * 4 + k4], s[kb], 0, 0, 0);
      __builtin_amdgcn_sched_group_barrier(0x100, 8, 0);
      __builtin_amdgcn_sched_group_barrier(0x008, 8, 0);
      __builtin_amdgcn_sched_barrier(0);
    }
    bf16x8 vf0[2][4];
#pragma unroll
    for (int st = 0; st < 2; ++st)
#pragma unroll
      for (int dvb = 0; dvb < 4; ++dvb) {
        const char* vp = Vs + (32 * dvb + r) * VROW + (16 * st + 4 * h) * 2;
        bf16x4 lo = *(const bf16x4*)vp;
        bf16x4 hi = *(const bf16x4*)(vp + 16);
        vf0[st][dvb] = __builtin_shufflevector(lo, hi, 0, 1, 2, 3, 4, 5, 6, 7);
      }
    __builtin_amdgcn_sched_barrier(0);
    float mx = s[0][0];
#pragma unroll
    for (int kb = 0; kb < 2; ++kb)
#pragma unroll
      for (int j = 0; j < 16; ++j) mx = fmaxf(mx, s[kb][j]);
    mx = half_swap_max(mx);
    const float m_new = fmaxf(m_run, mx * c);
    if (__builtin_amdgcn_ballot_w64(m_new > m_run) != 0ull) {
      const float alpha = __builtin_amdgcn_exp2f(m_run - m_new);
      m_run = m_new;
      l_run *= alpha;
#pragma unroll
      for (int i = 0; i < 4; ++i)
#pragma unroll
        for (int j = 0; j < 16; ++j) o[i][j] *= alpha;
    }
    float ps = 0.f;
#pragma unroll
    for (int kb = 0; kb < 2; ++kb)
#pragma unroll
      for (int j = 0; j < 16; ++j) {
        float pv = __builtin_amdgcn_exp2f(s[kb][j] * c - m_run);
        s[kb][j] = pv;
        ps += pv;
      }
    l_run += ps;
    bf16x8 pf[2][2];
#pragma unroll
    for (int kb = 0; kb < 2; ++kb)
#pragma unroll
      for (int st = 0; st < 2; ++st) {
        u4 pu;
        pu.x = pk2(s[kb][8 * st + 0], s[kb][8 * st + 1]);
        pu.y = pk2(s[kb][8 * st + 2], s[kb][8 * st + 3]);
        pu.z = pk2(s[kb][8 * st + 4], s[kb][8 * st + 5]);
        pu.w = pk2(s[kb][8 * st + 6], s[kb][8 * st + 7]);
        pf[kb][st] = __builtin_bit_cast(bf16x8, pu);
      }
    __builtin_amdgcn_sched_barrier(0);
    bf16x8 vf1[2][4];
#pragma unroll
    for (int st = 0; st < 2; ++st)
#pragma unroll
      for (int dvb = 0; dvb < 4; ++dvb) {
        const char* vp = Vs + (32 * dvb + r) * VROW + (32 + 16 * st + 4 * h) * 2;
        bf16x4 lo = *(const bf16x4*)vp;
        bf16x4 hi = *(const bf16x4*)(vp + 16);
        vf1[st][dvb] = __builtin_shufflevector(lo, hi, 0, 1, 2, 3, 4, 5, 6, 7);
      }
#pragma unroll
    for (int st = 0; st < 2; ++st)
#pragma unroll
      for (int dvb = 0; dvb < 4; ++dvb) o[dvb] = __builtin_amdgcn_mfma_f32_32x32x16_bf16(vf0[st][dvb], pf[0][st], o[dvb], 0, 0, 0);
    __builtin_amdgcn_sched_group_barrier(0x100, 16, 0);
    __builtin_amdgcn_sched_group_barrier(0x008, 8, 0);
    __builtin_amdgcn_sched_barrier(0);
#pragma unroll
    for (int st = 0; st < 2; ++st)
#pragma unroll
      for (int dvb = 0; dvb < 4; ++dvb) o[dvb] = __builtin_amdgcn_mfma_f32_32x32x16_bf16(vf1[st][dvb], pf[1][st], o[dvb], 0, 0, 0);
  }
  float l = half_swap_sum(l_run);
  float inv = 1.f / l;
  bf16_t* orow = O + (long)(w * 32 + r) * ldo;
#pragma unroll
  for (int dvb = 0; dvb < 4; ++dvb)
#pragma unroll
    for (int g = 0; g < 4; ++g) {
      u2 pk;
      pk.x = pk2(o[dvb][4 * g + 0] * inv, o[dvb][4 * g + 1] * inv);
      pk.y = pk2(o[dvb][4 * g + 2] * inv, o[dvb][4 * g + 3] * inv);
      *(u2*)(orow + 32 * dvb + 8 * g + 4 * h) = pk;
    }
  __syncthreads();
}

template <int DQK>
DI void flash256x_core(const bf16x8 (&qf)[DQK / 16], const bf16_t* __restrict__ Kp, int ldk,
                      const bf16_t* __restrict__ Vt, long ldvt, int nkeys, float c, bf16_t* __restrict__ O, int ldo,
                      char* smem) {
  constexpr int KROW = (DQK + 8) * 2;
  constexpr int BUFB = 64 * KROW + 128 * VROW;
  constexpr int KCH = DQK / 64;
  constexpr int CPR = DQK / 8;
  int tid = threadIdx.x;
  asm volatile("" : "+v"(tid));
  const int lane = tid & 63, w = tid >> 6, r = lane & 31, h = lane >> 5;
  f32x16 o[4];
#pragma unroll
  for (int i = 0; i < 4; ++i)
#pragma unroll
    for (int j = 0; j < 16; ++j) o[i][j] = 0.f;
  float m_run = -1e30f, l_run = 0.f;
  const bf16_t* vg0 = Vt + (long)(tid >> 3) * ldvt + (tid & 7) * 8;
  const bf16_t* vg1 = Vt + (long)(64 + (tid >> 3)) * ldvt + (tid & 7) * 8;
  const int vso0 = 64 * KROW + (tid >> 3) * VROW + (tid & 7) * 16;
  const int vso1 = vso0 + 64 * VROW;
  u4 kr[KCH], vr0, vr1;
#define F2_GLOAD(kt_) { _Pragma("unroll") for (int i_ = 0; i_ < KCH; ++i_) { int cc_ = tid + 512 * i_; \
      kr[i_] = *(const u4*)(Kp + (long)((kt_) * 64 + cc_ / CPR) * ldk + (cc_ % CPR) * 8); } \
    vr0 = *(const u4*)(vg0 + (kt_) * 64); vr1 = *(const u4*)(vg1 + (kt_) * 64); }
#define F2_LSTORE(buf_) { char* bb = smem + (buf_) * BUFB; \
    _Pragma("unroll") for (int i_ = 0; i_ < KCH; ++i_) { int cc_ = tid + 512 * i_; *(u4*)(bb + (cc_ / CPR) * KROW + (cc_ % CPR) * 16) = kr[i_]; } \
    *(u2*)(bb + vso0) = u2{vr0.x, vr0.y}; *(u2*)(bb + vso0 + 8) = u2{vr0.z, vr0.w}; \
    *(u2*)(bb + vso1) = u2{vr1.x, vr1.y}; *(u2*)(bb + vso1 + 8) = u2{vr1.z, vr1.w}; }
  const int nt = nkeys >> 6;
  F2_GLOAD(0)
  __syncthreads();
  F2_LSTORE(0)
  if (nt > 1) F2_GLOAD(1)
  __syncthreads();
  for (int kt = 0; kt < nt; ++kt) {
    const char* Ks = smem + (kt & 1) * BUFB;
    const char* Vs = Ks + 64 * KROW;
    f32x16 s[2];
#pragma unroll
    for (int kb = 0; kb < 2; ++kb)
#pragma unroll
      for (int j = 0; j < 16; ++j) s[kb][j] = 0.f;
    constexpr int KG = (DQK == 64) ? 4 : 2;
    __builtin_amdgcn_s_setprio(1);
#pragma unroll
    for (int kg = 0; kg < DQK / 16 / KG; ++kg) {
      bf16x8 kf[KG][2];
#pragma unroll
      for (int k4 = 0; k4 < KG; ++k4)
#pragma unroll
        for (int kb = 0; kb < 2; ++kb) kf[k4][kb] = *(const bf16x8*)(Ks + (32 * kb + r) * KROW + (16 * (kg * KG + k4) + 8 * h) * 2);
#pragma unroll
      for (int k4 = 0; k4 < KG; ++k4)
#pragma unroll
        for (int kb = 0; kb < 2; ++kb) s[kb] = __builtin_amdgcn_mfma_f32_32x32x16_bf16(kf[k4][kb], qf[kg * KG + k4], s[kb], 0, 0, 0);
      __builtin_amdgcn_sched_group_barrier(0x100, 2 * KG, 0);
      __builtin_amdgcn_sched_group_barrier(0x008, 2 * KG, 0);
      __builtin_amdgcn_sched_barrier(0);
    }
    __builtin_amdgcn_s_setprio(0);
    bf16x8 vf0[2][4];
    if constexpr (DQK == 64) {
#pragma unroll
      for (int st = 0; st < 2; ++st)
#pragma unroll
        for (int dvb = 0; dvb < 4; ++dvb) {
          const char* vp = Vs + (32 * dvb + r) * VROW + (16 * st + 4 * h) * 2;
          bf16x4 lo = *(const bf16x4*)vp;
          bf16x4 hi = *(const bf16x4*)(vp + 16);
          vf0[st][dvb] = __builtin_shufflevector(lo, hi, 0, 1, 2, 3, 4, 5, 6, 7);
        }
      __builtin_amdgcn_sched_barrier(0);
    }
    float mx = s[0][0];
#pragma unroll
    for (int kb = 0; kb < 2; ++kb)
#pragma unroll
      for (int j = 0; j < 16; ++j) mx = fmaxf(mx, s[kb][j]);
    mx = half_swap_max(mx);
    const float mxs = mx * c;
    if (__builtin_amdgcn_ballot_w64(mxs > m_run + 8.f) != 0ull) {
      const float m_new = fmaxf(m_run, mxs);
      const float alpha = __builtin_amdgcn_exp2f(m_run - m_new);
      m_run = m_new;
      l_run *= alpha;
#pragma unroll
      for (int i = 0; i < 4; ++i)
#pragma unroll
        for (int j = 0; j < 16; ++j) o[i][j] *= alpha;
    }
    float ps = 0.f;
#pragma unroll
    for (int kb = 0; kb < 2; ++kb)
#pragma unroll
      for (int j = 0; j < 16; ++j) {
        float pv = __builtin_amdgcn_exp2f(s[kb][j] * c - m_run);
        s[kb][j] = pv;
        ps += pv;
      }
    l_run += ps;
    bf16x8 pf[2][2];
#pragma unroll
    for (int kb = 0; kb < 2; ++kb)
#pragma unroll
      for (int st = 0; st < 2; ++st) {
        u4 pu;
        pu.x = pk2(s[kb][8 * st + 0], s[kb][8 * st + 1]);
        pu.y = pk2(s[kb][8 * st + 2], s[kb][8 * st + 3]);
        pu.z = pk2(s[kb][8 * st + 4], s[kb][8 * st + 5]);
        pu.w = pk2(s[kb][8 * st + 6], s[kb][8 * st + 7]);
        pf[kb][st] = __builtin_bit_cast(bf16x8, pu);
      }
    __builtin_amdgcn_sched_barrier(0);
    if (kt + 1 < nt) {
      F2_LSTORE((kt + 1) & 1)
      if (kt + 2 < nt) F2_GLOAD(kt + 2)
    }
    __builtin_amdgcn_sched_barrier(0);
    __builtin_amdgcn_s_setprio(1);
    if constexpr (DQK == 64) {
      bf16x8 vf1[2][4];
#pragma unroll
      for (int st = 0; st < 2; ++st)
#pragma unroll
        for (int dvb = 0; dvb < 4; ++dvb) {
          const char* vp = Vs + (32 * dvb + r) * VROW + (32 + 16 * st + 4 * h) * 2;
          bf16x4 lo = *(const bf16x4*)vp;
          bf16x4 hi = *(const bf16x4*)(vp + 16);
          vf1[st][dvb] = __builtin_shufflevector(lo, hi, 0, 1, 2, 3, 4, 5, 6, 7);
        }
#pragma unroll
      for (int st = 0; st < 2; ++st)
#pragma unroll
        for (int dvb = 0; dvb < 4; ++dvb) o[dvb] = __builtin_amdgcn_mfma_f32_32x32x16_bf16(vf0[st][dvb], pf[0][st], o[dvb], 0, 0, 0);
      __builtin_amdgcn_sched_group_barrier(0x100, 16, 0);
      __builtin_amdgcn_sched_group_barrier(0x008, 8, 0);
      __builtin_amdgcn_sched_barrier(0);
#pragma unroll
      for (int st = 0; st < 2; ++st)
#pragma unroll
        for (int dvb = 0; dvb < 4; ++dvb) o[dvb] = __builtin_amdgcn_mfma_f32_32x32x16_bf16(vf1[st][dvb], pf[1][st], o[dvb], 0, 0, 0);
    } else {
#pragma unroll
      for (int kb = 0; kb < 2; ++kb)
#pragma unroll
        for (int st = 0; st < 2; ++st) {
          bf16x8 vf[4];
#pragma unroll
          for (int dvb = 0; dvb < 4; ++dvb) {
            const char* vp = Vs + (32 * dvb + r) * VROW + (32 * kb + 16 * st + 4 * h) * 2;
            bf16x4 lo = *(const bf16x4*)vp;
            bf16x4 hi = *(const bf16x4*)(vp + 16);
            vf[dvb] = __builtin_shufflevector(lo, hi, 0, 1, 2, 3, 4, 5, 6, 7);
          }
#pragma unroll
          for (int dvb = 0; dvb < 4; ++dvb) o[dvb] = __builtin_amdgcn_mfma_f32_32x32x16_bf16(vf[dvb], pf[kb][st], o[dvb], 0, 0, 0);
          __builtin_amdgcn_sched_group_barrier(0x100, 8, 0);
          __builtin_amdgcn_sched_group_barrier(0x008, 4, 0);
          __builtin_amdgcn_sched_barrier(0);
        }
    }
    __builtin_amdgcn_s_setprio(0);
    __syncthreads();
  }
  float l = half_swap_sum(l_run);
  float inv = 1.f / l;
  bf16_t* orow = O + (long)(w * 32 + r) * ldo;
#pragma unroll
  for (int dvb = 0; dvb < 4; ++dvb)
#pragma unroll
    for (int g = 0; g < 4; ++g) {
      u2 pk;
      pk.x = pk2(o[dvb][4 * g + 0] * inv, o[dvb][4 * g + 1] * inv);
      pk.y = pk2(o[dvb][4 * g + 2] * inv, o[dvb][4 * g + 3] * inv);
      *(u2*)(orow + 32 * dvb + 8 * g + 4 * h) = pk;
    }
#undef F2_GLOAD
#undef F2_LSTORE
}

template <int DQK>
DI void flash256_item(const bf16_t* __restrict__ Q, int ldq, const bf16_t* __restrict__ Kp, int ldk,
                      const bf16_t* __restrict__ Vt, long ldvt, int nkeys, float c, bf16_t* __restrict__ O, int ldo,
                      char* smem) {
  constexpr int KROW = (DQK + 8) * 2;
  constexpr int BUFB = 64 * KROW + 128 * VROW;
  constexpr int NBUF = (DQK == 64) ? 3 : 2;
  constexpr int KCH = DQK / 64;
  constexpr int CPR = DQK / 8;
  constexpr int KG = (DQK == 64) ? 4 : 2;
  const int tid = threadIdx.x, lane = tid & 63, w = __builtin_amdgcn_readfirstlane(tid >> 6), r = lane & 31, h = lane >> 5;
  const bool skew = (DQK == 64) && (w >= 4);
  bf16x8 qf[DQK / 16];
  {
    const bf16_t* qrow = Q + (long)(w * 32 + r) * ldq + 8 * h;
#pragma unroll
    for (int ks = 0; ks < DQK / 16; ++ks) qf[ks] = *(const bf16x8*)(qrow + 16 * ks);
  }
  f32x16 o[4];
#pragma unroll
  for (int i = 0; i < 4; ++i)
#pragma unroll
    for (int j = 0; j < 16; ++j) o[i][j] = 0.f;
  float m_run = -1e30f, l_run = 0.f;
  const bf16_t* vg0 = Vt + (long)(tid >> 3) * ldvt + (tid & 7) * 8;
  const bf16_t* vg1 = Vt + (long)(64 + (tid >> 3)) * ldvt + (tid & 7) * 8;
  const int vso0 = 64 * KROW + (tid >> 3) * VROW + (tid & 7) * 16;
  const int vso1 = vso0 + 64 * VROW;
  const int nt = nkeys >> 6;
  u4 kr[KCH], vr0, vr1;
  bf16x8 pf[2][2];
  f32x16 s[2];
#define F2_GLOAD(kt_) { const int t_ = min((kt_), nt - 1); _Pragma("unroll") for (int i_ = 0; i_ < KCH; ++i_) { int cc_ = tid + 512 * i_; \
      kr[i_] = *(const u4*)(Kp + (long)(t_ * 64 + cc_ / CPR) * ldk + (cc_ % CPR) * 8); } \
    vr0 = *(const u4*)(vg0 + t_ * 64); vr1 = *(const u4*)(vg1 + t_ * 64); }
#define F2_LSTORE(buf_) { char* bb = smem + (buf_) * BUFB; \
    _Pragma("unroll") for (int i_ = 0; i_ < KCH; ++i_) { int cc_ = tid + 512 * i_; *(u4*)(bb + (cc_ / CPR) * KROW + (cc_ % CPR) * 16) = kr[i_]; } \
    *(u2*)(bb + vso0) = u2{vr0.x, vr0.y}; *(u2*)(bb + vso0 + 8) = u2{vr0.z, vr0.w}; \
    *(u2*)(bb + vso1) = u2{vr1.x, vr1.y}; *(u2*)(bb + vso1 + 8) = u2{vr1.z, vr1.w}; }
#define SEC_STAGE(kt_, nxt_) { F2_LSTORE(nxt_) F2_GLOAD((kt_) + 2) __builtin_amdgcn_sched_barrier(0); }
#define SEC_QK(cur_) { const char* Ks_ = smem + (cur_) * BUFB; \
    _Pragma("unroll") for (int kb = 0; kb < 2; ++kb) _Pragma("unroll") for (int j = 0; j < 16; ++j) s[kb][j] = 0.f; \
    __builtin_amdgcn_s_setprio(1); \
    _Pragma("unroll") for (int kg = 0; kg < DQK / 16 / KG; ++kg) { \
      bf16x8 kf[KG][2]; \
      _Pragma("unroll") for (int k4 = 0; k4 < KG; ++k4) _Pragma("unroll") for (int kb = 0; kb < 2; ++kb) \
        kf[k4][kb] = *(const bf16x8*)(Ks_ + (32 * kb + r) * KROW + (16 * (kg * KG + k4) + 8 * h) * 2); \
      _Pragma("unroll") for (int k4 = 0; k4 < KG; ++k4) _Pragma("unroll") for (int kb = 0; kb < 2; ++kb) \
        s[kb] = __builtin_amdgcn_mfma_f32_32x32x16_bf16(kf[k4][kb], qf[kg * KG + k4], s[kb], 0, 0, 0); \
      __builtin_amdgcn_sched_group_barrier(0x100, 2 * KG, 0); \
      __builtin_amdgcn_sched_group_barrier(0x008, 2 * KG, 0); \
      __builtin_amdgcn_sched_barrier(0); \
    } \
    __builtin_amdgcn_s_setprio(0); }
#define SEC_SOFTMAX() { \
    float mx = s[0][0]; \
    _Pragma("unroll") for (int kb = 0; kb < 2; ++kb) _Pragma("unroll") for (int j = 0; j < 16; ++j) mx = fmaxf(mx, s[kb][j]); \
    mx = half_swap_max(mx); \
    const float mxs = mx * c; \
    if (__builtin_amdgcn_ballot_w64(mxs > m_run + 8.f) != 0ull) { \
      const float m_new = fmaxf(m_run, mxs); \
      const float alpha = __builtin_amdgcn_exp2f(m_run - m_new); \
      m_run = m_new; l_run *= alpha; \
      _Pragma("unroll") for (int i = 0; i < 4; ++i) _Pragma("unroll") for (int j = 0; j < 16; ++j) o[i][j] *= alpha; \
    } \
    float ps = 0.f; \
    _Pragma("unroll") for (int kb = 0; kb < 2; ++kb) _Pragma("unroll") for (int j = 0; j < 16; ++j) { \
        float pv = __builtin_amdgcn_exp2f(s[kb][j] * c - m_run); s[kb][j] = pv; ps += pv; } \
    l_run += ps; \
    _Pragma("unroll") for (int kb = 0; kb < 2; ++kb) _Pragma("unroll") for (int st = 0; st < 2; ++st) { \
        u4 pu; \
        pu.x = pk2(s[kb][8 * st + 0], s[kb][8 * st + 1]); pu.y = pk2(s[kb][8 * st + 2], s[kb][8 * st + 3]); \
        pu.z = pk2(s[kb][8 * st + 4], s[kb][8 * st + 5]); pu.w = pk2(s[kb][8 * st + 6], s[kb][8 * st + 7]); \
        pf[kb][st] = __builtin_bit_cast(bf16x8, pu); } \
    __builtin_amdgcn_sched_barrier(0); }
#define SEC_PV(vb_) { const char* Vs_ = smem + (vb_) * BUFB + 64 * KROW; \
    constexpr int SB_ = (DQK == 64) ? 2 : 1;     \
    __builtin_amdgcn_s_setprio(1); \
    _Pragma("unroll") for (int kbs = 0; kbs < 4 / SB_; ++kbs) { \
      bf16x8 vf[SB_][4]; \
      _Pragma("unroll") for (int sb = 0; sb < SB_; ++sb) _Pragma("unroll") for (int dvb = 0; dvb < 4; ++dvb) { \
          const char* vp = Vs_ + (32 * dvb + r) * VROW + (16 * (kbs * SB_ + sb) + 4 * h) * 2; \
          bf16x4 lo = *(const bf16x4*)vp; bf16x4 hi = *(const bf16x4*)(vp + 16); \
          vf[sb][dvb] = __builtin_shufflevector(lo, hi, 0, 1, 2, 3, 4, 5, 6, 7); } \
      _Pragma("unroll") for (int sb = 0; sb < SB_; ++sb) _Pragma("unroll") for (int dvb = 0; dvb < 4; ++dvb) \
          o[dvb] = __builtin_amdgcn_mfma_f32_32x32x16_bf16(vf[sb][dvb], pf[(kbs * SB_ + sb) >> 1][(kbs * SB_ + sb) & 1], o[dvb], 0, 0, 0); \
      __builtin_amdgcn_sched_group_barrier(0x100, 8 * SB_, 0); \
      __builtin_amdgcn_sched_group_barrier(0x008, 4 * SB_, 0); \
      __builtin_amdgcn_sched_barrier(0); \
    } \
    __builtin_amdgcn_s_setprio(0); }
  F2_GLOAD(0)
  __syncthreads();
  F2_LSTORE(0)
  F2_GLOAD(1)
  __syncthreads();
  int cur = 0, prv = 0;
  if (!skew) {
    for (int kt = 0; kt < nt; ++kt) {
      const int nxt = cur == NBUF - 1 ? 0 : cur + 1;
      SEC_QK(cur)
      SEC_SOFTMAX()
      SEC_STAGE(kt, nxt)
      SEC_PV(cur)
      __syncthreads();
      cur = nxt;
    }
  } else {
    for (int kt = 0; kt < nt; ++kt) {
      const int nxt = cur == NBUF - 1 ? 0 : cur + 1;
      if (kt > 0) SEC_PV(prv)
      SEC_STAGE(kt, nxt)
      SEC_QK(cur)
      SEC_SOFTMAX()
      __syncthreads();
      prv = cur; cur = nxt;
    }
    SEC_PV(prv)
  }
  float l = half_swap_sum(l_run);
  float inv = 1.f / l;
  bf16_t* orow = O + (long)(w * 32 + r) * ldo;
#pragma unroll
  for (int dvb = 0; dvb < 4; ++dvb)
#pragma unroll
    for (int g = 0; g < 4; ++g) {
      u2 pk;
      pk.x = pk2(o[dvb][4 * g + 0] * inv, o[dvb][4 * g + 1] * inv);
      pk.y = pk2(o[dvb][4 * g + 2] * inv, o[dvb][4 * g + 3] * inv);
      *(u2*)(orow + 32 * dvb + 8 * g + 4 * h) = pk;
    }
#undef F2_GLOAD
#undef F2_LSTORE
#undef SEC_STAGE
#undef SEC_QK
#undef SEC_SOFTMAX
#undef SEC_PV
}

constexpr int GL_GS = 0;
constexpr int GL_TOT = 8192;
constexpr int GL_B1 = 10240;
constexpr int GL_B2 = 19456;
constexpr int GL_VT = 28672;
constexpr int GL_AS = 47104;

DI float fexp(float x) { return __builtin_amdgcn_exp2f(x * LOG2E); }
DI float log_sigmoid(float z) { return fminf(z, 0.f) - __logf(1.f + fexp(-fabsf(z))); }

DI void gla_gates(const P& p, int t0, int hh, char* smem, float (&bfv)[16], float (&bbv)[16], float& totf, float& totb) {
  const int tid = VT, d = tid & 63, tg = tid >> 6;
  float* gs = (float*)(smem + GL_GS);
  float* tots = (float*)(smem + GL_TOT);
  const float* gates = (const float*)(p.ws + OFF_GATES) + (long)t0 * 32;
  __syncthreads();
  ((f4*)gs)[tid * 2] = ((const f4*)gates)[tid * 2];
  ((f4*)gs)[tid * 2 + 1] = ((const f4*)gates)[tid * 2 + 1];
  float wf[16], wb[16];
#pragma unroll
  for (int r = 0; r < 16; ++r) {
    wf[r] = p.w_gu_f[r * 256 + hh * 64 + d];
    wb[r] = p.w_gu_b[r * 256 + hh * 64 + d];
  }
  const float biasf = p.b_g_f[hh * 64 + d], biasb = p.b_g_b[hh * 64 + d];
  __syncthreads();
#pragma unroll
  for (int j = 0; j < 16; ++j) {
    const float* gr = gs + (tg * 16 + j) * 32;
    float zf = biasf, zb = biasb;
#pragma unroll
    for (int r = 0; r < 16; ++r) { zf += gr[r] * wf[r]; zb += gr[16 + r] * wb[r]; }
    bfv[j] = log_sigmoid(zf) * (1.f / 16.f);
    bbv[j] = log_sigmoid(zb) * (1.f / 16.f);
  }
  float run = 0.f;
#pragma unroll
  for (int j = 0; j < 16; ++j) { run += bfv[j]; bfv[j] = run; }
  tots[(0 * 4 + tg) * 64 + d] = run;
  run = 0.f;
#pragma unroll
  for (int j = 15; j >= 0; --j) { run += bbv[j]; bbv[j] = run; }
  tots[(1 * 4 + tg) * 64 + d] = run;
  __syncthreads();
  float offf = 0.f, offb = 0.f;
  totf = 0.f; totb = 0.f;
#pragma unroll
  for (int g = 0; g < 4; ++g) {
    float a = tots[(0 * 4 + g) * 64 + d], b = tots[(1 * 4 + g) * 64 + d];
    totf += a; totb += b;
    if (g < tg) offf += a;
    if (g > tg) offb += b;
  }
#pragma unroll
  for (int j = 0; j < 16; ++j) { bfv[j] += offf; bbv[j] += offb; }
}

DI void gla_g1_item(const P& p, int cgi, int hh, char* smem) {
  const int tid = VT, lane = tid & 63, w = tid >> 6, d = tid & 63, tg = tid >> 6;
  const int r16 = lane & 15, q4 = lane >> 4;
  const int t0 = cgi * 64;
  float bfv[16], bbv[16], totf, totb;
  gla_gates(p, t0, hh, smem, bfv, bbv, totf, totb);
  {
    const long rowoff = (long)(t0 + tg * 16) * 256 + hh * 64 + d;
    const bf16_t* gq = (const bf16_t*)(p.ws + OFF_GQ) + rowoff;
    const bf16_t* gk = (const bf16_t*)(p.ws + OFF_GK) + rowoff;
    bf16_t* qef = (bf16_t*)((char*)p.out + OUT_QEF) + rowoff;
    bf16_t* kef = (bf16_t*)((char*)p.out + OUT_KEF) + rowoff;
    bf16_t* qeb = (bf16_t*)((char*)p.out + OUT_QEB) + rowoff;
    bf16_t* keb = (bf16_t*)((char*)p.out + OUT_KEB) + rowoff;
    float qv[16], kv[16];
#pragma unroll
    for (int j = 0; j < 16; ++j) { qv[j] = b2f(gq[(long)j * 256]) * 0.125f; kv[j] = b2f(gk[(long)j * 256]); }
    unsigned pf[8], pb[8];
#pragma unroll
    for (int j = 0; j < 16; ++j) {
      float ef = fexp(bfv[j]), eb = fexp(bbv[j]);
      qef[(long)j * 256] = f2b(qv[j] * ef);
      qeb[(long)j * 256] = f2b(qv[j] * eb);
      kef[(long)j * 256] = f2b(kv[j] * fexp(-bfv[j]));
      keb[(long)j * 256] = f2b(kv[j] * fexp(-bbv[j]));
    }
#pragma unroll
    for (int j = 0; j < 8; ++j) {
      pf[j] = pk2(kv[2 * j] * fexp(totf - bfv[2 * j]), kv[2 * j + 1] * fexp(totf - bfv[2 * j + 1]));
      pb[j] = pk2(kv[2 * j] * fexp(totb - bbv[2 * j]), kv[2 * j + 1] * fexp(totb - bbv[2 * j + 1]));
    }
    char* d1 = smem + GL_B1 + d * GROW + tg * 32;
    char* d2 = smem + GL_B2 + d * GROW + tg * 32;
    *(u4*)(d1) = u4{pf[0], pf[1], pf[2], pf[3]};
    *(u4*)(d1 + 16) = u4{pf[4], pf[5], pf[6], pf[7]};
    *(u4*)(d2) = u4{pb[0], pb[1], pb[2], pb[3]};
    *(u4*)(d2 + 16) = u4{pb[4], pb[5], pb[6], pb[7]};
  }
  if (tg == 0) {
    float* dec = (float*)(p.ws + OFF_DEC) + (long)((cgi * 4 + hh) * 2) * 64;
    dec[d] = fexp(totf);
    dec[64 + d] = fexp(totb);
  }
  const bf16_t* gvt = (const bf16_t*)(p.ws + OFF_GV) + (long)(hh * 128 + 32 * w + r16) * T + t0 + q4 * 8;
  bf16x8 af[2][2];
#pragma unroll
  for (int i = 0; i < 2; ++i)
#pragma unroll
    for (int ks = 0; ks < 2; ++ks) af[i][ks] = *(const bf16x8*)(gvt + (long)(16 * i) * T + ks * 32);
  __syncthreads();
#pragma unroll
  for (int dir = 0; dir < 2; ++dir) {
    const char* kb = smem + (dir ? GL_B2 : GL_B1);
    f32x4 acc[2][4];
#pragma unroll
    for (int i = 0; i < 2; ++i)
#pragma unroll
      for (int j = 0; j < 4; ++j) acc[i][j] = f32x4{0.f, 0.f, 0.f, 0.f};
#pragma unroll
    for (int ks = 0; ks < 2; ++ks) {
      bf16x8 bfr[4];
#pragma unroll
      for (int j = 0; j < 4; ++j) bfr[j] = *(const bf16x8*)(kb + (16 * j + r16) * GROW + (ks * 32 + q4 * 8) * 2);
#pragma unroll
      for (int i = 0; i < 2; ++i)
#pragma unroll
        for (int j = 0; j < 4; ++j) acc[i][j] = __builtin_amdgcn_mfma_f32_16x16x32_bf16(af[i][ks], bfr[j], acc[i][j], 0, 0, 0);
    }
    bf16_t* U = (bf16_t*)(p.ws + OFF_UBUF) + (long)((cgi * 4 + hh) * 2 + dir) * 8192;
#pragma unroll
    for (int i = 0; i < 2; ++i)
#pragma unroll
      for (int j = 0; j < 4; ++j)
#pragma unroll
        for (int r = 0; r < 4; ++r) {
          int v = 32 * w + 16 * i + 4 * q4 + r, dd = 16 * j + r16;
          U[v * 64 + dd] = f2b(acc[i][j][r]);
        }
  }
}

DI void gla_g3_wave(const P& p, int cgi, int hh, int slab, char* wsm) {
  const int lane = VT & 63, r16 = lane & 15, q4 = lane >> 4;
  const int t0 = cgi * 64;
  f32x4 o[8];
#pragma unroll
  for (int j = 0; j < 8; ++j) o[j] = f32x4{0.f, 0.f, 0.f, 0.f};
  const bf16_t* gvt = (const bf16_t*)(p.ws + OFF_GV) + (long)(hh * 128 + r16) * T + t0 + q4 * 8;
  const bf16_t* og = (const bf16_t*)(p.ws + OFF_OG);
#pragma unroll
  for (int dir = 0; dir < 2; ++dir) {
    const bf16_t* QE = (const bf16_t*)((const char*)p.out + (dir ? OUT_QEB : OUT_QEF)) + (long)t0 * 256 + hh * 64 + q4 * 8;
    const bf16_t* KE = (const bf16_t*)((const char*)p.out + (dir ? OUT_KEB : OUT_KEF)) + (long)t0 * 256 + hh * 64 + q4 * 8;
    const bf16_t* S = (const bf16_t*)(p.ws + OFF_UBUF) + (long)((cgi * 4 + hh) * 2 + dir) * 8192;
    bf16x8 qf[2], kf[2][4], vf[8], sf[8];
#pragma unroll
    for (int ks = 0; ks < 2; ++ks) qf[ks] = *(const bf16x8*)(QE + (long)(16 * slab + r16) * 256 + ks * 32);
#pragma unroll
    for (int ks = 0; ks < 2; ++ks)
#pragma unroll
      for (int j = 0; j < 4; ++j) kf[ks][j] = *(const bf16x8*)(KE + (long)(16 * j + r16) * 256 + ks * 32);
#pragma unroll
    for (int j = 0; j < 8; ++j) {
      vf[j] = *(const bf16x8*)(gvt + (long)(16 * j) * T);
      sf[j] = *(const bf16x8*)(S + (16 * j + r16) * 64 + q4 * 8);
    }
    __builtin_amdgcn_sched_barrier(0);
    f32x4 a[4];
#pragma unroll
    for (int j = 0; j < 4; ++j) a[j] = f32x4{0.f, 0.f, 0.f, 0.f};
#pragma unroll
    for (int ks = 0; ks < 2; ++ks)
#pragma unroll
      for (int j = 0; j < 4; ++j) a[j] = __builtin_amdgcn_mfma_f32_16x16x32_bf16(qf[ks], kf[ks][j], a[j], 0, 0, 0);
    __builtin_amdgcn_wave_barrier();
    bf16_t* As = (bf16_t*)wsm;
#pragma unroll
    for (int j = 0; j < 4; ++j)
#pragma unroll
      for (int r = 0; r < 4; ++r) {
        int il = 4 * q4 + r, i = 16 * slab + il, jj = 16 * j + r16;
        bool keep = dir ? (jj >= i) : (jj <= i);
        As[il * 72 + jj] = f2b(keep ? a[j][r] : 0.f);
      }
    __builtin_amdgcn_wave_barrier();
    asm volatile("s_waitcnt lgkmcnt(0)" ::: "memory");
    bf16x8 af[2];
#pragma unroll
    for (int ks = 0; ks < 2; ++ks) af[ks] = *(const bf16x8*)(wsm + r16 * GROW + (ks * 32 + q4 * 8) * 2);
    bf16x8 vf2[8], sf2[8];
#pragma unroll
    for (int j = 0; j < 8; ++j) {
      vf2[j] = *(const bf16x8*)(gvt + (long)(16 * j) * T + 32);
      sf2[j] = *(const bf16x8*)(S + (16 * j + r16) * 64 + 32 + q4 * 8);
    }
    __builtin_amdgcn_sched_barrier(0);
#pragma unroll
    for (int j = 0; j < 8; ++j) {
      o[j] = __builtin_amdgcn_mfma_f32_16x16x32_bf16(af[0], vf[j], o[j], 0, 0, 0);
      o[j] = __builtin_amdgcn_mfma_f32_16x16x32_bf16(qf[0], sf[j], o[j], 0, 0, 0);
    }
    __builtin_amdgcn_sched_barrier(0);
#pragma unroll
    for (int j = 0; j < 8; ++j) {
      o[j] = __builtin_amdgcn_mfma_f32_16x16x32_bf16(af[1], vf2[j], o[j], 0, 0, 0);
      o[j] = __builtin_amdgcn_mfma_f32_16x16x32_bf16(qf[1], sf2[j], o[j], 0, 0, 0);
    }
    __builtin_amdgcn_sched_barrier(0);
  }
  float gv[8][4];
#pragma unroll
  for (int j = 0; j < 8; ++j)
#pragma unroll
    for (int r = 0; r < 4; ++r) gv[j][r] = b2f(og[(long)(t0 + 16 * slab + 4 * q4 + r) * 512 + hh * 128 + 16 * j + r16]);
  __builtin_amdgcn_sched_barrier(0);
  float ss[4];
#pragma unroll
  for (int r = 0; r < 4; ++r) {
    float sq = 0.f;
#pragma unroll
    for (int j = 0; j < 8; ++j) sq += o[j][r] * o[j][r];
    sq += __shfl_xor(sq, 1); sq += __shfl_xor(sq, 2); sq += __shfl_xor(sq, 4); sq += __shfl_xor(sq, 8);
    ss[r] = rsqrtf(sq * (1.f / 128.f) + EPS);
  }
  bf16_t* mixin = (bf16_t*)(p.ws + OFF_MIXIN);
#pragma unroll
  for (int j = 0; j < 8; ++j) {
    const int v = 16 * j + r16;
    const float gw = p.gla_norm_w[v];
#pragma unroll
    for (int r = 0; r < 4; ++r) {
      const int tok = t0 + 16 * slab + 4 * q4 + r;
      float g = gv[j][r];
      float val = o[j][r] * ss[r] * gw * (g / (1.f + fexp(-g)));
      mixin[(long)tok * 1024 + hh * 128 + v] = f2b(val);
    }
  }
}

DI void gla_g3_block(const P& p, int cgi, int hh, char* smem) {
  constexpr int O_QE = 0, O_KE = 9216, O_S = 18432, DIRB = 36864, O_VT = 73728, O_AS = 92160;
  const int tid = threadIdx.x, lane = tid & 63, w = __builtin_amdgcn_readfirstlane(tid >> 6), dir = w >> 2, slab = w & 3;
  const int r16 = lane & 15, q4 = lane >> 4;
  const int t0 = cgi * 64;
  const int row8 = tid >> 3, kc = tid & 7;
  const bf16_t* outb = (const bf16_t*)p.out;
  u4 ld[10];
  {
    const long qoff = (long)(t0 + row8) * 256 + hh * 64 + kc * 8;
    ld[0] = *(const u4*)((const bf16_t*)((const char*)outb + OUT_QEF) + qoff);
    ld[1] = *(const u4*)((const bf16_t*)((const char*)outb + OUT_KEF) + qoff);
    ld[4] = *(const u4*)((const bf16_t*)((const char*)outb + OUT_QEB) + qoff);
    ld[5] = *(const u4*)((const bf16_t*)((const char*)outb + OUT_KEB) + qoff);
    const bf16_t* S0 = (const bf16_t*)(p.ws + OFF_UBUF) + (long)((cgi * 4 + hh) * 2) * 8192 + row8 * 64 + kc * 8;
    ld[2] = *(const u4*)(S0);
    ld[3] = *(const u4*)(S0 + 64 * 64);
    ld[6] = *(const u4*)(S0 + 8192);
    ld[7] = *(const u4*)(S0 + 8192 + 64 * 64);
    const bf16_t* gvt = (const bf16_t*)(p.ws + OFF_GV) + (long)(hh * 128 + row8) * T + t0 + kc * 8;
    ld[8] = *(const u4*)(gvt);
    ld[9] = *(const u4*)(gvt + (long)64 * T);
  }
  __syncthreads();
  {
    const int so = row8 * GROW + kc * 16;
    *(u4*)(smem + O_QE + so) = ld[0];
    *(u4*)(smem + O_KE + so) = ld[1];
    *(u4*)(smem + O_S + so) = ld[2];
    *(u4*)(smem + O_S + 64 * GROW + so) = ld[3];
    *(u4*)(smem + DIRB + O_QE + so) = ld[4];
    *(u4*)(smem + DIRB + O_KE + so) = ld[5];
    *(u4*)(smem + DIRB + O_S + so) = ld[6];
    *(u4*)(smem + DIRB + O_S + 64 * GROW + so) = ld[7];
    *(u4*)(smem + O_VT + so) = ld[8];
    *(u4*)(smem + O_VT + 64 * GROW + so) = ld[9];
  }
  __syncthreads();
  const char* base = smem + dir * DIRB;
  f32x4 o[8];
#pragma unroll
  for (int j = 0; j < 8; ++j) o[j] = f32x4{0.f, 0.f, 0.f, 0.f};
  bf16x8 qf[2];
#pragma unroll
  for (int ks = 0; ks < 2; ++ks) qf[ks] = *(const bf16x8*)(base + O_QE + (16 * slab + r16) * GROW + (ks * 32 + q4 * 8) * 2);
  {
    f32x4 a[4];
#pragma unroll
    for (int j = 0; j < 4; ++j) a[j] = f32x4{0.f, 0.f, 0.f, 0.f};
#pragma unroll
    for (int ks = 0; ks < 2; ++ks)
#pragma unroll
      for (int j = 0; j < 4; ++j) {
        bf16x8 kf = *(const bf16x8*)(base + O_KE + (16 * j + r16) * GROW + (ks * 32 + q4 * 8) * 2);
        a[j] = __builtin_amdgcn_mfma_f32_16x16x32_bf16(qf[ks], kf, a[j], 0, 0, 0);
      }
    bf16_t* As = (bf16_t*)(smem + O_AS + dir * 9216);
#pragma unroll
    for (int j = 0; j < 4; ++j)
#pragma unroll
      for (int r = 0; r < 4; ++r) {
        int i = 16 * slab + 4 * q4 + r, jj = 16 * j + r16;
        bool keep = dir ? (jj >= i) : (jj <= i);
        As[i * 72 + jj] = f2b(keep ? a[j][r] : 0.f);
      }
  }
  __builtin_amdgcn_wave_barrier();
  asm volatile("s_waitcnt lgkmcnt(0)" ::: "memory");
#pragma unroll
  for (int ks = 0; ks < 2; ++ks) {
    bf16x8 af = *(const bf16x8*)(smem + O_AS + dir * 9216 + (16 * slab + r16) * GROW + (ks * 32 + q4 * 8) * 2);
#pragma unroll
    for (int j = 0; j < 8; ++j) {
      bf16x8 vf = *(const bf16x8*)(smem + O_VT + (16 * j + r16) * GROW + (ks * 32 + q4 * 8) * 2);
      o[j] = __builtin_amdgcn_mfma_f32_16x16x32_bf16(af, vf, o[j], 0, 0, 0);
      bf16x8 sf = *(const bf16x8*)(base + O_S + (16 * j + r16) * GROW + (ks * 32 + q4 * 8) * 2);
      o[j] = __builtin_amdgcn_mfma_f32_16x16x32_bf16(qf[ks], sf, o[j], 0, 0, 0);
    }
  }
  __syncthreads();
  float* ob = (float*)smem;
  if (dir == 1) {
#pragma unroll
    for (int j = 0; j < 8; ++j)
#pragma unroll
      for (int r = 0; r < 4; ++r) ob[(16 * slab + 4 * q4 + r) * 132 + 16 * j + r16] = o[j][r];
  }
  float gv[8][4];
  if (dir == 0) {
    const bf16_t* og = (const bf16_t*)(p.ws + OFF_OG);
#pragma unroll
    for (int j = 0; j < 8; ++j)
#pragma unroll
      for (int r = 0; r < 4; ++r) gv[j][r] = b2f(og[(long)(t0 + 16 * slab + 4 * q4 + r) * 512 + hh * 128 + 16 * j + r16]);
  }
  __syncthreads();
  if (dir == 0) {
#pragma unroll
    for (int j = 0; j < 8; ++j)
#pragma unroll
      for (int r = 0; r < 4; ++r) o[j][r] += ob[(16 * slab + 4 * q4 + r) * 132 + 16 * j + r16];
    float ss[4];
#pragma unroll
    for (int r = 0; r < 4; ++r) {
      float sq = 0.f;
#pragma unroll
      for (int j = 0; j < 8; ++j) sq += o[j][r] * o[j][r];
      sq += __shfl_xor(sq, 1); sq += __shfl_xor(sq, 2); sq += __shfl_xor(sq, 4); sq += __shfl_xor(sq, 8);
      ss[r] = rsqrtf(sq * (1.f / 128.f) + EPS);
    }
    bf16_t* mixin = (bf16_t*)(p.ws + OFF_MIXIN);
#pragma unroll
    for (int j = 0; j < 8; ++j) {
      const int v = 16 * j + r16;
      const float gw = p.gla_norm_w[v];
#pragma unroll
      for (int r = 0; r < 4; ++r) {
        const int tok = t0 + 16 * slab + 4 * q4 + r;
        float g = gv[j][r];
        float val = o[j][r] * ss[r] * gw * (g / (1.f + fexp(-g)));
        mixin[(long)tok * 1024 + hh * 128 + v] = f2b(val);
      }
    }
  }
}

DI void gla_scan_item(const P& p, int cbase, int nch, int hh, int dir, int sub) {
  const int e = (sub * 256 + VT) * 2;
  const int d = e & 63;
  bf16_t* U = (bf16_t*)(p.ws + OFF_UBUF);
  const float* dec = (const float*)(p.ws + OFF_DEC);
  float st0 = 0.f, st1 = 0.f;
  for (int n0 = 0; n0 < nch; n0 += 32) {
    unsigned u[32]; u2 dc[32];
#pragma unroll
    for (int j = 0; j < 32; ++j) {
      int n = n0 + j;
      int cgi = cbase + (dir ? nch - 1 - n : n);
      long base = (long)((cgi * 4 + hh) * 2 + dir);
      u[j] = *(const unsigned*)(U + base * 8192 + e);
      dc[j] = *(const u2*)(dec + base * 64 + d);
    }
#pragma unroll
    for (int j = 0; j < 32; ++j) {
      int n = n0 + j;
      int cgi = cbase + (dir ? nch - 1 - n : n);
      long base = (long)((cgi * 4 + hh) * 2 + dir);
      *(unsigned*)(U + base * 8192 + e) = pk2(st0, st1);
      st0 = __uint_as_float(dc[j].x) * st0 + blo(u[j]);
      st1 = __uint_as_float(dc[j].y) * st1 + bhi(u[j]);
    }
  }
}

DI void phase_rope_g1(const P& p, char* smem) {
  _Pragma("nounroll") for (int rp = 0; rp < REPG1; ++rp)
  for (int b0 = 0; b0 < NCHUNK * 4; b0 += VN) { int it = min(b0 + VB, NCHUNK * 4 - 1); gla_g1_item(p, it >> 2, it & 3, smem); }
}

DI void phase_attn_scan(const P& p, char* smem_block, int rep) {
  const int NSCAN_P = 128, NSCAN_S = 4096, NATT_P = 512, NATT_S = 2048;
  const float c = 0.125f * LOG2E;
  if (!rep) {
    for (int it = VB; it < NSCAN_P + NSCAN_S; it += VN) {
      if (it < NSCAN_P) {
        int sub = it & 15, ch = it >> 4;
        gla_scan_item(p, 0, 256, ch >> 1, ch & 1, sub);
      } else {
        int i2 = it - NSCAN_P;
        int sub = i2 & 15, ch = i2 >> 4;
        int sq = ch >> 3;
        gla_scan_item(p, 256 + sq * 32, 32, (ch >> 1) & 3, ch & 1, sub);
      }
    }
  }
  for (int i3 = blockIdx.x; i3 < NATT_P + NATT_S; i3 += gridDim.x) {
    int vh, qb, sq, nkeys;
    if (i3 < NATT_P) { vh = i3 & 7; qb = i3 >> 3; sq = 0; nkeys = TP; }
    else { int i4 = i3 - NATT_P; vh = i4 & 7; int rest = i4 >> 3; qb = rest & 7; sq = 1 + (rest >> 3); nkeys = SS; }
    const int ts = seq_start(sq);
    const int tq = ts + qb * 256;
    const bf16_t* Q = (const bf16_t*)(p.ws + OFF_DQ) + (long)tq * 512 + vh * 64;
    const bf16_t* K = (const bf16_t*)(p.ws + OFF_DK) + (long)ts * 512 + vh * 64;
    const bf16_t* Vt = (const bf16_t*)(p.ws + OFF_DVT) + (long)((vh >> 1) * 128) * T + ts;
    bf16_t* O = (bf16_t*)(p.ws + OFF_ODIFF) + (long)tq * 1024 + vh * 128;
    flash256_item<64>(Q, 512, K, 512, Vt, (long)T, nkeys, c, O, 1024, smem_block);
  }
}

DI void phase_g3_combine(const P& p, char* smem_block) {
  _Pragma("nounroll") for (int rp = 0; rp < REPG3; ++rp)
  for (int it = blockIdx.x; it < NCHUNK * 4; it += gridDim.x) gla_g3_block(p, it >> 2, it & 3, smem_block);
  const int lane = VT & 63;
  float lam;
  {
    float a = p.lq1[lane] * p.lk1[lane], b = p.lq2[lane] * p.lk2[lane];
    a = wave_sum(a); b = wave_sum(b);
    lam = expf(a) - expf(b) + 0.2f;
  }
  const float post = 1.f - 0.2f;
  const bf16_t* od = (const bf16_t*)(p.ws + OFF_ODIFF);
  bf16_t* mixin = (bf16_t*)(p.ws + OFF_MIXIN);
  const int hh = lane >> 4, c8 = (lane & 15) * 8;
  float sw[8];
#pragma unroll
  for (int j = 0; j < 8; ++j) sw[j] = p.subln_w[c8 + j] * post;
  _Pragma("nounroll") for (int rp = 0; rp < REPCMB; ++rp)
  for (int t = VB * 4 + (VT >> 6); t < T; t += VN * 4) {
    u4 a = *(const u4*)(od + (long)t * 1024 + (hh * 2) * 128 + c8);
    u4 b = *(const u4*)(od + (long)t * 1024 + (hh * 2 + 1) * 128 + c8);
    float v[8];
    v[0] = blo(a.x) - lam * blo(b.x); v[1] = bhi(a.x) - lam * bhi(b.x);
    v[2] = blo(a.y) - lam * blo(b.y); v[3] = bhi(a.y) - lam * bhi(b.y);
    v[4] = blo(a.z) - lam * blo(b.z); v[5] = bhi(a.z) - lam * bhi(b.z);
    v[6] = blo(a.w) - lam * blo(b.w); v[7] = bhi(a.w) - lam * bhi(b.w);
    float s = 0.f;
#pragma unroll
    for (int j = 0; j < 8; ++j) s += v[j] * v[j];
    s += __shfl_xor(s, 1); s += __shfl_xor(s, 2); s += __shfl_xor(s, 4); s += __shfl_xor(s, 8);
    float rs = rsqrtf(s * (1.f / 128.f) + EPS);
    u4 pk;
    pk.x = pk2(v[0] * rs * sw[0], v[1] * rs * sw[1]);
    pk.y = pk2(v[2] * rs * sw[2], v[3] * rs * sw[3]);
    pk.z = pk2(v[4] * rs * sw[4], v[5] * rs * sw[5]);
    pk.w = pk2(v[6] * rs * sw[6], v[7] * rs * sw[7]);
    *(u4*)(mixin + (long)t * 1024 + 512 + hh * 128 + c8) = pk;
  }
}

template <int WHICH>
DI void phase_rows(const P& p) {
  const int lane = VT & 63;
  const bf16_t* mix = (const bf16_t*)(p.ws + OFF_MIX);
  bf16_t* hb = (bf16_t*)(p.ws + OFF_HBUF);
  for (int tg = VB * 4 + (VT >> 6); tg < T / NR; tg += VN * 4) {
    const int t = tg * NR;
    char* xo = (char*)(p.out + (long)t * 1024);
    char* xres = xo + 2048;
    const bf16_t* m = mix + (long)t * 1024;
    bf16_t* h = hb + (long)t * 1024;
    if (WHICH == 0) {
      const float* xin = t < TP ? p.xp + (long)t * 1024 : p.xs + (long)(t - TP) * 1024;
      row_resid_xn<true, false>((const char*)xin, 4096, m, p.norm_mix_post, p.norm_x_pre, xres, 4096, h, lane);
    } else if (WHICH == 1) {
      row_resid_xn<false, false>(xres, 4096, m, p.norm_x_post, p.norm_f_pre, xres, 4096, h, lane);
    } else {
      row_resid_xn<false, true>(xres, 4096, m, p.norm_f_post, nullptr, xo, 4096, nullptr, lane);
    }
  }
}

DI void phase_xq_xattn(const P& p, char* smem) {
  char* ws = p.ws;
  const bf16_t* A = (const bf16_t*)(ws + OFF_HBUF);
  const bf16_t* B = (const bf16_t*)(ws + OFF_WXQ);
  const float c = 0.0625f * LOG2E;
  for (int L = blockIdx.x; L < (T / 256) * 4; L += gridDim.x) {
    int tidx = threadIdx.x;
    asm volatile("" : "+v"(tidx));
    const int wid = __builtin_amdgcn_readfirstlane(tidx >> 6), lane = tidx & 63, wr = wid >> 2, wc = wid & 3;
    int fr = lane & 15, fq = lane >> 4;
    int pm, pn;
    g8_unit(L, T / 256, 4, pm, pn);
    const int m0 = pm * 256;
    bf16x8 qf[16];
    {
      f32x4 acc[2][2][4][2];
      g8_tile<true>(A, B, 1024, m0, pn * 256, (bf16_t*)smem, acc, tidx, false);
      asm volatile("" : "+v"(fr), "+v"(fq));
#pragma unroll
      for (int ai = 0; ai < 2; ++ai)
#pragma unroll
        for (int bj = 0; bj < 2; ++bj)
#pragma unroll
          for (int m = 0; m < 4; ++m)
#pragma unroll
            for (int n = 0; n < 2; ++n) {
              const int row = ai * 128 + wr * 64 + m * 16 + fr;
              f32x4 v = acc[ai][bj][m][n];
              u2 pk; pk.x = pk2(v[0], v[1]); pk.y = pk2(v[2], v[3]);
              const int chunk = bj * 16 + wc * 4 + n * 2 + (fq >> 1);
              *(u2*)(smem + row * 512 + ((chunk ^ (row & 31)) << 4) + (fq & 1) * 8) = pk;
            }
    }
    __syncthreads();
    {
      const int row = wid * 32 + (lane & 31), hh = lane >> 5;
#pragma unroll
      for (int ks = 0; ks < 16; ++ks) qf[ks] = *(const bf16x8*)(smem + row * 512 + (((2 * ks + hh) ^ (row & 31)) << 4));
    }
    __syncthreads();
    const int sq = seq_of_token(m0);
    const bf16_t* K = (const bf16_t*)(ws + OFF_KX) + (long)(sq * 256) * 1024 + pn * 256;
#pragma unroll
    for (int half = 0; half < 2; ++half) {
      const bf16_t* Vt = (const bf16_t*)(ws + OFF_VXT) + (long)(pn * 256 + half * 128) * MT + sq * 256;
      bf16_t* O = (bf16_t*)(ws + OFF_XOIN) + (long)m0 * 1024 + pn * 256 + half * 128;
      flash256x_core<256>(qf, K, 1024, Vt, (long)MT, 256, c, O, 1024, smem);
    }
  }
}

constexpr int NPH = 14;

#define XB_TMO      128
#define XB_XCNT(j)  (256  + 64 * (j))
#define XB_XSUB(j)  (1280 + 64 * (j))
#define XB_XGEN(j)  (2304 + 64 * (j))
#define XB_TOP      3328
#define XB_TOPGEN   3392
#define XCD_BAR_WORDS 3456
#define XB_SPIN_CAP (1u << 18)
#define LAS __attribute__((address_space(3)))

__device__ __forceinline__ unsigned xb_ld(unsigned* p)              { return __hip_atomic_load(p, __ATOMIC_RELAXED, __HIP_MEMORY_SCOPE_AGENT); }
__device__ __forceinline__ unsigned xb_add(unsigned* p, unsigned v) { return __hip_atomic_fetch_add(p, v, __ATOMIC_RELAXED, __HIP_MEMORY_SCOPE_AGENT); }
__device__ __forceinline__ unsigned xb_xcc_id() { return (unsigned)__builtin_amdgcn_s_getreg((3 << 11) | 20) & 0xFu; }
#define XB_SPIN(cond, bar) do { unsigned _sp = 0; while (cond) { __builtin_amdgcn_s_sleep(1); \
    if ((++_sp & 255u) == 0u) { if (xb_ld(&(bar)[XB_TMO])) break; if (_sp > XB_SPIN_CAP) { atomicAdd(&(bar)[XB_TMO], 1u); break; } } } } while (0)

struct XcdBarrier {
    unsigned* bar; unsigned x;
    volatile LAS unsigned* st;
};

__device__ __forceinline__ XcdBarrier xcd_barrier_post(unsigned* bar, volatile LAS unsigned* st) {
    XcdBarrier b; b.bar = bar; b.x = xb_xcc_id(); b.st = st;
    if (threadIdx.x == 0) (void)xb_add(&bar[XB_XCNT(b.x)], 1u);
    return b;
}
__device__ __forceinline__ void xcd_barrier_complete(unsigned* bar, unsigned x, unsigned& nloc, unsigned& nx) {
    const unsigned G = gridDim.x * gridDim.y * gridDim.z;
    unsigned sum, cnt, mine, sp = 0u;
    for (;;) {
        sum = 0u; cnt = 0u; mine = 0u;
#pragma unroll
        for (unsigned j = 0; j < 16; ++j) { const unsigned c = xb_ld(&bar[XB_XCNT(j)]); sum += c; cnt += (c > 0u) ? 1u : 0u; mine = (j == x) ? c : mine; }
        if (sum == G) break;
        __builtin_amdgcn_s_sleep(1);
        if ((++sp & 255u) == 0u) { if (xb_ld(&bar[XB_TMO])) break; if (sp > XB_SPIN_CAP) { atomicAdd(&bar[XB_TMO], 1u); break; } }
    }
    nloc = mine > 0u ? mine : 1u; nx = cnt > 0u ? cnt : 1u;
}

__device__ __forceinline__ void xcd_barrier(const XcdBarrier& b) {
    asm volatile("s_waitcnt vmcnt(0)" ::: "memory");
    __syncthreads();
    if (threadIdx.x == 0) {
        unsigned* bar = b.bar;
        __builtin_amdgcn_s_waitcnt(0);
        unsigned nloc = b.st[0], nx = b.st[1];
        if (nloc == 0u) { xcd_barrier_complete(bar, b.x, nloc, nx); b.st[0] = nloc; b.st[1] = nx; }
        const unsigned old = xb_add(&bar[XB_XSUB(b.x)], 1u);
        const unsigned gen = old / nloc;
        if (old + 1u == (gen + 1u) * nloc) {
            __builtin_amdgcn_fence(__ATOMIC_RELEASE, "agent");
            asm volatile("s_waitcnt vmcnt(0)" ::: "memory");
            const unsigned og = xb_add(&bar[XB_TOP], 1u);
            const unsigned tg = og / nx;
            if (og + 1u == (tg + 1u) * nx) xb_add(&bar[XB_TOPGEN], 1u);
            else XB_SPIN(xb_ld(&bar[XB_TOPGEN]) == tg, bar);
            __builtin_amdgcn_fence(__ATOMIC_ACQUIRE, "agent");
            xb_add(&bar[XB_XGEN(b.x)], 1u);
            asm volatile("s_waitcnt vmcnt(0)" ::: "memory");
        } else {
            XB_SPIN(xb_ld(&bar[XB_XGEN(b.x)]) == gen, bar);
            __builtin_amdgcn_fence(__ATOMIC_ACQUIRE, "agent");
            asm volatile("s_waitcnt vmcnt(0)" ::: "memory");
        }
    }
    __syncthreads();
}


DI unsigned long long uni64(unsigned long long v) {
  unsigned lo = __builtin_amdgcn_readfirstlane((unsigned)v), hi = __builtin_amdgcn_readfirstlane((unsigned)(v >> 32));
  return ((unsigned long long)hi << 32) | lo;
}
#define UNI_F(field) lp.field = (const float*)(const __attribute__((address_space(1))) float*)uni64((unsigned long long)lp.field);
DI void uniformize(P& lp) {
  UNI_F(xp) UNI_F(xs) UNI_F(memp) UNI_F(mems)
  UNI_F(norm_mix_pre) UNI_F(w_in) UNI_F(w_gu_f) UNI_F(b_g_f) UNI_F(w_gu_b) UNI_F(b_g_b) UNI_F(gla_norm_w)
  UNI_F(lq1) UNI_F(lk1) UNI_F(lq2) UNI_F(lk2) UNI_F(subln_w) UNI_F(w_out) UNI_F(norm_mix_post) UNI_F(norm_x_pre) UNI_F(norm_mem)
  UNI_F(w_xq) UNI_F(w_xkv) UNI_F(w_xo) UNI_F(norm_x_post) UNI_F(norm_f_pre) UNI_F(w_fg) UNI_F(w_fu) UNI_F(w_fd) UNI_F(norm_f_post)
  lp.out = (float*)(__attribute__((address_space(1))) float*)uni64((unsigned long long)lp.out);
  lp.ws = (char*)(__attribute__((address_space(1))) char*)uni64((unsigned long long)lp.ws);
}

template <int PH>
DI void run_phase(const P& p, char* smem, int rep) {
  char* ws = p.ws;
  if constexpr (PH == 0) phase_prep(p, smem + (threadIdx.x >> 8) * 65536);
  else if constexpr (PH == 2) phase_rope_g1(p, smem + (threadIdx.x >> 8) * 65536);
  else if constexpr (PH == 3) phase_attn_scan(p, smem, rep);
  else if constexpr (PH == 4) phase_g3_combine(p, smem);
  else if constexpr (PH == 6) phase_rows<0>(p);
  else if constexpr (PH == 8) {   }
  else if constexpr (PH == 10) phase_rows<1>(p);
  else if constexpr (PH == 13) phase_rows<2>(p);
  else if constexpr (PH == 1) {
    const Job j0{(const bf16_t*)(ws + OFF_HBUF), (const bf16_t*)(ws + OFF_WIN), nullptr, 1024, T / 256, NIN / 256, 0};
    const Job j1{(const bf16_t*)(ws + OFF_MBUF), (const bf16_t*)(ws + OFF_WXKV), nullptr, 1024, MT / 256, 8, 1};
    const int n0 = j0.mtiles * j0.ntiles, n1 = j1.mtiles * j1.ntiles;
    const int G = gridDim.x;
    bool pre = false;
    for (int L = blockIdx.x; L < n0 + n1; L += G) {
      const bool first = L < n0;
      Job jb;
      jb.A = first ? j0.A : j1.A; jb.B = first ? j0.B : j1.B; jb.dst = nullptr; jb.K = 1024;
      jb.mtiles = first ? j0.mtiles : j1.mtiles; jb.ntiles = first ? j0.ntiles : j1.ntiles; jb.mode = first ? 0 : 1;
      const int L2 = L + G;
      const bool hn = L2 < n0 + n1;
      const bool first2 = L2 < n0;
      Job jn;
      jn.A = first2 ? j0.A : j1.A; jn.B = first2 ? j0.B : j1.B; jn.dst = nullptr; jn.K = 1024;
      jn.mtiles = first2 ? j0.mtiles : j1.mtiles; jn.ntiles = first2 ? j0.ntiles : j1.ntiles; jn.mode = first2 ? 0 : 1;
      run_gemm_unit(p, jb, first ? L : L - n0, smem, pre, hn, jn, first2 ? L2 : L2 - n0);
      pre = hn;
    }
  }
  else if constexpr (PH == 5) run_gemm_job(p, Job{(const bf16_t*)(ws + OFF_MIXIN), (const bf16_t*)(ws + OFF_WOUT), (bf16_t*)(ws + OFF_MIX), 1024, T / 256, 4, 2}, smem);
  else if constexpr (PH == 7) phase_xq_xattn(p, smem);
  else if constexpr (PH == 9) run_gemm_job(p, Job{(const bf16_t*)(ws + OFF_XOIN), (const bf16_t*)(ws + OFF_WXO), (bf16_t*)(ws + OFF_MIX), 1024, T / 256, 4, 2}, smem);
  else if constexpr (PH == 11) run_gemm_job(p, Job{(const bf16_t*)(ws + OFF_HBUF), (const bf16_t*)(ws + OFF_WGU), (bf16_t*)(ws + OFF_ACT), 1024, T / 256, 22, 3}, smem);
  else if constexpr (PH == 12) run_gemm_job(p, Job{(const bf16_t*)(ws + OFF_ACT), (const bf16_t*)(ws + OFF_WDN), (bf16_t*)(ws + OFF_MIX), DFF, T / 256, 4, 2}, smem);
}

constexpr int LDS_BYTES = 131072;
__global__ void __launch_bounds__(512, 2) mega(P p, int ph_lo, int ph_hi) {
  extern __shared__ __attribute__((aligned(16))) char smem[];
  __shared__ u4 xb_words;
  if (threadIdx.x == 0) xb_words = u4{0u, 0u, 0u, 0u};
  __syncthreads();
  XcdBarrier xb = xcd_barrier_post((unsigned*)(p.ws + OFF_BAR), (volatile LAS unsigned*)&xb_words);
  if (ph_lo < 0) cg::this_grid().sync();
#define PHASE(n)                                          \
  if (PHSEL < 0 || PHSEL == n) {                          \
    if (ph_lo <= n && n < ph_hi) {                        \
      if (n > ph_lo) xcd_barrier(xb);                     \
      if (n == 1) { _Pragma("nounroll") for (int xs = 0; xs < XSYNC; ++xs) xcd_barrier(xb); } \
      const __attribute__((address_space(4))) char* kp = (const __attribute__((address_space(4))) char*)__builtin_amdgcn_kernarg_segment_ptr(); \
      asm volatile("" : "+s"(kp));                        \
      P lp;                                               \
      __builtin_memcpy(&lp, kp, sizeof(P));               \
      uniformize(lp);                                     \
      _Pragma("nounroll") for (int rep = 0; rep < (((REPMASK >> n) & 1) ? 2 : 1); ++rep) run_phase<n>(lp, smem, rep); \
    }                                                     \
  }
  PHASE(0) PHASE(1) PHASE(2) PHASE(3) PHASE(4) PHASE(5) PHASE(6) PHASE(7) PHASE(9) PHASE(10) PHASE(11) PHASE(12) PHASE(13)
}

extern "C" void kernel_launch(void* const* d_in, const int* in_sizes, int n_in, void* d_out, int out_size, void* d_ws,
                              size_t ws_size, hipStream_t stream) {
  static int grid_blocks = 0;
  if (!grid_blocks) {
    int dev = 0, cus = 0, per_cu = 0;
    hipGetDevice(&dev);
    hipDeviceGetAttribute(&cus, hipDeviceAttributeMultiprocessorCount, dev);
    hipFuncSetAttribute((const void*)mega, hipFuncAttributeMaxDynamicSharedMemorySize, LDS_BYTES);
    hipOccupancyMaxActiveBlocksPerMultiprocessor(&per_cu, mega, 512, LDS_BYTES);
    if (per_cu < 1) per_cu = 1;
    grid_blocks = cus * per_cu;
  }
  P p{};
  const float** f = (const float**)&p;
  for (int i = 0; i < 29; ++i) f[i] = (const float*)d_in[i];
  p.out = (float*)d_out;
  p.ws = (char*)d_ws;
#if MEGA
  hipMemsetAsync((char*)d_ws + OFF_BAR, 0, 16384, stream);
  int lo = 0, hi = NPH;
  void* args[] = {&p, &lo, &hi};
  hipError_t e = hipLaunchCooperativeKernel((void*)mega, dim3(grid_blocks), dim3(512), args, LDS_BYTES, stream);
  if (e != hipSuccess) fprintf(stderr, "cooperative launch failed: %s (grid %d)\n", hipGetErrorString(e), grid_blocks);
#else
  for (int ph = 0; ph < NPH; ++ph) hipLaunchKernelGGL(mega, dim3(grid_blocks), dim3(512), LDS_BYTES, stream, p, ph, ph + 1);
#endif
}
```

```cpp
#include <hip/hip_runtime.h>
#include <hip/hip_cooperative_groups.h>
#include <stdint.h>
#include <cstdio>
namespace cg = cooperative_groups;

#ifndef MEGA
#define MEGA 1
#endif
#ifndef PHSEL
#define PHSEL -1
#endif
#ifndef REPMASK
#define REPMASK 0
#endif
#ifndef REPG3
#define REPG3 1
#endif
#ifndef REPG1
#define REPG1 1
#endif
#ifndef XSYNC
#define XSYNC 0
#endif
#ifndef REPCMB
#define REPCMB 1
#endif

typedef unsigned short bf16_t;
using bf16x8 = __attribute__((ext_vector_type(8))) short;
using bf16x4 = __attribute__((ext_vector_type(4))) short;
using f32x4 = __attribute__((ext_vector_type(4))) float;
using u4 = __attribute__((ext_vector_type(4))) unsigned;
using u2 = __attribute__((ext_vector_type(2))) unsigned;
using f4 = __attribute__((ext_vector_type(4))) float;
using f32x16 = __attribute__((ext_vector_type(16))) float;
typedef __attribute__((ext_vector_type(2))) __bf16 bf2_t;
#define DI __device__ __forceinline__
#define VT ((int)(threadIdx.x & 255))
#define VB ((int)(blockIdx.x * 2 + (threadIdx.x >> 8)))
#define VN ((int)(gridDim.x * 2))

DI unsigned pk2(float a, float b) { bf2_t v; v[0] = (__bf16)a; v[1] = (__bf16)b; return __builtin_bit_cast(unsigned, v); }
DI bf16_t f2b(float a) { return __builtin_bit_cast(unsigned short, (__bf16)a); }
DI float b2f(unsigned b) { return __uint_as_float(b << 16); }
DI float blo(unsigned u) { return __uint_as_float(u << 16); }
DI float bhi(unsigned u) { return __uint_as_float(u & 0xffff0000u); }
DI float half_swap_max(float x) {
  auto rr = __builtin_amdgcn_permlane32_swap(__float_as_uint(x), __float_as_uint(x), false, false);
  return fmaxf(__uint_as_float(rr[0]), __uint_as_float(rr[1]));
}
DI float half_swap_sum(float x) {
  auto rr = __builtin_amdgcn_permlane32_swap(__float_as_uint(x), __float_as_uint(x), false, false);
  return __uint_as_float(rr[0]) + __uint_as_float(rr[1]);
}
DI float wave_sum(float v) {
#pragma unroll
  for (int o = 32; o > 0; o >>= 1) v += __shfl_xor(v, o);
  return v;
}

constexpr int T = 81920, TP = 16384, SS = 2048, D = 1024, MT = 8448, DFF = 2816;
constexpr int NCHUNK = T / 64;
constexpr int NIN = 3328;
constexpr float EPS = 1e-6f;
constexpr float LOG2E = 1.4426950408889634f;

constexpr size_t OFF_WIN = 0;
constexpr size_t OFF_WOUT = OFF_WIN + (size_t)NIN * 1024 * 2;
constexpr size_t OFF_WXQ = OFF_WOUT + 1024 * 1024 * 2;
constexpr size_t OFF_WXO = OFF_WXQ + 1024 * 1024 * 2;
constexpr size_t OFF_WXKV = OFF_WXO + 1024 * 1024 * 2;
constexpr size_t OFF_WGU = OFF_WXKV + 2048 * 1024 * 2;
constexpr size_t OFF_WDN = OFF_WGU + (size_t)5632 * 1024 * 2;
constexpr size_t OFF_HBUF = OFF_WDN + (size_t)1024 * 2816 * 2;
constexpr size_t OFF_GQ = OFF_HBUF + (size_t)T * 1024 * 2;
constexpr size_t OFF_GK = OFF_GQ + (size_t)T * 256 * 2;
constexpr size_t OFF_GV = OFF_GK + (size_t)T * 256 * 2;
constexpr size_t OFF_OG = OFF_GV + (size_t)T * 512 * 2;
constexpr size_t OFF_DQ = OFF_OG + (size_t)T * 512 * 2;
constexpr size_t OFF_DK = OFF_DQ + (size_t)T * 512 * 2;
constexpr size_t OFF_DVT = OFF_DK + (size_t)T * 512 * 2;
constexpr size_t OFF_GATES = OFF_DVT + (size_t)T * 512 * 2;
constexpr size_t OFF_UBUF = OFF_GATES + (size_t)T * 32 * 4;
constexpr size_t OFF_DEC = OFF_UBUF + (size_t)NCHUNK * 4 * 2 * 8192 * 2;
constexpr size_t OFF_MBUF = OFF_DEC + (size_t)NCHUNK * 4 * 2 * 64 * 4;
constexpr size_t OFF_KX = OFF_MBUF + (size_t)MT * 1024 * 2;
constexpr size_t OFF_VXT = OFF_KX + (size_t)MT * 1024 * 2;
constexpr size_t OFF_BAR = OFF_VXT + (size_t)MT * 1024 * 2;
constexpr size_t WS_END = OFF_BAR + 16384;
constexpr size_t OUT_QEF = 0;
constexpr size_t OUT_KEF = OUT_QEF + (size_t)T * 256 * 2;
constexpr size_t OUT_QEB = OUT_KEF + (size_t)T * 256 * 2;
constexpr size_t OUT_KEB = OUT_QEB + (size_t)T * 256 * 2;
constexpr size_t OFF_ODIFF = OFF_HBUF;
constexpr size_t OFF_MIXIN = OFF_DQ;
constexpr size_t OFF_MIX = OFF_UBUF;
constexpr size_t OFF_QX = OFF_MIXIN;
constexpr size_t OFF_XOIN = OFF_GQ;
constexpr size_t OFF_ACT = OFF_GQ;

struct P {
  const float *xp, *xs, *memp, *mems;
  const float *norm_mix_pre, *w_in, *w_gu_f, *b_g_f, *w_gu_b, *b_g_b, *gla_norm_w;
  const float *lq1, *lk1, *lq2, *lk2, *subln_w, *w_out, *norm_mix_post, *norm_x_pre, *norm_mem;
  const float *w_xq, *w_xkv, *w_xo, *norm_x_post, *norm_f_pre, *w_fg, *w_fu, *w_fd, *norm_f_post;
  float* out;
  char* ws;
};

DI int seq_start(int s) { return s == 0 ? 0 : TP + (s - 1) * SS; }
DI int seq_of_token(int t) { return t < TP ? 0 : 1 + (t - TP) / SS; }

DI void row_norm_bf16(const float* __restrict__ x, const float* __restrict__ w, bf16_t* __restrict__ out, int lane) {
  f4 v[4];
  float ss = 0.f;
#pragma unroll
  for (int i = 0; i < 4; ++i) {
    v[i] = ((const f4*)x)[i * 64 + lane];
    ss += v[i].x * v[i].x + v[i].y * v[i].y + v[i].z * v[i].z + v[i].w * v[i].w;
  }
  ss = wave_sum(ss);
  float rs = rsqrtf(ss * (1.f / 1024.f) + EPS);
#pragma unroll
  for (int i = 0; i < 4; ++i) {
    f4 ww = ((const f4*)w)[i * 64 + lane];
    u2 pk;
    pk.x = pk2(v[i].x * rs * ww.x, v[i].y * rs * ww.y);
    pk.y = pk2(v[i].z * rs * ww.z, v[i].w * rs * ww.w);
    ((u2*)out)[i * 64 + lane] = pk;
  }
}

template <bool XIN_F32, bool LAST>
DI void row_resid(const void* xin, const bf16_t* __restrict__ mix, const float* __restrict__ wpost,
                  const float* __restrict__ wnext, void* xout, bf16_t* __restrict__ hout, int lane) {
  f4 x[4], m[4];
  float ss = 0.f;
#pragma unroll
  for (int i = 0; i < 4; ++i) {
    if (XIN_F32) x[i] = ((const f4*)xin)[i * 64 + lane];
    else { u2 xu = ((const u2*)xin)[i * 64 + lane]; x[i].x = blo(xu.x); x[i].y = bhi(xu.x); x[i].z = blo(xu.y); x[i].w = bhi(xu.y); }
    u2 u = ((const u2*)mix)[i * 64 + lane];
    m[i].x = blo(u.x); m[i].y = bhi(u.x); m[i].z = blo(u.y); m[i].w = bhi(u.y);
    ss += m[i].x * m[i].x + m[i].y * m[i].y + m[i].z * m[i].z + m[i].w * m[i].w;
  }
  ss = wave_sum(ss);
  float rs = rsqrtf(ss * (1.f / 1024.f) + EPS);
  float ss1 = 0.f;
#pragma unroll
  for (int i = 0; i < 4; ++i) {
    f4 ww = ((const f4*)wpost)[i * 64 + lane];
    x[i].x += m[i].x * rs * ww.x; x[i].y += m[i].y * rs * ww.y;
    x[i].z += m[i].z * rs * ww.z; x[i].w += m[i].w * rs * ww.w;
    ss1 += x[i].x * x[i].x + x[i].y * x[i].y + x[i].z * x[i].z + x[i].w * x[i].w;
  }
  if (LAST) {
#pragma unroll
    for (int i = 0; i < 4; ++i) ((f4*)xout)[i * 64 + lane] = x[i];
  } else {
#pragma unroll
    for (int i = 0; i < 4; ++i) {
      u2 pk; pk.x = pk2(x[i].x, x[i].y); pk.y = pk2(x[i].z, x[i].w);
      ((u2*)xout)[i * 64 + lane] = pk;
    }
    ss1 = wave_sum(ss1);
    float rs1 = rsqrtf(ss1 * (1.f / 1024.f) + EPS);
#pragma unroll
    for (int i = 0; i < 4; ++i) {
      f4 ww = ((const f4*)wnext)[i * 64 + lane];
      u2 pk;
      pk.x = pk2(x[i].x * rs1 * ww.x, x[i].y * rs1 * ww.y);
      pk.y = pk2(x[i].z * rs1 * ww.z, x[i].w * rs1 * ww.w);
      ((u2*)hout)[i * 64 + lane] = pk;
    }
  }
}

constexpr int NR = 4;
DI void row_norm_bf16_xn(const float* __restrict__ x, const float* __restrict__ w, bf16_t* __restrict__ out, int lane) {
  f4 v[NR][4];
#pragma unroll
  for (int q = 0; q < NR; ++q)
#pragma unroll
    for (int i = 0; i < 4; ++i) v[q][i] = ((const f4*)(x + q * 1024))[i * 64 + lane];
  __builtin_amdgcn_sched_barrier(0);
#pragma unroll
  for (int q = 0; q < NR; ++q) {
    float ss = 0.f;
#pragma unroll
    for (int i = 0; i < 4; ++i) ss += v[q][i].x * v[q][i].x + v[q][i].y * v[q][i].y + v[q][i].z * v[q][i].z + v[q][i].w * v[q][i].w;
    ss = wave_sum(ss);
    float rs = rsqrtf(ss * (1.f / 1024.f) + EPS);
#pragma unroll
    for (int i = 0; i < 4; ++i) {
      f4 ww = ((const f4*)w)[i * 64 + lane];
      u2 pk;
      pk.x = pk2(v[q][i].x * rs * ww.x, v[q][i].y * rs * ww.y);
      pk.y = pk2(v[q][i].z * rs * ww.z, v[q][i].w * rs * ww.w);
      ((u2*)(out + q * 1024))[i * 64 + lane] = pk;
    }
  }
}

template <bool XIN_F32, bool LAST>
DI void row_resid_xn(const char* xin, int xin_stride, const bf16_t* __restrict__ mix, const float* __restrict__ wpost,
                     const float* __restrict__ wnext, char* xout, int xout_stride, bf16_t* __restrict__ hout, int lane) {
  f4 x[NR][4]; u2 mu[NR][4];
#pragma unroll
  for (int q = 0; q < NR; ++q) {
#pragma unroll
    for (int i = 0; i < 4; ++i) {
      if (XIN_F32) x[q][i] = ((const f4*)(xin + (long)q * xin_stride))[i * 64 + lane];
      else { u2 xu = ((const u2*)(xin + (long)q * xin_stride))[i * 64 + lane]; x[q][i].x = blo(xu.x); x[q][i].y = bhi(xu.x); x[q][i].z = blo(xu.y); x[q][i].w = bhi(xu.y); }
      mu[q][i] = ((const u2*)(mix + q * 1024))[i * 64 + lane];
    }
  }
  __builtin_amdgcn_sched_barrier(0);
#pragma unroll
  for (int q = 0; q < NR; ++q) {
    f4 m[4];
    float ss = 0.f;
#pragma unroll
    for (int i = 0; i < 4; ++i) {
      m[i].x = blo(mu[q][i].x); m[i].y = bhi(mu[q][i].x); m[i].z = blo(mu[q][i].y); m[i].w = bhi(mu[q][i].y);
      ss += m[i].x * m[i].x + m[i].y * m[i].y + m[i].z * m[i].z + m[i].w * m[i].w;
    }
    ss = wave_sum(ss);
    float rs = rsqrtf(ss * (1.f / 1024.f) + EPS);
    float ss1 = 0.f;
#pragma unroll
    for (int i = 0; i < 4; ++i) {
      f4 ww = ((const f4*)wpost)[i * 64 + lane];
      x[q][i].x += m[i].x * rs * ww.x; x[q][i].y += m[i].y * rs * ww.y;
      x[q][i].z += m[i].z * rs * ww.z; x[q][i].w += m[i].w * rs * ww.w;
      ss1 += x[q][i].x * x[q][i].x + x[q][i].y * x[q][i].y + x[q][i].z * x[q][i].z + x[q][i].w * x[q][i].w;
    }
    if (LAST) {
#pragma unroll
      for (int i = 0; i < 4; ++i) ((f4*)(xout + (long)q * xout_stride))[i * 64 + lane] = x[q][i];
    } else {
#pragma unroll
      for (int i = 0; i < 4; ++i) {
        u2 pk; pk.x = pk2(x[q][i].x, x[q][i].y); pk.y = pk2(x[q][i].z, x[q][i].w);
        ((u2*)(xout + (long)q * xout_stride))[i * 64 + lane] = pk;
      }
      ss1 = wave_sum(ss1);
      float rs1 = rsqrtf(ss1 * (1.f / 1024.f) + EPS);
#pragma unroll
      for (int i = 0; i < 4; ++i) {
        f4 ww = ((const f4*)wnext)[i * 64 + lane];
        u2 pk;
        pk.x = pk2(x[q][i].x * rs1 * ww.x, x[q][i].y * rs1 * ww.y);
        pk.y = pk2(x[q][i].z * rs1 * ww.z, x[q][i].w * rs1 * ww.w);
        ((u2*)(hout + q * 1024))[i * 64 + lane] = pk;
      }
    }
  }
}

template <class F>
DI void wt_conv(bf16_t* __restrict__ dst, int K, int N, int tile0, int& tile_base, char* smem, F src4) {
  float* tl = (float*)smem;
  const int tid = VT;
  const int ntn = N >> 6, ntk = K >> 6, nt = ntn * ntk;
  int first = (tile0 & ~1) - tile_base;
  const int stride = VN;
  if (first < 0) first += ((-first + stride - 1) / stride) * stride;
  for (int te = first; te < nt; te += stride) {
    const int t = te + (tile0 & 1);
    const bool live = t < nt;
    const int tn = live ? t % ntn : 0, tk = live ? t / ntn : 0;
    const int n0 = tn * 64, k0 = tk * 64;
    __syncthreads();
    if (live) {
      const int kk = tid >> 4, n4 = (tid & 15) * 4;
#pragma unroll
      for (int it = 0; it < 4; ++it) {
        const int k = kk + 16 * it;
        const float* sp = src4(k0 + k, n0 + n4);
        f4 v = sp ? *(const f4*)sp : f4{0.f, 0.f, 0.f, 0.f};
        tl[k * 65 + n4 + 0] = v.x; tl[k * 65 + n4 + 1] = v.y; tl[k * 65 + n4 + 2] = v.z; tl[k * 65 + n4 + 3] = v.w;
      }
    }
    __syncthreads();
    if (live) {
      const int n = tid >> 2, kq = (tid & 3) * 16;
      unsigned pk[8];
#pragma unroll
      for (int j = 0; j < 8; ++j) pk[j] = pk2(tl[(kq + 2 * j) * 65 + n], tl[(kq + 2 * j + 1) * 65 + n]);
      bf16_t* d = dst + (long)(n0 + n) * K + k0 + kq;
      *(u4*)d = u4{pk[0], pk[1], pk[2], pk[3]};
      *(u4*)(d + 8) = u4{pk[4], pk[5], pk[6], pk[7]};
    }
  }
  tile_base += nt;
}

DI void phase_prep(const P& p, char* smem) {
  char* ws = p.ws;
  int tb = 0;
  const int vb = VB;
  {
    const float* w = p.w_in;
    wt_conv((bf16_t*)(ws + OFF_WIN), 1024, NIN, vb, tb, smem, [=](int k, int n) -> const float* {
      int sc = n < 1024 ? n : (n < 3072 ? n + 32 : (n < 3104 ? n - 3072 + 1024 : -1));
      return sc < 0 ? nullptr : w + (long)k * 3104 + sc;
    });
  }
  { const float* w = p.w_out; wt_conv((bf16_t*)(ws + OFF_WOUT), 1024, 1024, vb, tb, smem, [=](int k, int n) -> const float* { return w + (long)k * 1024 + n; }); }
  { const float* w = p.w_xq;  wt_conv((bf16_t*)(ws + OFF_WXQ), 1024, 1024, vb, tb, smem, [=](int k, int n) -> const float* { return w + (long)k * 1024 + n; }); }
  { const float* w = p.w_xo;  wt_conv((bf16_t*)(ws + OFF_WXO), 1024, 1024, vb, tb, smem, [=](int k, int n) -> const float* { return w + (long)k * 1024 + n; }); }
  { const float* w = p.w_xkv; wt_conv((bf16_t*)(ws + OFF_WXKV), 1024, 2048, vb, tb, smem, [=](int k, int n) -> const float* { return w + (long)k * 2048 + n; }); }
  {
    const float* wg = p.w_fg; const float* wu = p.w_fu;
    wt_conv((bf16_t*)(ws + OFF_WGU), 1024, 5632, vb, tb, smem, [=](int k, int n) -> const float* {
      int pr = n >> 5, which = (n >> 4) & 1, j = n & 15;
      int sc = pr * 16 + j;
      return (which ? wu : wg) + (long)k * DFF + sc;
    });
  }
  { const float* w = p.w_fd; wt_conv((bf16_t*)(ws + OFF_WDN), DFF, 1024, vb, tb, smem, [=](int k, int n) -> const float* { return w + (long)k * 1024 + n; }); }
  const long gtid = (long)VB * 256 + VT;
  (void)gtid;
  const int lane = VT & 63;
  const int gw = VB * 4 + (VT >> 6);
  const int nw = VN * 4;
  for (int rg = gw; rg < MT / NR; rg += nw) {
    const int r = rg * NR;
    const float* src = r < 256 ? p.memp + (long)r * 1024 : p.mems + (long)(r - 256) * 1024;
    row_norm_bf16_xn(src, p.norm_mem, (bf16_t*)(ws + OFF_MBUF) + (long)r * 1024, lane);
  }
  for (int rg = gw; rg < T / NR; rg += nw) {
    const int r = rg * NR;
    const float* src = r < TP ? p.xp + (long)r * 1024 : p.xs + (long)(r - TP) * 1024;
    row_norm_bf16_xn(src, p.norm_mix_pre, (bf16_t*)(ws + OFF_HBUF) + (long)r * 1024, lane);
  }
}

constexpr int GROW = 144;
constexpr int G8_BM = 256, G8_BK = 64, G8_HALF = 128, G8_HT = G8_HALF * G8_BK;

DI int g8_lds_byte(int r, int c) {
  int st = (r >> 4) * 2 + (c >> 5), rr = r & 15, cc = c & 31, ob = rr * 64 + cc * 2;
  return st * 1024 + (ob ^ (((ob >> 9) & 1) << 5));
}
DI void g8_stage_rc(int b, int& R, int& C) {
  int st = b / 1024, sb = b % 1024, swz = sb ^ (((sb >> 9) & 1) << 5);
  R = (st >> 1) * 16 + swz / 64; C = (st & 1) * 32 + (swz % 64) / 2;
}

template <bool SWAP>
DI void g8_tile(const bf16_t* __restrict__ Ag, const bf16_t* __restrict__ Bg, int K, int brow, int bcol, bf16_t* shm,
                f32x4 (&acc)[2][2][4][2], const int tidx, const bool prestaged, const bool halfn = false) {
#define SA(b, h) (shm + ((b) * 2 + (h)) * G8_HT)
#define SB(b, h) (shm + (4 + (b) * 2 + (h)) * G8_HT)
#define STAGE(Pp, BASE, br, kt) do { const char* _gb = (const char*)(BASE + (long)(br) * K + (long)(kt) * G8_BK); \
    __builtin_amdgcn_global_load_lds((const unsigned*)(_gb + voff0), \
        (__attribute__((address_space(3))) unsigned*)((char*)(Pp) + tidx * 16), 16, 0, 0); \
    __builtin_amdgcn_global_load_lds((const unsigned*)(_gb + (long)K * 128 + voff0), \
        (__attribute__((address_space(3))) unsigned*)((char*)(Pp) + tidx * 16 + 8192), 16, 0, 0); } while (0)
#define LDA(dst, b, h) for (int m = 0; m < 4; ++m) for (int k = 0; k < 2; ++k) \
    dst[m][k] = *reinterpret_cast<const bf16x8*>((char*)SA(b, h) + g8_lds_byte(wr * 64 + m * 16 + fr, k * 32 + fq * 8))
#define LDB(dst, b, h) for (int n = 0; n < 2; ++n) for (int k = 0; k < 2; ++k) \
    dst[n][k] = *reinterpret_cast<const bf16x8*>((char*)SB(b, h) + g8_lds_byte(wc * 32 + n * 16 + fr, k * 32 + fq * 8))
#define MMA(ai, bj, Af, Bf) do { __builtin_amdgcn_s_setprio(1); \
    for (int m = 0; m < 4; ++m) for (int n = 0; n < 2; ++n) for (int k = 0; k < 2; ++k) \
      acc[ai][bj][m][n] = SWAP ? __builtin_amdgcn_mfma_f32_16x16x32_bf16(Bf[n][k], Af[m][k], acc[ai][bj][m][n], 0, 0, 0) \
                               : __builtin_amdgcn_mfma_f32_16x16x32_bf16(Af[m][k], Bf[n][k], acc[ai][bj][m][n], 0, 0, 0); \
    __builtin_amdgcn_s_setprio(0); } while (0)
#define WAIT_V(n) asm volatile("s_waitcnt vmcnt(" #n ")" ::: "memory")
#define WAIT_L(n) asm volatile("s_waitcnt lgkmcnt(" #n ")" ::: "memory")
#define BAR __builtin_amdgcn_s_barrier()
#define SCHED __builtin_amdgcn_sched_barrier(0)
  const int wid = __builtin_amdgcn_readfirstlane(tidx >> 6), lane = tidx & 63, wr = wid >> 2, wc = wid & 3, fr = lane & 15, fq = lane >> 4;
#pragma unroll
  for (int a = 0; a < 2; ++a)
#pragma unroll
    for (int b = 0; b < 2; ++b)
#pragma unroll
      for (int m = 0; m < 4; ++m)
#pragma unroll
        for (int n = 0; n < 2; ++n) acc[a][b][m][n] = f32x4{0.f, 0.f, 0.f, 0.f};
  bf16x8 At[4][2], B0[2][2], B1[2][2];
  const int nt = K / G8_BK;
  unsigned voff0;
  { int _r, _c; g8_stage_rc(tidx * 16, _r, _c); voff0 = (unsigned)(_r * K + _c) * 2u; }
  if (!prestaged) {
    STAGE(SB(0, 0), Bg, bcol, 0); STAGE(SA(0, 0), Ag, brow, 0);
    STAGE(SB(0, 1), Bg, bcol + G8_HALF, 0); STAGE(SA(0, 1), Ag, brow + G8_HALF, 0);
    if (wr == 1) BAR;
    WAIT_V(4); BAR;
  } else {
    if (wr == 1) BAR;
    WAIT_V(0); BAR;
  }
  STAGE(SB(1, 0), Bg, bcol, 1); STAGE(SA(1, 0), Ag, brow, 1); STAGE(SB(1, 1), Bg, bcol + G8_HALF, 1);
  WAIT_V(6); BAR;
  for (int t = 0; t < nt - 2; t += 2) {
    LDB(B0, 0, 0); SCHED; LDA(At, 0, 0); STAGE(SA(1, 1), Ag, brow + G8_HALF, t + 1);
    WAIT_L(8); BAR; WAIT_L(0); MMA(0, 0, At, B0); BAR; SCHED;
    LDB(B1, 0, 1); STAGE(SB(0, 0), Bg, bcol, t + 2);
    BAR; WAIT_L(0); if (!halfn) MMA(0, 1, At, B1); BAR;
    LDA(At, 0, 1); STAGE(SA(0, 0), Ag, brow, t + 2);
    BAR; WAIT_L(0); MMA(1, 0, At, B0); BAR; SCHED;
    STAGE(SB(0, 1), Bg, bcol + G8_HALF, t + 2);
    WAIT_V(6); BAR; if (!halfn) MMA(1, 1, At, B1); BAR;
    LDB(B0, 1, 0); SCHED; LDA(At, 1, 0); STAGE(SA(0, 1), Ag, brow + G8_HALF, t + 2);
    WAIT_L(8); BAR; WAIT_L(0); MMA(0, 0, At, B0); BAR; SCHED;
    LDB(B1, 1, 1); STAGE(SB(1, 0), Bg, bcol, t + 3);
    BAR; WAIT_L(0); if (!halfn) MMA(0, 1, At, B1); BAR;
    LDA(At, 1, 1); STAGE(SA(1, 0), Ag, brow, t + 3);
    BAR; WAIT_L(0); MMA(1, 0, At, B0); BAR; SCHED;
    STAGE(SB(1, 1), Bg, bcol + G8_HALF, t + 3);
    WAIT_V(6); BAR; if (!halfn) MMA(1, 1, At, B1); BAR;
  }
  { LDB(B0, 0, 0); LDA(At, 0, 0); STAGE(SA(1, 1), Ag, brow + G8_HALF, nt - 1);
    BAR; WAIT_L(0); MMA(0, 0, At, B0); BAR;
    LDB(B1, 0, 1); BAR; WAIT_L(0); if (!halfn) MMA(0, 1, At, B1); BAR;
    LDA(At, 0, 1); WAIT_V(4); BAR; WAIT_L(0); MMA(1, 0, At, B0); if (!halfn) MMA(1, 1, At, B1); BAR; }
  { LDB(B0, 1, 0); LDA(At, 1, 0); WAIT_V(2); BAR; WAIT_L(0); MMA(0, 0, At, B0); BAR;
    LDB(B1, 1, 1); WAIT_V(0); BAR; WAIT_L(0); if (!halfn) MMA(0, 1, At, B1); BAR;
    LDA(At, 1, 1); BAR; WAIT_L(0); MMA(1, 0, At, B0); if (!halfn) MMA(1, 1, At, B1); BAR; }
  if (wr == 0) BAR;
#undef SA
#undef SB
#undef STAGE
#undef LDA
#undef LDB
#undef MMA
}

DI void g8_stage0(const bf16_t* __restrict__ Ag, const bf16_t* __restrict__ Bg, int K, int brow, int bcol, bf16_t* shm, const int tidx) {
  unsigned voff0;
  { int _r, _c; g8_stage_rc(tidx * 16, _r, _c); voff0 = (unsigned)(_r * K + _c) * 2u; }
#define SA(b, h) (shm + ((b) * 2 + (h)) * G8_HT)
#define SB(b, h) (shm + (4 + (b) * 2 + (h)) * G8_HT)
#define STAGE(Pp, BASE, br, kt) do { const char* _gb = (const char*)(BASE + (long)(br) * K + (long)(kt) * G8_BK); \
    __builtin_amdgcn_global_load_lds((const unsigned*)(_gb + voff0), \
        (__attribute__((address_space(3))) unsigned*)((char*)(Pp) + tidx * 16), 16, 0, 0); \
    __builtin_amdgcn_global_load_lds((const unsigned*)(_gb + (long)K * 128 + voff0), \
        (__attribute__((address_space(3))) unsigned*)((char*)(Pp) + tidx * 16 + 8192), 16, 0, 0); } while (0)
  STAGE(SB(0, 0), Bg, bcol, 0); STAGE(SA(0, 0), Ag, brow, 0);
  STAGE(SB(0, 1), Bg, bcol + G8_HALF, 0); STAGE(SA(0, 1), Ag, brow + G8_HALF, 0);
#undef SA
#undef SB
#undef STAGE
}

struct Job {
  const bf16_t* A; const bf16_t* B; bf16_t* dst;
  int K, mtiles, ntiles, mode;
};

DI void g8_unit(int L, int nM, int nN, int& pm, int& pn) {
  const int nwg = nM * nN;
  int wgid = L;
  { const int q = nwg / 8, r = nwg % 8, xcd = wgid % 8, off = wgid / 8; wgid = (xcd < r ? xcd * (q + 1) : r * (q + 1) + (xcd - r) * q) + off; }
  const int nig = 8 * nN, gid = wgid / nig, fm = gid * 8, gsz = (nM - fm) < 8 ? (nM - fm) : 8;
  pm = fm + ((wgid % nig) % gsz); pn = (wgid % nig) / gsz;
}

DI void run_gemm_unit(const P& p, const Job& jb, int L, char* smem, const bool prestaged, const bool hasnext, const Job& jn, int Ln) {
  char* ws = p.ws;
  int tidx = threadIdx.x;
  asm volatile("" : "+v"(tidx));
  const int wid = __builtin_amdgcn_readfirstlane(tidx >> 6), lane = tidx & 63, wr = wid >> 2, wc = wid & 3;
  int fr = lane & 15, fq = lane >> 4;
  int pm, pn;
  g8_unit(L, jb.mtiles, jb.ntiles, pm, pn);
  const int m0 = pm * 256, n0 = pn * 256;
  f32x4 acc[2][2][4][2];
  const bool transposed = (jb.mode == 0 && ((n0 >= 2560 && n0 < 3072) || (n0 >= 512 && n0 < 1024))) || (jb.mode == 1 && n0 >= 1024);
  g8_tile<true>(jb.A, jb.B, jb.K, m0, n0, (bf16_t*)smem, acc, tidx, prestaged, jb.mode == 0 && n0 >= 3072);
  const bool early = hasnext && (jb.mode == 3);
  if (early) {
    int pm2, pn2;
    g8_unit(Ln, jn.mtiles, jn.ntiles, pm2, pn2);
    g8_stage0(jn.A, jn.B, jn.K, pm2 * 256, pn2 * 256, (bf16_t*)smem, tidx);
  }
  asm volatile("" : "+v"(fr), "+v"(fq));
  const bool gates = (jb.mode == 0 && n0 >= 3072);
  u4 outv[16];
  bf16_t* gdst = nullptr;
  long istride = 0;
  int nch = 16;
  if (gates) {
    if (wc == 0) {
      float* g = (float*)(ws + OFF_GATES);
#pragma unroll
      for (int ai = 0; ai < 2; ++ai)
#pragma unroll
        for (int m = 0; m < 4; ++m)
#pragma unroll
          for (int n = 0; n < 2; ++n) {
            int row = m0 + ai * 128 + wr * 64 + m * 16 + fr;
            *(f32x4*)(g + (long)row * 32 + n * 16 + fq * 4) = acc[ai][0][m][n];
          }
    }
    nch = 0;
  } else if (transposed) {
    bf16_t* dstT; long ldT; int nb;
    if (jb.mode == 0 && n0 < 1024) { dstT = (bf16_t*)(ws + OFF_GV); ldT = T; nb = 512; }
    else if (jb.mode == 0) { dstT = (bf16_t*)(ws + OFF_DVT); ldT = T; nb = 2560; }
    else { dstT = (bf16_t*)(ws + OFF_VXT); ldT = MT; nb = 1024; }
#pragma unroll
    for (int ai = 0; ai < 2; ++ai)
#pragma unroll
      for (int bj = 0; bj < 2; ++bj)
#pragma unroll
        for (int m = 0; m < 4; ++m)
#pragma unroll
          for (int n = 0; n < 2; ++n) {
            const int rowm = ai * 128 + wr * 64 + m * 16 + fr;
            f32x4 v = acc[ai][bj][m][n];
#pragma unroll
            for (int j = 0; j < 4; ++j) {
              const int colL = bj * 128 + wc * 32 + n * 16 + fq * 4 + j;
              *(bf16_t*)(smem + colL * 512 + (((rowm >> 3) ^ (colL & 31)) << 4) + (rowm & 7) * 2) = f2b(v[j]);
            }
          }
    __syncthreads();
#pragma unroll
    for (int i = 0; i < 16; ++i) {
      const int colL = (tidx >> 5) + 16 * i, c = tidx & 31;
      outv[i] = *(const u4*)(smem + colL * 512 + ((c ^ (colL & 31)) << 4));
    }
    gdst = dstT + (long)(n0 - nb + (tidx >> 5)) * ldT + m0 + (tidx & 31) * 8;
    istride = 16 * ldT;
  } else if (jb.mode == 3) {
#pragma unroll
    for (int ai = 0; ai < 2; ++ai)
#pragma unroll
      for (int bj = 0; bj < 2; ++bj)
#pragma unroll
        for (int m = 0; m < 4; ++m) {
          const int row = ai * 128 + wr * 64 + m * 16 + fr;
          f32x4 g = acc[ai][bj][m][0], u = acc[ai][bj][m][1];
          float o[4];
#pragma unroll
          for (int r = 0; r < 4; ++r) o[r] = g[r] * u[r] * __builtin_amdgcn_rcpf(1.f + __builtin_amdgcn_exp2f(-g[r] * LOG2E));
          u2 pk; pk.x = pk2(o[0], o[1]); pk.y = pk2(o[2], o[3]);
          const int chunk = bj * 8 + wc * 2 + (fq >> 1);
          *(u2*)(smem + row * 256 + (row >= 128 ? 65536 : 32768) + ((chunk ^ (row & 15)) << 4) + (fq & 1) * 8) = pk;
        }
    __syncthreads();
#pragma unroll
    for (int i = 0; i < 8; ++i) {
      const int row = (tidx >> 4) + 32 * i, c = tidx & 15;
      outv[i] = *(const u4*)(smem + row * 256 + (row >= 128 ? 65536 : 32768) + ((c ^ (row & 15)) << 4));
    }
    gdst = jb.dst + (long)(m0 + (tidx >> 4)) * DFF + (n0 >> 1) + (tidx & 15) * 8;
    istride = 32L * DFF;
    nch = 8;
  } else {
    bf16_t* dst; int ld; int nb;
    if (jb.mode == 2) { dst = jb.dst; ld = 1024; nb = 0; }
    else if (jb.mode == 1) { dst = (bf16_t*)(ws + OFF_KX); ld = 1024; nb = 0; }
    else {
      if (n0 < 256) { dst = (bf16_t*)(ws + OFF_GQ); ld = 256; nb = 0; }
      else if (n0 < 512) { dst = (bf16_t*)(ws + OFF_GK); ld = 256; nb = 256; }
      else if (n0 < 1536) { dst = (bf16_t*)(ws + OFF_OG); ld = 512; nb = 1024; }
      else if (n0 < 2048) { dst = (bf16_t*)(ws + OFF_DQ); ld = 512; nb = 1536; }
      else { dst = (bf16_t*)(ws + OFF_DK); ld = 512; nb = 2048; }
    }
    const bool rope = (jb.mode == 0) && (n0 >= 1536) && (n0 < 2560) && ((wc & 1) == 0);
    const float l2t = log2f(500000.f) * (1.f / 8.f);
#pragma unroll
    for (int ai = 0; ai < 2; ++ai)
#pragma unroll
      for (int bj = 0; bj < 2; ++bj)
#pragma unroll
        for (int m = 0; m < 4; ++m)
#pragma unroll
          for (int n = 0; n < 2; ++n) {
            const int row = ai * 128 + wr * 64 + m * 16 + fr;
            f32x4 v = acc[ai][bj][m][n];
            if (rope && n == 0) {
              const int grow = m0 + row;
              const int pos = grow < TP ? grow : ((grow - TP) & (SS - 1));
#pragma unroll
              for (int j = 0; j < 4; ++j) {
                auto rr = __builtin_amdgcn_permlane32_swap(__float_as_uint(v[j]), __float_as_uint(v[j]), false, false);
                const float pv = __uint_as_float(fq < 2 ? rr[1] : rr[0]);
                const int i = (fq & 1) * 4 + j;
                const float inv = exp2f(-(float)i * l2t);
                const float ang = (float)pos * inv;
                const float kk = rintf(ang * 0.15915494309189535f);
                const float frv = fmaf(ang, 0.15915494309189535f, -kk) + ang * 6.4206383e-9f;
                const float sn = __builtin_amdgcn_sinf(frv), cs = __builtin_amdgcn_cosf(frv);
                v[j] = fq < 2 ? v[j] * cs - pv * sn : v[j] * cs + pv * sn;
              }
            }
            u2 pk; pk.x = pk2(v[0], v[1]); pk.y = pk2(v[2], v[3]);
            const int chunk = bj * 16 + wc * 4 + n * 2 + (fq >> 1);
            *(u2*)(smem + row * 512 + ((chunk ^ (row & 31)) << 4) + (fq & 1) * 8) = pk;
          }
    __syncthreads();
#pragma unroll
    for (int i = 0; i < 16; ++i) {
      const int row = (tidx >> 5) + 16 * i, c = tidx & 31;
      outv[i] = *(const u4*)(smem + row * 512 + ((c ^ (row & 31)) << 4));
    }
    gdst = dst + (long)(m0 + (tidx >> 5)) * ld + (n0 - nb) + (tidx & 31) * 8;
    istride = 16L * ld;
  }
  __syncthreads();
  if (hasnext && !early) {
    int pm2, pn2;
    g8_unit(Ln, jn.mtiles, jn.ntiles, pm2, pn2);
    g8_stage0(jn.A, jn.B, jn.K, pm2 * 256, pn2 * 256, (bf16_t*)smem, tidx);
  }
#pragma unroll
  for (int i = 0; i < 16; ++i)
    if (i < nch) *(u4*)(gdst + (long)i * istride) = outv[i];
  if (!hasnext) asm volatile("s_waitcnt vmcnt(0)" ::: "memory");
}

DI void run_gemm_job(const P& p, const Job& jb, char* smem) {
  const int nu = jb.mtiles * jb.ntiles;
  const int G = gridDim.x;
  bool pre = false;
  for (int L = blockIdx.x; L < nu; L += G) {
    const bool hn = L + G < nu;
    run_gemm_unit(p, jb, L, smem, pre, hn, jb, L + G);
    pre = hn;
  }
}

constexpr int VROW = 136;

template <int DQK, bool PF>
DI void flash_item(const bf16_t* __restrict__ Q, int ldq, const bf16_t* __restrict__ Kp, int ldk,
                   const bf16_t* __restrict__ Vt, long ldvt, int nkeys, float c, bf16_t* __restrict__ O, int ldo,
                   char* smem) {
  constexpr int KROW = (DQK + 8) * 2;
  constexpr int KCH = 64 * DQK * 2 / 16 / 256;
  constexpr int CPR = DQK / 8;
  char* Ks = smem;
  char* Vs = smem + 64 * KROW;
  const int tid = VT, lane = tid & 63, w = tid >> 6, r = lane & 31, h = lane >> 5;
  bf16x8 qf[DQK / 16];
  {
    const bf16_t* qrow = Q + (long)(w * 32 + r) * ldq + 8 * h;
#pragma unroll
    for (int ks = 0; ks < DQK / 16; ++ks) qf[ks] = *(const bf16x8*)(qrow + 16 * ks);
  }
  f32x16 o[4];
#pragma unroll
  for (int i = 0; i < 4; ++i)
#pragma unroll
    for (int j = 0; j < 16; ++j) o[i][j] = 0.f;
  float m_run = -1e30f, l_run = 0.f;
  u4 kreg[KCH], vreg[4];
#define FL_GLOAD(kt_) \
  _Pragma("unroll") for (int i = 0; i < KCH; ++i) { \
    int cc = tid + 256 * i, row = cc / CPR, kc = cc % CPR; \
    kreg[i] = *(const u4*)(Kp + (long)((kt_) * 64 + row) * ldk + kc * 8); \
  } \
  _Pragma("unroll") for (int i = 0; i < 4; ++i) { \
    int cc = tid + 256 * i, row = cc >> 3, kc = cc & 7; \
    vreg[i] = *(const u4*)(Vt + (long)row * ldvt + (kt_) * 64 + kc * 8); \
  }
#define FL_LSTORE() \
  _Pragma("unroll") for (int i = 0; i < KCH; ++i) { \
    int cc = tid + 256 * i, row = cc / CPR, kc = cc % CPR; \
    *(u4*)(Ks + row * KROW + kc * 16) = kreg[i]; \
  } \
  _Pragma("unroll") for (int i = 0; i < 4; ++i) { \
    int cc = tid + 256 * i, row = cc >> 3, kc = cc & 7; \
    *(u2*)(Vs + row * VROW + kc * 16) = u2{vreg[i].x, vreg[i].y}; \
    *(u2*)(Vs + row * VROW + kc * 16 + 8) = u2{vreg[i].z, vreg[i].w}; \
  }
  const int nt = nkeys >> 6;
  if (PF) { FL_GLOAD(0) }
  for (int kt = 0; kt < nt; ++kt) {
    __syncthreads();
    if (PF) {
      FL_LSTORE()
    } else {
#pragma unroll
      for (int g = 0; g < KCH / 4; ++g) {
        u4 tmp[4];
#pragma unroll
        for (int i = 0; i < 4; ++i) {
          int cc = tid + 256 * (g * 4 + i), row = cc / CPR, kc = cc % CPR;
          tmp[i] = *(const u4*)(Kp + (long)(kt * 64 + row) * ldk + kc * 8);
        }
#pragma unroll
        for (int i = 0; i < 4; ++i) {
          int cc = tid + 256 * (g * 4 + i), row = cc / CPR, kc = cc % CPR;
          *(u4*)(Ks + row * KROW + kc * 16) = tmp[i];
        }
        __builtin_amdgcn_sched_barrier(0);
      }
      {
        u4 tmp[4];
#pragma unroll
        for (int i = 0; i < 4; ++i) {
          int cc = tid + 256 * i, row = cc >> 3, kc = cc & 7;
          tmp[i] = *(const u4*)(Vt + (long)row * ldvt + kt * 64 + kc * 8);
        }
#pragma unroll
        for (int i = 0; i < 4; ++i) {
          int cc = tid + 256 * i, row = cc >> 3, kc = cc & 7;
          *(u2*)(Vs + row * VROW + kc * 16) = u2{tmp[i].x, tmp[i].y};
          *(u2*)(Vs + row * VROW + kc * 16 + 8) = u2{tmp[i].z, tmp[i].w};
        }
      }
    }
    __syncthreads();
    if (PF && kt + 1 < nt) { FL_GLOAD(kt + 1) }
    f32x16 s[2];
#pragma unroll
    for (int kb = 0; kb < 2; ++kb)
#pragma unroll
      for (int j = 0; j < 16; ++j) s[kb][j] = 0.f;
#pragma unroll
    for (int kg = 0; kg < DQK / 64; ++kg) {
      bf16x8 kf[4][2];
#pragma unroll
      for (int k4 = 0; k4 < 4; ++k4)
#pragma unroll
        for (int kb = 0; kb < 2; ++kb)
          kf[k4][kb] = *(const bf16x8*)(Ks + (32 * kb + r) * KROW + (16 * (kg * 4 + k4) + 8 * h) * 2);
#pragma unroll
      for (int k4 = 0; k4 < 4; ++k4)
#pragma unroll
        for (int kb = 0; kb < 2; ++kb)
          s[kb] = __builtin_amdgcn_mfma_f32_32x32x16_bf16(kf[k4][kb], qf[kg * 4 + k4], s[kb], 0, 0, 0);
      __builtin_amdgcn_sched_group_barrier(0x100, 8, 0);
      __builtin_amdgcn_sched_group_barrier(0x008, 8, 0);
      __builtin_amdgcn_sched_barrier(0);
    }
    bf16x8 vf0[2][4];
#pragma unroll
    for (int st = 0; st < 2; ++st)
#pragma unroll
      for (int dvb = 0; dvb < 4; ++dvb) {
        const char* vp = Vs + (32 * dvb + r) * VROW + (16 * st + 4 * h) * 2;
        bf16x4 lo = *(const bf16x4*)vp;
        bf16x4 hi = *(const bf16x4*)(vp + 16);
        vf0[st][dvb] = __builtin_shufflevector(lo, hi, 0, 1, 2, 3, 4, 5, 6, 7);
      }
    __builtin_amdgcn_sched_barrier(0);
    float mx = s[0][0];
#pragma unroll
    for (int kb = 0; kb < 2; ++kb)
#pragma unroll
      for (int j = 0; j < 16; ++j) mx = fmaxf(mx, s[kb][j]);
    mx = half_swap_max(mx);
    const float m_new = fmaxf(m_run, mx * c);
    if (__builtin_amdgcn_ballot_w64(m_new > m_run) != 0ull) {
      const float alpha = __builtin_amdgcn_exp2f(m_run - m_new);
      m_run = m_new;
      l_run *= alpha;
#pragma unroll
      for (int i = 0; i < 4; ++i)
#pragma unroll
        for (int j = 0; j < 16; ++j) o[i][j] *= alpha;
    }
    float ps = 0.f;
#pragma unroll
    for (int kb = 0; kb < 2; ++kb)
#pragma unroll
      for (int j = 0; j < 16; ++j) {
        float pv = __builtin_amdgcn_exp2f(s[kb][j] * c - m_run);
        s[kb][j] = pv;
        ps += pv;
      }
    l_run += ps;
    bf16x8 pf[2][2];
#pragma unroll
    for (int kb = 0; kb < 2; ++kb)
#pragma unroll
      for (int st = 0; st < 2; ++st) {
        u4 pu;
        pu.x = pk2(s[kb][8 * st + 0], s[kb][8 * st + 1]);
        pu.y = pk2(s[kb][8 * st + 2], s[kb][8 * st + 3]);
        pu.z = pk2(s[kb][8 * st + 4], s[kb][8 * st + 5]);
        pu.w = pk2(s[kb][8 * st + 6], s[kb][8 * st + 7]);
        pf[kb][st] = __builtin_bit_cast(bf16x8, pu);
      }
    __builtin_amdgcn_sched_barrier(0);
    bf16x8 vf1[2][4];
#pragma unroll
    for (int st = 0; st < 2; ++st)
#pragma unroll
      for (int dvb = 0; dvb < 4; ++dvb) {
        const char* vp = Vs + (32 * dvb + r) * VROW + (32 + 16 * st + 4 * h) * 2;
        bf16x4 lo = *(const bf16x4*)vp;
        bf16x4 hi = *(const bf16x4*)(vp + 16);
        vf1[st][dvb] = __builtin_shufflevector(lo, hi, 0, 1, 2, 3, 4, 5, 6, 7);
      }
#pragma unroll
    for (int st = 0; st < 2; ++st)
#pragma unroll
      for (int dvb = 0; dvb < 4; ++dvb) o[dvb] = __builtin_amdgcn_mfma_f32_32x32x16_bf16(vf0[st][dvb], pf[0][st], o[dvb], 0, 0, 0);
    __builtin_amdgcn_sched_group_barrier(0x100, 16, 0);
    __builtin_amdgcn_sched_group_barrier(0x008, 8, 0);
    __builtin_amdgcn_sched_barrier(0);
#pragma unroll
    for (int st = 0; st < 2; ++st)
#pragma unroll
      for (int dvb = 0; dvb < 4; ++dvb) o[dvb] = __builtin_amdgcn_mfma_f32_32x32x16_bf16(vf1[st][dvb], pf[1][st], o[dvb], 0, 0, 0);
  }
  float l = half_swap_sum(l_run);
  float inv = 1.f / l;
  bf16_t* orow = O + (long)(w * 32 + r) * ldo;
#pragma unroll
  for (int dvb = 0; dvb < 4; ++dvb)
#pragma unroll
    for (int g = 0; g < 4; ++g) {
      u2 pk;
      pk.x = pk2(o[dvb][4 * g + 0] * inv, o[dvb][4 * g + 1] * inv);
      pk.y = pk2(o[dvb][4 * g + 2] * inv, o[dvb][4 * g + 3] * inv);
      *(u2*)(orow + 32 * dvb + 8 * g + 4 * h) = pk;
    }
  __syncthreads();
}

template <int DQK>
DI void flash256x_core(const bf16x8 (&qf)[DQK / 16], const bf16_t* __restrict__ Kp, int ldk,
                      const bf16_t* __restrict__ Vt, long ldvt, int nkeys, float c, bf16_t* __restrict__ O, int ldo,
                      char* smem) {
  constexpr int KROW = (DQK + 8) * 2;
  constexpr int BUFB = 64 * KROW + 128 * VROW;
  constexpr int KCH = DQK / 64;
  constexpr int CPR = DQK / 8;
  int tid = threadIdx.x;
  asm volatile("" : "+v"(tid));
  const int lane = tid & 63, w = tid >> 6, r = lane & 31, h = lane >> 5;
  f32x16 o[4];
#pragma unroll
  for (int i = 0; i < 4; ++i)
#pragma unroll
    for (int j = 0; j < 16; ++j) o[i][j] = 0.f;
  float m_run = -1e30f, l_run = 0.f;
  const bf16_t* vg0 = Vt + (long)(tid >> 3) * ldvt + (tid & 7) * 8;
  const bf16_t* vg1 = Vt + (long)(64 + (tid >> 3)) * ldvt + (tid & 7) * 8;
  const int vso0 = 64 * KROW + (tid >> 3) * VROW + (tid & 7) * 16;
  const int vso1 = vso0 + 64 * VROW;
  u4 kr[KCH], vr0, vr1;
#define F2_GLOAD(kt_) { _Pragma("unroll") for (int i_ = 0; i_ < KCH; ++i_) { int cc_ = tid + 512 * i_; \
      kr[i_] = *(const u4*)(Kp + (long)((kt_) * 64 + cc_ / CPR) * ldk + (cc_ % CPR) * 8); } \
    vr0 = *(const u4*)(vg0 + (kt_) * 64); vr1 = *(const u4*)(vg1 + (kt_) * 64); }
#define F2_LSTORE(buf_) { char* bb = smem + (buf_) * BUFB; \
    _Pragma("unroll") for (int i_ = 0; i_ < KCH; ++i_) { int cc_ = tid + 512 * i_; *(u4*)(bb + (cc_ / CPR) * KROW + (cc_ % CPR) * 16) = kr[i_]; } \
    *(u2*)(bb + vso0) = u2{vr0.x, vr0.y}; *(u2*)(bb + vso0 + 8) = u2{vr0.z, vr0.w}; \
    *(u2*)(bb + vso1) = u2{vr1.x, vr1.y}; *(u2*)(bb + vso1 + 8) = u2{vr1.z, vr1.w}; }
  const int nt = nkeys >> 6;
  F2_GLOAD(0)
  __syncthreads();
  F2_LSTORE(0)
  if (nt > 1) F2_GLOAD(1)
  __syncthreads();
  for (int kt = 0; kt < nt; ++kt) {
    const char* Ks = smem + (kt & 1) * BUFB;
    const char* Vs = Ks + 64 * KROW;
    f32x16 s[2];
#pragma unroll
    for (int kb = 0; kb < 2; ++kb)
#pragma unroll
      for (int j = 0; j < 16; ++j) s[kb][j] = 0.f;
    constexpr int KG = (DQK == 64) ? 4 : 2;
    __builtin_amdgcn_s_setprio(1);
#pragma unroll
    for (int kg = 0; kg < DQK / 16 / KG; ++kg) {
      bf16x8 kf[KG][2];
#pragma unroll
      for (int k4 = 0; k4 < KG; ++k4)
#pragma unroll
        for (int kb = 0; kb < 2; ++kb) kf[k4][kb] = *(const bf16x8*)(Ks + (32 * kb + r) * KROW + (16 * (kg * KG + k4) + 8 * h) * 2);
#pragma unroll
      for (int k4 = 0; k4 < KG; ++k4)
#pragma unroll
        for (int kb = 0; kb < 2; ++kb) s[kb] = __builtin_amdgcn_mfma_f32_32x32x16_bf16(kf[k4][kb], qf[kg * KG + k4], s[kb], 0, 0, 0);
      __builtin_amdgcn_sched_group_barrier(0x100, 2 * KG, 0);
      __builtin_amdgcn_sched_group_barrier(0x008, 2 * KG, 0);
      __builtin_amdgcn_sched_barrier(0);
    }
    __builtin_amdgcn_s_setprio(0);
    bf16x8 vf0[2][4];
    if constexpr (DQK == 64) {
#pragma unroll
      for (int st = 0; st < 2; ++st)
#pragma unroll
        for (int dvb = 0; dvb < 4; ++dvb) {
          const char* vp = Vs + (32 * dvb + r) * VROW + (16 * st + 4 * h) * 2;
          bf16x4 lo = *(const bf16x4*)vp;
          bf16x4 hi = *(const bf16x4*)(vp + 16);
          vf0[st][dvb] = __builtin_shufflevector(lo, hi, 0, 1, 2, 3, 4, 5, 6, 7);
        }
      __builtin_amdgcn_sched_barrier(0);
    }
    float mx = s[0][0];
#pragma unroll
    for (int kb = 0; kb < 2; ++kb)
#pragma unroll
      for (int j = 0; j < 16; ++j) mx = fmaxf(mx, s[kb][j]);
    mx = half_swap_max(mx);
    const float mxs = mx * c;
    if (__builtin_amdgcn_ballot_w64(mxs > m_run + 8.f) != 0ull) {
      const float m_new = fmaxf(m_run, mxs);
      const float alpha = __builtin_amdgcn_exp2f(m_run - m_new);
      m_run = m_new;
      l_run *= alpha;
#pragma unroll
      for (int i = 0; i < 4; ++i)
#pragma unroll
        for (int j = 0; j < 16; ++j) o[i][j] *= alpha;
    }
    float ps = 0.f;
#pragma unroll
    for (int kb = 0; kb < 2; ++kb)
#pragma unroll
      for (int j = 0; j < 16; ++j) {
        float pv = __builtin_amdgcn_exp2f(s[kb][j] * c - m_run);
        s[kb][j] = pv;
        ps += pv;
      }
    l_run += ps;
    bf16x8 pf[2][2];
#pragma unroll
    for (int kb = 0; kb < 2; ++kb)
#pragma unroll
      for (int st = 0; st < 2; ++st) {
        u4 pu;
        pu.x = pk2(s[kb][8 * st + 0], s[kb][8 * st + 1]);
        pu.y = pk2(s[kb][8 * st + 2], s[kb][8 * st + 3]);
        pu.z = pk2(s[kb][8 * st + 4], s[kb][8 * st + 5]);
        pu.w = pk2(s[kb][8 * st + 6], s[kb][8 * st + 7]);
        pf[kb][st] = __builtin_bit_cast(bf16x8, pu);
      }
    __builtin_amdgcn_sched_barrier(0);
    if (kt + 1 < nt) {
      F2_LSTORE((kt + 1) & 1)
      if (kt + 2 < nt) F2_GLOAD(kt + 2)
    }
    __builtin_amdgcn_sched_barrier(0);
    __builtin_amdgcn_s_setprio(1);
    if constexpr (DQK == 64) {
      bf16x8 vf1[2][4];
#pragma unroll
      for (int st = 0; st < 2; ++st)
#pragma unroll
        for (int dvb = 0; dvb < 4; ++dvb) {
          const char* vp = Vs + (32 * dvb + r) * VROW + (32 + 16 * st + 4 * h) * 2;
          bf16x4 lo = *(const bf16x4*)vp;
          bf16x4 hi = *(const bf16x4*)(vp + 16);
          vf1[st][dvb] = __builtin_shufflevector(lo, hi, 0, 1, 2, 3, 4, 5, 6, 7);
        }
#pragma unroll
      for (int st = 0; st < 2; ++st)
#pragma unroll
        for (int dvb = 0; dvb < 4; ++dvb) o[dvb] = __builtin_amdgcn_mfma_f32_32x32x16_bf16(vf0[st][dvb], pf[0][st], o[dvb], 0, 0, 0);
      __builtin_amdgcn_sched_group_barrier(0x100, 16, 0);
      __builtin_amdgcn_sched_group_barrier(0x008, 8, 0);
      __builtin_amdgcn_sched_barrier(0);
#pragma unroll
      for (int st = 0; st < 2; ++st)
#pragma unroll
        for (int dvb = 0; dvb < 4; ++dvb) o[dvb] = __builtin_amdgcn_mfma_f32_32x32x16_bf16(vf1[st][dvb], pf[1][st], o[dvb], 0, 0, 0);
    } else {
#pragma unroll
      for (int kb = 0; kb < 2; ++kb)
#pragma unroll
        for (int st = 0; st < 2; ++st) {
          bf16x8 vf[4];
#pragma unroll
          for (int dvb = 0; dvb < 4; ++dvb) {
            const char* vp = Vs + (32 * dvb + r) * VROW + (32 * kb + 16 * st + 4 * h) * 2;
            bf16x4 lo = *(const bf16x4*)vp;
            bf16x4 hi = *(const bf16x4*)(vp + 16);
            vf[dvb] = __builtin_shufflevector(lo, hi, 0, 1, 2, 3, 4, 5, 6, 7);
          }
#pragma unroll
          for (int dvb = 0; dvb < 4; ++dvb) o[dvb] = __builtin_amdgcn_mfma_f32_32x32x16_bf16(vf[dvb], pf[kb][st], o[dvb], 0, 0, 0);
          __builtin_amdgcn_sched_group_barrier(0x100, 8, 0);
          __builtin_amdgcn_sched_group_barrier(0x008, 4, 0);
          __builtin_amdgcn_sched_barrier(0);
        }
    }
    __builtin_amdgcn_s_setprio(0);
    __syncthreads();
  }
  float l = half_swap_sum(l_run);
  float inv = 1.f / l;
  bf16_t* orow = O + (long)(w * 32 + r) * ldo;
#pragma unroll
  for (int dvb = 0; dvb < 4; ++dvb)
#pragma unroll
    for (int g = 0; g < 4; ++g) {
      u2 pk;
      pk.x = pk2(o[dvb][4 * g + 0] * inv, o[dvb][4 * g + 1] * inv);
      pk.y = pk2(o[dvb][4 * g + 2] * inv, o[dvb][4 * g + 3] * inv);
      *(u2*)(orow + 32 * dvb + 8 * g + 4 * h) = pk;
    }
#undef F2_GLOAD
#undef F2_LSTORE
}

template <int DQK>
DI void flash256_item(const bf16_t* __restrict__ Q, int ldq, const bf16_t* __restrict__ Kp, int ldk,
                      const bf16_t* __restrict__ Vt, long ldvt, int nkeys, float c, bf16_t* __restrict__ O, int ldo,
                      char* smem) {
  constexpr int KROW = (DQK + 8) * 2;
  constexpr int BUFB = 64 * KROW + 128 * VROW;
  constexpr int NBUF = (DQK == 64) ? 3 : 2;
  constexpr int KCH = DQK / 64;
  constexpr int CPR = DQK / 8;
  constexpr int KG = (DQK == 64) ? 4 : 2;
  const int tid = threadIdx.x, lane = tid & 63, w = __builtin_amdgcn_readfirstlane(tid >> 6), r = lane & 31, h = lane >> 5;
  const bool skew = (DQK == 64) && (w >= 4);
  bf16x8 qf[DQK / 16];
  {
    const bf16_t* qrow = Q + (long)(w * 32 + r) * ldq + 8 * h;
#pragma unroll
    for (int ks = 0; ks < DQK / 16; ++ks) qf[ks] = *(const bf16x8*)(qrow + 16 * ks);
  }
  f32x16 o[4];
#pragma unroll
  for (int i = 0; i < 4; ++i)
#pragma unroll
    for (int j = 0; j < 16; ++j) o[i][j] = 0.f;
  float m_run = -1e30f, l_run = 0.f;
  const bf16_t* vg0 = Vt + (long)(tid >> 3) * ldvt + (tid & 7) * 8;
  const bf16_t* vg1 = Vt + (long)(64 + (tid >> 3)) * ldvt + (tid & 7) * 8;
  const int vso0 = 64 * KROW + (tid >> 3) * VROW + (tid & 7) * 16;
  const int vso1 = vso0 + 64 * VROW;
  const int nt = nkeys >> 6;
  u4 kr[KCH], vr0, vr1;
  bf16x8 pf[2][2];
  f32x16 s[2];
#define F2_GLOAD(kt_) { const int t_ = min((kt_), nt - 1); _Pragma("unroll") for (int i_ = 0; i_ < KCH; ++i_) { int cc_ = tid + 512 * i_; \
      kr[i_] = *(const u4*)(Kp + (long)(t_ * 64 + cc_ / CPR) * ldk + (cc_ % CPR) * 8); } \
    vr0 = *(const u4*)(vg0 + t_ * 64); vr1 = *(const u4*)(vg1 + t_ * 64); }
#define F2_LSTORE(buf_) { char* bb = smem + (buf_) * BUFB; \
    _Pragma("unroll") for (int i_ = 0; i_ < KCH; ++i_) { int cc_ = tid + 512 * i_; *(u4*)(bb + (cc_ / CPR) * KROW + (cc_ % CPR) * 16) = kr[i_]; } \
    *(u2*)(bb + vso0) = u2{vr0.x, vr0.y}; *(u2*)(bb + vso0 + 8) = u2{vr0.z, vr0.w}; \
    *(u2*)(bb + vso1) = u2{vr1.x, vr1.y}; *(u2*)(bb + vso1 + 8) = u2{vr1.z, vr1.w}; }
#define SEC_STAGE(kt_, nxt_) { F2_LSTORE(nxt_) F2_GLOAD((kt_) + 2) __builtin_amdgcn_sched_barrier(0); }
#define SEC_QK(cur_) { const char* Ks_ = smem + (cur_) * BUFB; \
    _Pragma("unroll") for (int kb = 0; kb < 2; ++kb) _Pragma("unroll") for (int j = 0; j < 16; ++j) s[kb][j] = 0.f; \
    __builtin_amdgcn_s_setprio(1); \
    _Pragma("unroll") for (int kg = 0; kg < DQK / 16 / KG; ++kg) { \
      bf16x8 kf[KG][2]; \
      _Pragma("unroll") for (int k4 = 0; k4 < KG; ++k4) _Pragma("unroll") for (int kb = 0; kb < 2; ++kb) \
        kf[k4][kb] = *(const bf16x8*)(Ks_ + (32 * kb + r) * KROW + (16 * (kg * KG + k4) + 8 * h) * 2); \
      _Pragma("unroll") for (int k4 = 0; k4 < KG; ++k4) _Pragma("unroll") for (int kb = 0; kb < 2; ++kb) \
        s[kb] = __builtin_amdgcn_mfma_f32_32x32x16_bf16(kf[k4][kb], qf[kg * KG + k4], s[kb], 0, 0, 0); \
      __builtin_amdgcn_sched_group_barrier(0x100, 2 * KG, 0); \
      __builtin_amdgcn_sched_group_barrier(0x008, 2 * KG, 0); \
      __builtin_amdgcn_sched_barrier(0); \
    } \
    __builtin_amdgcn_s_setprio(0); }
#define SEC_SOFTMAX() { \
    float mx = s[0][0]; \
    _Pragma("unroll") for (int kb = 0; kb < 2; ++kb) _Pragma("unroll") for (int j = 0; j < 16; ++j) mx = fmaxf(mx, s[kb][j]); \
    mx = half_swap_max(mx); \
    const float mxs = mx * c; \
    if (__builtin_amdgcn_ballot_w64(mxs > m_run + 8.f) != 0ull) { \
      const float m_new = fmaxf(m_run, mxs); \
      const float alpha = __builtin_amdgcn_exp2f(m_run - m_new); \
      m_run = m_new; l_run *= alpha; \
      _Pragma("unroll") for (int i = 0; i < 4; ++i) _Pragma("unroll") for (int j = 0; j < 16; ++j) o[i][j] *= alpha; \
    } \
    float ps = 0.f; \
    _Pragma("unroll") for (int kb = 0; kb < 2; ++kb) _Pragma("unroll") for (int j = 0; j < 16; ++j) { \
        float pv = __builtin_amdgcn_exp2f(s[kb][j] * c - m_run); s[kb][j] = pv; ps += pv; } \
    l_run += ps; \
    _Pragma("unroll") for (int kb = 0; kb < 2; ++kb) _Pragma("unroll") for (int st = 0; st < 2; ++st) { \
        u4 pu; \
        pu.x = pk2(s[kb][8 * st + 0], s[kb][8 * st + 1]); pu.y = pk2(s[kb][8 * st + 2], s[kb][8 * st + 3]); \
        pu.z = pk2(s[kb][8 * st + 4], s[kb][8 * st + 5]); pu.w = pk2(s[kb][8 * st + 6], s[kb][8 * st + 7]); \
        pf[kb][st] = __builtin_bit_cast(bf16x8, pu); } \
    __builtin_amdgcn_sched_barrier(0); }
#define SEC_PV(vb_) { const char* Vs_ = smem + (vb_) * BUFB + 64 * KROW; \
    constexpr int SB_ = (DQK == 64) ? 2 : 1;     \
    __builtin_amdgcn_s_setprio(1); \
    _Pragma("unroll") for (int kbs = 0; kbs < 4 / SB_; ++kbs) { \
      bf16x8 vf[SB_][4]; \
      _Pragma("unroll") for (int sb = 0; sb < SB_; ++sb) _Pragma("unroll") for (int dvb = 0; dvb < 4; ++dvb) { \
          const char* vp = Vs_ + (32 * dvb + r) * VROW + (16 * (kbs * SB_ + sb) + 4 * h) * 2; \
          bf16x4 lo = *(const bf16x4*)vp; bf16x4 hi = *(const bf16x4*)(vp + 16); \
          vf[sb][dvb] = __builtin_shufflevector(lo, hi, 0, 1, 2, 3, 4, 5, 6, 7); } \
      _Pragma("unroll") for (int sb = 0; sb < SB_; ++sb) _Pragma("unroll") for (int dvb = 0; dvb < 4; ++dvb) \
          o[dvb] = __builtin_amdgcn_mfma_f32_32x32x16_bf16(vf[sb][dvb], pf[(kbs * SB_ + sb) >> 1][(kbs * SB_ + sb) & 1], o[dvb], 0, 0, 0); \
      __builtin_amdgcn_sched_group_barrier(0x100, 8 * SB_, 0); \
      __builtin_amdgcn_sched_group_barrier(0x008, 4 * SB_, 0); \
      __builtin_amdgcn_sched_barrier(0); \
    } \
    __builtin_amdgcn_s_setprio(0); }
  F2_GLOAD(0)
  __syncthreads();
  F2_LSTORE(0)
  F2_GLOAD(1)
  __syncthreads();
  int cur = 0, prv = 0;
  if (!skew) {
    for (int kt = 0; kt < nt; ++kt) {
      const int nxt = cur == NBUF - 1 ? 0 : cur + 1;
      SEC_QK(cur)
      SEC_SOFTMAX()
      SEC_STAGE(kt, nxt)
      SEC_PV(cur)
      __syncthreads();
      cur = nxt;
    }
  } else {
    for (int kt = 0; kt < nt; ++kt) {
      const int nxt = cur == NBUF - 1 ? 0 : cur + 1;
      if (kt > 0) SEC_PV(prv)
      SEC_STAGE(kt, nxt)
      SEC_QK(cur)
      SEC_SOFTMAX()
      __syncthreads();
      prv = cur; cur = nxt;
    }
    SEC_PV(prv)
  }
  float l = half_swap_sum(l_run);
  float inv = 1.f / l;
  bf16_t* orow = O + (long)(w * 32 + r) * ldo;
#pragma unroll
  for (int dvb = 0; dvb < 4; ++dvb)
#pragma unroll
    for (int g = 0; g < 4; ++g) {
      u2 pk;
      pk.x = pk2(o[dvb][4 * g + 0] * inv, o[dvb][4 * g + 1] * inv);
      pk.y = pk2(o[dvb][4 * g + 2] * inv, o[dvb][4 * g + 3] * inv);
      *(u2*)(orow + 32 * dvb + 8 * g + 4 * h) = pk;
    }
#undef F2_GLOAD
#undef F2_LSTORE
#undef SEC_STAGE
#undef SEC_QK
#undef SEC_SOFTMAX
#undef SEC_PV
}

constexpr int GL_GS = 0;
constexpr int GL_TOT = 8192;
constexpr int GL_B1 = 10240;
constexpr int GL_B2 = 19456;
constexpr int GL_VT = 28672;
constexpr int GL_AS = 47104;

DI float fexp(float x) { return __builtin_amdgcn_exp2f(x * LOG2E); }
DI float log_sigmoid(float z) { return fminf(z, 0.f) - __logf(1.f + fexp(-fabsf(z))); }

DI void gla_gates(const P& p, int t0, int hh, char* smem, float (&bfv)[16], float (&bbv)[16], float& totf, float& totb) {
  const int tid = VT, d = tid & 63, tg = tid >> 6;
  float* gs = (float*)(smem + GL_GS);
  float* tots = (float*)(smem + GL_TOT);
  const float* gates = (const float*)(p.ws + OFF_GATES) + (long)t0 * 32;
  __syncthreads();
  ((f4*)gs)[tid * 2] = ((const f4*)gates)[tid * 2];
  ((f4*)gs)[tid * 2 + 1] = ((const f4*)gates)[tid * 2 + 1];
  float wf[16], wb[16];
#pragma unroll
  for (int r = 0; r < 16; ++r) {
    wf[r] = p.w_gu_f[r * 256 + hh * 64 + d];
    wb[r] = p.w_gu_b[r * 256 + hh * 64 + d];
  }
  const float biasf = p.b_g_f[hh * 64 + d], biasb = p.b_g_b[hh * 64 + d];
  __syncthreads();
#pragma unroll
  for (int j = 0; j < 16; ++j) {
    const float* gr = gs + (tg * 16 + j) * 32;
    float zf = biasf, zb = biasb;
#pragma unroll
    for (int r = 0; r < 16; ++r) { zf += gr[r] * wf[r]; zb += gr[16 + r] * wb[r]; }
    bfv[j] = log_sigmoid(zf) * (1.f / 16.f);
    bbv[j] = log_sigmoid(zb) * (1.f / 16.f);
  }
  float run = 0.f;
#pragma unroll
  for (int j = 0; j < 16; ++j) { run += bfv[j]; bfv[j] = run; }
  tots[(0 * 4 + tg) * 64 + d] = run;
  run = 0.f;
#pragma unroll
  for (int j = 15; j >= 0; --j) { run += bbv[j]; bbv[j] = run; }
  tots[(1 * 4 + tg) * 64 + d] = run;
  __syncthreads();
  float offf = 0.f, offb = 0.f;
  totf = 0.f; totb = 0.f;
#pragma unroll
  for (int g = 0; g < 4; ++g) {
    float a = tots[(0 * 4 + g) * 64 + d], b = tots[(1 * 4 + g) * 64 + d];
    totf += a; totb += b;
    if (g < tg) offf += a;
    if (g > tg) offb += b;
  }
#pragma unroll
  for (int j = 0; j < 16; ++j) { bfv[j] += offf; bbv[j] += offb; }
}

DI void gla_g1_item(const P& p, int cgi, int hh, char* smem) {
  const int tid = VT, lane = tid & 63, w = tid >> 6, d = tid & 63, tg = tid >> 6;
  const int r16 = lane & 15, q4 = lane >> 4;
  const int t0 = cgi * 64;
  float bfv[16], bbv[16], totf, totb;
  gla_gates(p, t0, hh, smem, bfv, bbv, totf, totb);
  {
    const long rowoff = (long)(t0 + tg * 16) * 256 + hh * 64 + d;
    const bf16_t* gq = (const bf16_t*)(p.ws + OFF_GQ) + rowoff;
    const bf16_t* gk = (const bf16_t*)(p.ws + OFF_GK) + rowoff;
    bf16_t* qef = (bf16_t*)((char*)p.out + OUT_QEF) + rowoff;
    bf16_t* kef = (bf16_t*)((char*)p.out + OUT_KEF) + rowoff;
    bf16_t* qeb = (bf16_t*)((char*)p.out + OUT_QEB) + rowoff;
    bf16_t* keb = (bf16_t*)((char*)p.out + OUT_KEB) + rowoff;
    float qv[16], kv[16];
#pragma unroll
    for (int j = 0; j < 16; ++j) { qv[j] = b2f(gq[(long)j * 256]) * 0.125f; kv[j] = b2f(gk[(long)j * 256]); }
    unsigned pf[8], pb[8];
#pragma unroll
    for (int j = 0; j < 16; ++j) {
      float ef = fexp(bfv[j]), eb = fexp(bbv[j]);
      qef[(long)j * 256] = f2b(qv[j] * ef);
      qeb[(long)j * 256] = f2b(qv[j] * eb);
      kef[(long)j * 256] = f2b(kv[j] * fexp(-bfv[j]));
      keb[(long)j * 256] = f2b(kv[j] * fexp(-bbv[j]));
    }
#pragma unroll
    for (int j = 0; j < 8; ++j) {
      pf[j] = pk2(kv[2 * j] * fexp(totf - bfv[2 * j]), kv[2 * j + 1] * fexp(totf - bfv[2 * j + 1]));
      pb[j] = pk2(kv[2 * j] * fexp(totb - bbv[2 * j]), kv[2 * j + 1] * fexp(totb - bbv[2 * j + 1]));
    }
    char* d1 = smem + GL_B1 + d * GROW + tg * 32;
    char* d2 = smem + GL_B2 + d * GROW + tg * 32;
    *(u4*)(d1) = u4{pf[0], pf[1], pf[2], pf[3]};
    *(u4*)(d1 + 16) = u4{pf[4], pf[5], pf[6], pf[7]};
    *(u4*)(d2) = u4{pb[0], pb[1], pb[2], pb[3]};
    *(u4*)(d2 + 16) = u4{pb[4], pb[5], pb[6], pb[7]};
  }
  if (tg == 0) {
    float* dec = (float*)(p.ws + OFF_DEC) + (long)((cgi * 4 + hh) * 2) * 64;
    dec[d] = fexp(totf);
    dec[64 + d] = fexp(totb);
  }
  const bf16_t* gvt = (const bf16_t*)(p.ws + OFF_GV) + (long)(hh * 128 + 32 * w + r16) * T + t0 + q4 * 8;
  bf16x8 af[2][2];
#pragma unroll
  for (int i = 0; i < 2; ++i)
#pragma unroll
    for (int ks = 0; ks < 2; ++ks) af[i][ks] = *(const bf16x8*)(gvt + (long)(16 * i) * T + ks * 32);
  __syncthreads();
#pragma unroll
  for (int dir = 0; dir < 2; ++dir) {
    const char* kb = smem + (dir ? GL_B2 : GL_B1);
    f32x4 acc[2][4];
#pragma unroll
    for (int i = 0; i < 2; ++i)
#pragma unroll
      for (int j = 0; j < 4; ++j) acc[i][j] = f32x4{0.f, 0.f, 0.f, 0.f};
#pragma unroll
    for (int ks = 0; ks < 2; ++ks) {
      bf16x8 bfr[4];
#pragma unroll
      for (int j = 0; j < 4; ++j) bfr[j] = *(const bf16x8*)(kb + (16 * j + r16) * GROW + (ks * 32 + q4 * 8) * 2);
#pragma unroll
      for (int i = 0; i < 2; ++i)
#pragma unroll
        for (int j = 0; j < 4; ++j) acc[i][j] = __builtin_amdgcn_mfma_f32_16x16x32_bf16(af[i][ks], bfr[j], acc[i][j], 0, 0, 0);
    }
    bf16_t* U = (bf16_t*)(p.ws + OFF_UBUF) + (long)((cgi * 4 + hh) * 2 + dir) * 8192;
#pragma unroll
    for (int i = 0; i < 2; ++i)
#pragma unroll
      for (int j = 0; j < 4; ++j)
#pragma unroll
        for (int r = 0; r < 4; ++r) {
          int v = 32 * w + 16 * i + 4 * q4 + r, dd = 16 * j + r16;
          U[v * 64 + dd] = f2b(acc[i][j][r]);
        }
  }
}

DI void gla_g3_wave(const P& p, int cgi, int hh, int slab, char* wsm) {
  const int lane = VT & 63, r16 = lane & 15, q4 = lane >> 4;
  const int t0 = cgi * 64;
  f32x4 o[8];
#pragma unroll
  for (int j = 0; j < 8; ++j) o[j] = f32x4{0.f, 0.f, 0.f, 0.f};
  const bf16_t* gvt = (const bf16_t*)(p.ws + OFF_GV) + (long)(hh * 128 + r16) * T + t0 + q4 * 8;
  const bf16_t* og = (const bf16_t*)(p.ws + OFF_OG);
#pragma unroll
  for (int dir = 0; dir < 2; ++dir) {
    const bf16_t* QE = (const bf16_t*)((const char*)p.out + (dir ? OUT_QEB : OUT_QEF)) + (long)t0 * 256 + hh * 64 + q4 * 8;
    const bf16_t* KE = (const bf16_t*)((const char*)p.out + (dir ? OUT_KEB : OUT_KEF)) + (long)t0 * 256 + hh * 64 + q4 * 8;
    const bf16_t* S = (const bf16_t*)(p.ws + OFF_UBUF) + (long)((cgi * 4 + hh) * 2 + dir) * 8192;
    bf16x8 qf[2], kf[2][4], vf[8], sf[8];
#pragma unroll
    for (int ks = 0; ks < 2; ++ks) qf[ks] = *(const bf16x8*)(QE + (long)(16 * slab + r16) * 256 + ks * 32);
#pragma unroll
    for (int ks = 0; ks < 2; ++ks)
#pragma unroll
      for (int j = 0; j < 4; ++j) kf[ks][j] = *(const bf16x8*)(KE + (long)(16 * j + r16) * 256 + ks * 32);
#pragma unroll
    for (int j = 0; j < 8; ++j) {
      vf[j] = *(const bf16x8*)(gvt + (long)(16 * j) * T);
      sf[j] = *(const bf16x8*)(S + (16 * j + r16) * 64 + q4 * 8);
    }
    __builtin_amdgcn_sched_barrier(0);
    f32x4 a[4];
#pragma unroll
    for (int j = 0; j < 4; ++j) a[j] = f32x4{0.f, 0.f, 0.f, 0.f};
#pragma unroll
    for (int ks = 0; ks < 2; ++ks)
#pragma unroll
      for (int j = 0; j < 4; ++j) a[j] = __builtin_amdgcn_mfma_f32_16x16x32_bf16(qf[ks], kf[ks][j], a[j], 0, 0, 0);
    __builtin_amdgcn_wave_barrier();
    bf16_t* As = (bf16_t*)wsm;
#pragma unroll
    for (int j = 0; j < 4; ++j)
#pragma unroll
      for (int r = 0; r < 4; ++r) {
        int il = 4 * q4 + r, i = 16 * slab + il, jj = 16 * j + r16;
        bool keep = dir ? (jj >= i) : (jj <= i);
        As[il * 72 + jj] = f2b(keep ? a[j][r] : 0.f);
      }
    __builtin_amdgcn_wave_barrier();
    asm volatile("s_waitcnt lgkmcnt(0)" ::: "memory");
    bf16x8 af[2];
#pragma unroll
    for (int ks = 0; ks < 2; ++ks) af[ks] = *(const bf16x8*)(wsm + r16 * GROW + (ks * 32 + q4 * 8) * 2);
    bf16x8 vf2[8], sf2[8];
#pragma unroll
    for (int j = 0; j < 8; ++j) {
      vf2[j] = *(const bf16x8*)(gvt + (long)(16 * j) * T + 32);
      sf2[j] = *(const bf16x8*)(S + (16 * j + r16) * 64 + 32 + q4 * 8);
    }
    __builtin_amdgcn_sched_barrier(0);
#pragma unroll
    for (int j = 0; j < 8; ++j) {
      o[j] = __builtin_amdgcn_mfma_f32_16x16x32_bf16(af[0], vf[j], o[j], 0, 0, 0);
      o[j] = __builtin_amdgcn_mfma_f32_16x16x32_bf16(qf[0], sf[j], o[j], 0, 0, 0);
    }
    __builtin_amdgcn_sched_barrier(0);
#pragma unroll
    for (int j = 0; j < 8; ++j) {
      o[j] = __builtin_amdgcn_mfma_f32_16x16x32_bf16(af[1], vf2[j], o[j], 0, 0, 0);
      o[j] = __builtin_amdgcn_mfma_f32_16x16x32_bf16(qf[1], sf2[j], o[j], 0, 0, 0);
    }
    __builtin_amdgcn_sched_barrier(0);
  }
  float gv[8][4];
#pragma unroll
  for (int j = 0; j < 8; ++j)
#pragma unroll
    for (int r = 0; r < 4; ++r) gv[j][r] = b2f(og[(long)(t0 + 16 * slab + 4 * q4 + r) * 512 + hh * 128 + 16 * j + r16]);
  __builtin_amdgcn_sched_barrier(0);
  float ss[4];
#pragma unroll
  for (int r = 0; r < 4; ++r) {
    float sq = 0.f;
#pragma unroll
    for (int j = 0; j < 8; ++j) sq += o[j][r] * o[j][r];
    sq += __shfl_xor(sq, 1); sq += __shfl_xor(sq, 2); sq += __shfl_xor(sq, 4); sq += __shfl_xor(sq, 8);
    ss[r] = rsqrtf(sq * (1.f / 128.f) + EPS);
  }
  bf16_t* mixin = (bf16_t*)(p.ws + OFF_MIXIN);
#pragma unroll
  for (int j = 0; j < 8; ++j) {
    const int v = 16 * j + r16;
    const float gw = p.gla_norm_w[v];
#pragma unroll
    for (int r = 0; r < 4; ++r) {
      const int tok = t0 + 16 * slab + 4 * q4 + r;
      float g = gv[j][r];
      float val = o[j][r] * ss[r] * gw * (g / (1.f + fexp(-g)));
      mixin[(long)tok * 1024 + hh * 128 + v] = f2b(val);
    }
  }
}

DI void gla_g3_block(const P& p, int cgi, int hh, char* smem) {
  constexpr int O_QE = 0, O_KE = 9216, O_S = 18432, DIRB = 36864, O_VT = 73728, O_AS = 92160;
  const int tid = threadIdx.x, lane = tid & 63, w = __builtin_amdgcn_readfirstlane(tid >> 6), dir = w >> 2, slab = w & 3;
  const int r16 = lane & 15, q4 = lane >> 4;
  const int t0 = cgi * 64;
  const int row8 = tid >> 3, kc = tid & 7;
  const bf16_t* outb = (const bf16_t*)p.out;
  u4 ld[10];
  {
    const long qoff = (long)(t0 + row8) * 256 + hh * 64 + kc * 8;
    ld[0] = *(const u4*)((const bf16_t*)((const char*)outb + OUT_QEF) + qoff);
    ld[1] = *(const u4*)((const bf16_t*)((const char*)outb + OUT_KEF) + qoff);
    ld[4] = *(const u4*)((const bf16_t*)((const char*)outb + OUT_QEB) + qoff);
    ld[5] = *(const u4*)((const bf16_t*)((const char*)outb + OUT_KEB) + qoff);
    const bf16_t* S0 = (const bf16_t*)(p.ws + OFF_UBUF) + (long)((cgi * 4 + hh) * 2) * 8192 + row8 * 64 + kc * 8;
    ld[2] = *(const u4*)(S0);
    ld[3] = *(const u4*)(S0 + 64 * 64);
    ld[6] = *(const u4*)(S0 + 8192);
    ld[7] = *(const u4*)(S0 + 8192 + 64 * 64);
    const bf16_t* gvt = (const bf16_t*)(p.ws + OFF_GV) + (long)(hh * 128 + row8) * T + t0 + kc * 8;
    ld[8] = *(const u4*)(gvt);
    ld[9] = *(const u4*)(gvt + (long)64 * T);
  }
  __syncthreads();
  {
    const int so = row8 * GROW + kc * 16;
    *(u4*)(smem + O_QE + so) = ld[0];
    *(u4*)(smem + O_KE + so) = ld[1];
    *(u4*)(smem + O_S + so) = ld[2];
    *(u4*)(smem + O_S + 64 * GROW + so) = ld[3];
    *(u4*)(smem + DIRB + O_QE + so) = ld[4];
    *(u4*)(smem + DIRB + O_KE + so) = ld[5];
    *(u4*)(smem + DIRB + O_S + so) = ld[6];
    *(u4*)(smem + DIRB + O_S + 64 * GROW + so) = ld[7];
    *(u4*)(smem + O_VT + so) = ld[8];
    *(u4*)(smem + O_VT + 64 * GROW + so) = ld[9];
  }
  __syncthreads();
  const char* base = smem + dir * DIRB;
  f32x4 o[8];
#pragma unroll
  for (int j = 0; j < 8; ++j) o[j] = f32x4{0.f, 0.f, 0.f, 0.f};
  bf16x8 qf[2];
#pragma unroll
  for (int ks = 0; ks < 2; ++ks) qf[ks] = *(const bf16x8*)(base + O_QE + (16 * slab + r16) * GROW + (ks * 32 + q4 * 8) * 2);
  {
    f32x4 a[4];
#pragma unroll
    for (int j = 0; j < 4; ++j) a[j] = f32x4{0.f, 0.f, 0.f, 0.f};
#pragma unroll
    for (int ks = 0; ks < 2; ++ks)
#pragma unroll
      for (int j = 0; j < 4; ++j) {
        bf16x8 kf = *(const bf16x8*)(base + O_KE + (16 * j + r16) * GROW + (ks * 32 + q4 * 8) * 2);
        a[j] = __builtin_amdgcn_mfma_f32_16x16x32_bf16(qf[ks], kf, a[j], 0, 0, 0);
      }
    bf16_t* As = (bf16_t*)(smem + O_AS + dir * 9216);
#pragma unroll
    for (int j = 0; j < 4; ++j)
#pragma unroll
      for (int r = 0; r < 4; ++r) {
        int i = 16 * slab + 4 * q4 + r, jj = 16 * j + r16;
        bool keep = dir ? (jj >= i) : (jj <= i);
        As[i * 72 + jj] = f2b(keep ? a[j][r] : 0.f);
      }
  }
  __builtin_amdgcn_wave_barrier();
  asm volatile("s_waitcnt lgkmcnt(0)" ::: "memory");
#pragma unroll
  for (int ks = 0; ks < 2; ++ks) {
    bf16x8 af = *(const bf16x8*)(smem + O_AS + dir * 9216 + (16 * slab + r16) * GROW + (ks * 32 + q4 * 8) * 2);
#pragma unroll
    for (int j = 0; j < 8; ++j) {
      bf16x8 vf = *(const bf16x8*)(smem + O_VT + (16 * j + r16) * GROW + (ks * 32 + q4 * 8) * 2);
      o[j] = __builtin_amdgcn_mfma_f32_16x16x32_bf16(af, vf, o[j], 0, 0, 0);
      bf16x8 sf = *(const bf16x8*)(base + O_S + (16 * j + r16) * GROW + (ks * 32 + q4 * 8) * 2);
      o[j] = __builtin_amdgcn_mfma_f32_16x16x32_bf16(qf[ks], sf, o[j], 0, 0, 0);
    }
  }
  __syncthreads();
  float* ob = (float*)smem;
  if (dir == 1) {
#pragma unroll
    for (int j = 0; j < 8; ++j)
#pragma unroll
      for (int r = 0; r < 4; ++r) ob[(16 * slab + 4 * q4 + r) * 132 + 16 * j + r16] = o[j][r];
  }
  float gv[8][4];
  if (dir == 0) {
    const bf16_t* og = (const bf16_t*)(p.ws + OFF_OG);
#pragma unroll
    for (int j = 0; j < 8; ++j)
#pragma unroll
      for (int r = 0; r < 4; ++r) gv[j][r] = b2f(og[(long)(t0 + 16 * slab + 4 * q4 + r) * 512 + hh * 128 + 16 * j + r16]);
  }
  __syncthreads();
  if (dir == 0) {
#pragma unroll
    for (int j = 0; j < 8; ++j)
#pragma unroll
      for (int r = 0; r < 4; ++r) o[j][r] += ob[(16 * slab + 4 * q4 + r) * 132 + 16 * j + r16];
    float ss[4];
#pragma unroll
    for (int r = 0; r < 4; ++r) {
      float sq = 0.f;
#pragma unroll
      for (int j = 0; j < 8; ++j) sq += o[j][r] * o[j][r];
      sq += __shfl_xor(sq, 1); sq += __shfl_xor(sq, 2); sq += __shfl_xor(sq, 4); sq += __shfl_xor(sq, 8);
      ss[r] = rsqrtf(sq * (1.f / 128.f) + EPS);
    }
    bf16_t* mixin = (bf16_t*)(p.ws + OFF_MIXIN);
#pragma unroll
    for (int j = 0; j < 8; ++j) {
      const int v = 16 * j + r16;
      const float gw = p.gla_norm_w[v];
#pragma unroll
      for (int r = 0; r < 4; ++r) {
        const int tok = t0 + 16 * slab + 4 * q4 + r;
        float g = gv[j][r];
        float val = o[j][r] * ss[r] * gw * (g / (1.f + fexp(-g)));
        mixin[(long)tok * 1024 + hh * 128 + v] = f2b(val);
      }
    }
  }
}

DI void gla_scan_item(const P& p, int cbase, int nch, int hh, int dir, int sub) {
  const int e = (sub * 256 + VT) * 2;
  const int d = e & 63;
  bf16_t* U = (bf16_t*)(p.ws + OFF_UBUF);
  const float* dec = (const float*)(p.ws + OFF_DEC);
  float st0 = 0.f, st1 = 0.f;
  for (int n0 = 0; n0 < nch; n0 += 32) {
    unsigned u[32]; u2 dc[32];
#pragma unroll
    for (int j = 0; j < 32; ++j) {
      int n = n0 + j;
      int cgi = cbase + (dir ? nch - 1 - n : n);
      long base = (long)((cgi * 4 + hh) * 2 + dir);
      u[j] = *(const unsigned*)(U + base * 8192 + e);
      dc[j] = *(const u2*)(dec + base * 64 + d);
    }
#pragma unroll
    for (int j = 0; j < 32; ++j) {
      int n = n0 + j;
      int cgi = cbase + (dir ? nch - 1 - n : n);
      long base = (long)((cgi * 4 + hh) * 2 + dir);
      *(unsigned*)(U + base * 8192 + e) = pk2(st0, st1);
      st0 = __uint_as_float(dc[j].x) * st0 + blo(u[j]);
      st1 = __uint_as_float(dc[j].y) * st1 + bhi(u[j]);
    }
  }
}

DI void phase_rope_g1(const P& p, char* smem) {
  _Pragma("nounroll") for (int rp = 0; rp < REPG1; ++rp)
  for (int b0 = 0; b0 < NCHUNK * 4; b0 += VN) { int it = min(b0 + VB, NCHUNK * 4 - 1); gla_g1_item(p, it >> 2, it & 3, smem); }
}

DI void phase_attn_scan(const P& p, char* smem_block, int rep) {
  const int NSCAN_P = 128, NSCAN_S = 4096, NATT_P = 512, NATT_S = 2048;
  const float c = 0.125f * LOG2E;
  if (!rep) {
    for (int it = VB; it < NSCAN_P + NSCAN_S; it += VN) {
      if (it < NSCAN_P) {
        int sub = it & 15, ch = it >> 4;
        gla_scan_item(p, 0, 256, ch >> 1, ch & 1, sub);
      } else {
        int i2 = it - NSCAN_P;
        int sub = i2 & 15, ch = i2 >> 4;
        int sq = ch >> 3;
        gla_scan_item(p, 256 + sq * 32, 32, (ch >> 1) & 3, ch & 1, sub);
      }
    }
  }
  for (int i3 = blockIdx.x; i3 < NATT_P + NATT_S; i3 += gridDim.x) {
    int vh, qb, sq, nkeys;
    if (i3 < NATT_P) { vh = i3 & 7; qb = i3 >> 3; sq = 0; nkeys = TP; }
    else { int i4 = i3 - NATT_P; vh = i4 & 7; int rest = i4 >> 3; qb = rest & 7; sq = 1 + (rest >> 3); nkeys = SS; }
    const int ts = seq_start(sq);
    const int tq = ts + qb * 256;
    const bf16_t* Q = (const bf16_t*)(p.ws + OFF_DQ) + (long)tq * 512 + vh * 64;
    const bf16_t* K = (const bf16_t*)(p.ws + OFF_DK) + (long)ts * 512 + vh * 64;
    const bf16_t* Vt = (const bf16_t*)(p.ws + OFF_DVT) + (long)((vh >> 1) * 128) * T + ts;
    bf16_t* O = (bf16_t*)(p.ws + OFF_ODIFF) + (long)tq * 1024 + vh * 128;
    flash256_item<64>(Q, 512, K, 512, Vt, (long)T, nkeys, c, O, 1024, smem_block);
  }
}

DI void phase_g3_combine(const P& p, char* smem_block) {
  _Pragma("nounroll") for (int rp = 0; rp < REPG3; ++rp)
  for (int it = blockIdx.x; it < NCHUNK * 4; it += gridDim.x) gla_g3_block(p, it >> 2, it & 3, smem_block);
  const int lane = VT & 63;
  float lam;
  {
    float a = p.lq1[lane] * p.lk1[lane], b = p.lq2[lane] * p.lk2[lane];
    a = wave_sum(a); b = wave_sum(b);
    lam = expf(a) - expf(b) + 0.2f;
  }
  const float post = 1.f - 0.2f;
  const bf16_t* od = (const bf16_t*)(p.ws + OFF_ODIFF);
  bf16_t* mixin = (bf16_t*)(p.ws + OFF_MIXIN);
  const int hh = lane >> 4, c8 = (lane & 15) * 8;
  float sw[8];
#pragma unroll
  for (int j = 0; j < 8; ++j) sw[j] = p.subln_w[c8 + j] * post;
  _Pragma("nounroll") for (int rp = 0; rp < REPCMB; ++rp)
  for (int t = VB * 4 + (VT >> 6); t < T; t += VN * 4) {
    u4 a = *(const u4*)(od + (long)t * 1024 + (hh * 2) * 128 + c8);
    u4 b = *(const u4*)(od + (long)t * 1024 + (hh * 2 + 1) * 128 + c8);
    float v[8];
    v[0] = blo(a.x) - lam * blo(b.x); v[1] = bhi(a.x) - lam * bhi(b.x);
    v[2] = blo(a.y) - lam * blo(b.y); v[3] = bhi(a.y) - lam * bhi(b.y);
    v[4] = blo(a.z) - lam * blo(b.z); v[5] = bhi(a.z) - lam * bhi(b.z);
    v[6] = blo(a.w) - lam * blo(b.w); v[7] = bhi(a.w) - lam * bhi(b.w);
    float s = 0.f;
#pragma unroll
    for (int j = 0; j < 8; ++j) s += v[j] * v[j];
    s += __shfl_xor(s, 1); s += __shfl_xor(s, 2); s += __shfl_xor(s, 4); s += __shfl_xor(s, 8);
    float rs = rsqrtf(s * (1.f / 128.f) + EPS);
    u4 pk;
    pk.x = pk2(v[0] * rs * sw[0], v[1] * rs * sw[1]);
    pk.y = pk2(v[2] * rs * sw[2], v[3] * rs * sw[3]);
    pk.z = pk2(v[4] * rs * sw[4], v[5] * rs * sw[5]);
    pk.w = pk2(v[6] * rs * sw[6], v[7] * rs * sw[7]);
    *(u4*)(mixin + (long)t * 1024 + 512 + hh * 128 + c8) = pk;
  }
}

template <int WHICH>
DI void phase_rows(const P& p) {
  const int lane = VT & 63;
  const bf16_t* mix = (const bf16_t*)(p.ws + OFF_MIX);
  bf16_t* hb = (bf16_t*)(p.ws + OFF_HBUF);
  for (int tg = VB * 4 + (VT >> 6); tg < T / NR; tg += VN * 4) {
    const int t = tg * NR;
    char* xo = (char*)(p.out + (long)t * 1024);
    char* xres = xo + 2048;
    const bf16_t* m = mix + (long)t * 1024;
    bf16_t* h = hb + (long)t * 1024;
    if (WHICH == 0) {
      const float* xin = t < TP ? p.xp + (long)t * 1024 : p.xs + (long)(t - TP) * 1024;
      row_resid_xn<true, false>((const char*)xin, 4096, m, p.norm_mix_post, p.norm_x_pre, xres, 4096, h, lane);
    } else if (WHICH == 1) {
      row_resid_xn<false, false>(xres, 4096, m, p.norm_x_post, p.norm_f_pre, xres, 4096, h, lane);
    } else {
      row_resid_xn<false, true>(xres, 4096, m, p.norm_f_post, nullptr, xo, 4096, nullptr, lane);
    }
  }
}

DI void phase_xq_xattn(const P& p, char* smem) {
  char* ws = p.ws;
  const bf16_t* A = (const bf16_t*)(ws + OFF_HBUF);
  const bf16_t* B = (const bf16_t*)(ws + OFF_WXQ);
  const float c = 0.0625f * LOG2E;
  for (int L = blockIdx.x; L < (T / 256) * 4; L += gridDim.x) {
    int tidx = threadIdx.x;
    asm volatile("" : "+v"(tidx));
    const int wid = __builtin_amdgcn_readfirstlane(tidx >> 6), lane = tidx & 63, wr = wid >> 2, wc = wid & 3;
    int fr = lane & 15, fq = lane >> 4;
    int pm, pn;
    g8_unit(L, T / 256, 4, pm, pn);
    const int m0 = pm * 256;
    bf16x8 qf[16];
    {
      f32x4 acc[2][2][4][2];
      g8_tile<true>(A, B, 1024, m0, pn * 256, (bf16_t*)smem, acc, tidx, false);
      asm volatile("" : "+v"(fr), "+v"(fq));
#pragma unroll
      for (int ai = 0; ai < 2; ++ai)
#pragma unroll
        for (int bj = 0; bj < 2; ++bj)
#pragma unroll
          for (int m = 0; m < 4; ++m)
#pragma unroll
            for (int n = 0; n < 2; ++n) {
              const int row = ai * 128 + wr * 64 + m * 16 + fr;
              f32x4 v = acc[ai][bj][m][n];
              u2 pk; pk.x = pk2(v[0], v[1]); pk.y = pk2(v[2], v[3]);
              const int chunk = bj * 16 + wc * 4 + n * 2 + (fq >> 1);
              *(u2*)(smem + row * 512 + ((chunk ^ (row & 31)) << 4) + (fq & 1) * 8) = pk;
            }
    }
    __syncthreads();
    {
      const int row = wid * 32 + (lane & 31), hh = lane >> 5;
#pragma unroll
      for (int ks = 0; ks < 16; ++ks) qf[ks] = *(const bf16x8*)(smem + row * 512 + (((2 * ks + hh) ^ (row & 31)) << 4));
    }
    __syncthreads();
    const int sq = seq_of_token(m0);
    const bf16_t* K = (const bf16_t*)(ws + OFF_KX) + (long)(sq * 256) * 1024 + pn * 256;
#pragma unroll
    for (int half = 0; half < 2; ++half) {
      const bf16_t* Vt = (const bf16_t*)(ws + OFF_VXT) + (long)(pn * 256 + half * 128) * MT + sq * 256;
      bf16_t* O = (bf16_t*)(ws + OFF_XOIN) + (long)m0 * 1024 + pn * 256 + half * 128;
      flash256x_core<256>(qf, K, 1024, Vt, (long)MT, 256, c, O, 1024, smem);
    }
  }
}

constexpr int NPH = 14;

#define XB_TMO      128
#define XB_XCNT(j)  (256  + 64 * (j))
#define XB_XSUB(j)  (1280 + 64 * (j))
#define XB_XGEN(j)  (2304 + 64 * (j))
#define XB_TOP      3328
#define XB_TOPGEN   3392
#define XCD_BAR_WORDS 3456
#define XB_SPIN_CAP (1u << 18)
#define LAS __attribute__((address_space(3)))

__device__ __forceinline__ unsigned xb_ld(unsigned* p)              { return __hip_atomic_load(p, __ATOMIC_RELAXED, __HIP_MEMORY_SCOPE_AGENT); }
__device__ __forceinline__ unsigned xb_add(unsigned* p, unsigned v) { return __hip_atomic_fetch_add(p, v, __ATOMIC_RELAXED, __HIP_MEMORY_SCOPE_AGENT); }
__device__ __forceinline__ unsigned xb_xcc_id() { return (unsigned)__builtin_amdgcn_s_getreg((3 << 11) | 20) & 0xFu; }
#define XB_SPIN(cond, bar) do { unsigned _sp = 0; while (cond) { __builtin_amdgcn_s_sleep(1); \
    if ((++_sp & 255u) == 0u) { if (xb_ld(&(bar)[XB_TMO])) break; if (_sp > XB_SPIN_CAP) { atomicAdd(&(bar)[XB_TMO], 1u); break; } } } } while (0)

struct XcdBarrier {
    unsigned* bar; unsigned x;
    volatile LAS unsigned* st;
};

__device__ __forceinline__ XcdBarrier xcd_barrier_post(unsigned* bar, volatile LAS unsigned* st) {
    XcdBarrier b; b.bar = bar; b.x = xb_xcc_id(); b.st = st;
    if (threadIdx.x == 0) (void)xb_add(&bar[XB_XCNT(b.x)], 1u);
    return b;
}
__device__ __forceinline__ void xcd_barrier_complete(unsigned* bar, unsigned x, unsigned& nloc, unsigned& nx) {
    const unsigned G = gridDim.x * gridDim.y * gridDim.z;
    unsigned sum, cnt, mine, sp = 0u;
    for (;;) {
        sum = 0u; cnt = 0u; mine = 0u;
#pragma unroll
        for (unsigned j = 0; j < 16; ++j) { const unsigned c = xb_ld(&bar[XB_XCNT(j)]); sum += c; cnt += (c > 0u) ? 1u : 0u; mine = (j == x) ? c : mine; }
        if (sum == G) break;
        __builtin_amdgcn_s_sleep(1);
        if ((++sp & 255u) == 0u) { if (xb_ld(&bar[XB_TMO])) break; if (sp > XB_SPIN_CAP) { atomicAdd(&bar[XB_TMO], 1u); break; } }
    }
    nloc = mine > 0u ? mine : 1u; nx = cnt > 0u ? cnt : 1u;
}

__device__ __forceinline__ void xcd_barrier(const XcdBarrier& b) {
    asm volatile("s_waitcnt vmcnt(0)" ::: "memory");
    __syncthreads();
    if (threadIdx.x == 0) {
        unsigned* bar = b.bar;
        __builtin_amdgcn_s_waitcnt(0);
        unsigned nloc = b.st[0], nx = b.st[1];
        if (nloc == 0u) { xcd_barrier_complete(bar, b.x, nloc, nx); b.st[0] = nloc; b.st[1] = nx; }
        const unsigned old = xb_add(&bar[XB_XSUB(b.x)], 1u);
        const unsigned gen = old / nloc;
        if (old + 1u == (gen + 1u) * nloc) {
            __builtin_amdgcn_fence(__ATOMIC_RELEASE, "agent");
            asm volatile("s_waitcnt vmcnt(0)" ::: "memory");
            const unsigned og = xb_add(&bar[XB_TOP], 1u);
            const unsigned tg = og / nx;
            if (og + 1u == (tg + 1u) * nx) xb_add(&bar[XB_TOPGEN], 1u);
            else XB_SPIN(xb_ld(&bar[XB_TOPGEN]) == tg, bar);
            __builtin_amdgcn_fence(__ATOMIC_ACQUIRE, "agent");
            xb_add(&bar[XB_XGEN(b.x)], 1u);
            asm volatile("s_waitcnt vmcnt(0)" ::: "memory");
        } else {
            XB_SPIN(xb_ld(&bar[XB_XGEN(b.x)]) == gen, bar);
            __builtin_amdgcn_fence(__ATOMIC_ACQUIRE, "agent");
            asm volatile("s_waitcnt vmcnt(0)" ::: "memory");
        }
    }
    __syncthreads();
}


DI unsigned long long uni64(unsigned long long v) {
  unsigned lo = __builtin_amdgcn_readfirstlane((unsigned)v), hi = __builtin_amdgcn_readfirstlane((unsigned)(v >> 32));
  return ((unsigned long long)hi << 32) | lo;
}
#define UNI_F(field) lp.field = (const float*)(const __attribute__((address_space(1))) float*)uni64((unsigned long long)lp.field);
DI void uniformize(P& lp) {
  UNI_F(xp) UNI_F(xs) UNI_F(memp) UNI_F(mems)
  UNI_F(norm_mix_pre) UNI_F(w_in) UNI_F(w_gu_f) UNI_F(b_g_f) UNI_F(w_gu_b) UNI_F(b_g_b) UNI_F(gla_norm_w)
  UNI_F(lq1) UNI_F(lk1) UNI_F(lq2) UNI_F(lk2) UNI_F(subln_w) UNI_F(w_out) UNI_F(norm_mix_post) UNI_F(norm_x_pre) UNI_F(norm_mem)
  UNI_F(w_xq) UNI_F(w_xkv) UNI_F(w_xo) UNI_F(norm_x_post) UNI_F(norm_f_pre) UNI_F(w_fg) UNI_F(w_fu) UNI_F(w_fd) UNI_F(norm_f_post)
  lp.out = (float*)(__attribute__((address_space(1))) float*)uni64((unsigned long long)lp.out);
  lp.ws = (char*)(__attribute__((address_space(1))) char*)uni64((unsigned long long)lp.ws);
}

template <int PH>
DI void run_phase(const P& p, char* smem, int rep) {
  char* ws = p.ws;
  if constexpr (PH == 0) phase_prep(p, smem + (threadIdx.x >> 8) * 65536);
  else if constexpr (PH == 2) phase_rope_g1(p, smem + (threadIdx.x >> 8) * 65536);
  else if constexpr (PH == 3) phase_attn_scan(p, smem, rep);
  else if constexpr (PH == 4) phase_g3_combine(p, smem);
  else if constexpr (PH == 6) phase_rows<0>(p);
  else if constexpr (PH == 8) {   }
  else if constexpr (PH == 10) phase_rows<1>(p);
  else if constexpr (PH == 13) phase_rows<2>(p);
  else if constexpr (PH == 1) {
    const Job j0{(const bf16_t*)(ws + OFF_HBUF), (const bf16_t*)(ws + OFF_WIN), nullptr, 1024, T / 256, NIN / 256, 0};
    const Job j1{(const bf16_t*)(ws + OFF_MBUF), (const bf16_t*)(ws + OFF_WXKV), nullptr, 1024, MT / 256, 8, 1};
    const int n0 = j0.mtiles * j0.ntiles, n1 = j1.mtiles * j1.ntiles;
    const int G = gridDim.x;
    bool pre = false;
    for (int L = blockIdx.x; L < n0 + n1; L += G) {
      const bool first = L < n0;
      Job jb;
      jb.A = first ? j0.A : j1.A; jb.B = first ? j0.B : j1.B; jb.dst = nullptr; jb.K = 1024;
      jb.mtiles = first ? j0.mtiles : j1.mtiles; jb.ntiles = first ? j0.ntiles : j1.ntiles; jb.mode = first ? 0 : 1;
      const int L2 = L + G;
      const bool hn = L2 < n0 + n1;
      const bool first2 = L2 < n0;
      Job jn;
      jn.A = first2 ? j0.A : j1.A; jn.B = first2 ? j0.B : j1.B; jn.dst = nullptr; jn.K = 1024;
      jn.mtiles = first2 ? j0.mtiles : j1.mtiles; jn.ntiles = first2 ? j0.ntiles : j1.ntiles; jn.mode = first2 ? 0 : 1;
      run_gemm_unit(p, jb, first ? L : L - n0, smem, pre, hn, jn, first2 ? L2 : L2 - n0);
      pre = hn;
    }
  }
  else if constexpr (PH == 5) run_gemm_job(p, Job{(const bf16_t*)(ws + OFF_MIXIN), (const bf16_t*)(ws + OFF_WOUT), (bf16_t*)(ws + OFF_MIX), 1024, T / 256, 4, 2}, smem);
  else if constexpr (PH == 7) phase_xq_xattn(p, smem);
  else if constexpr (PH == 9) run_gemm_job(p, Job{(const bf16_t*)(ws + OFF_XOIN), (const bf16_t*)(ws + OFF_WXO), (bf16_t*)(ws + OFF_MIX), 1024, T / 256, 4, 2}, smem);
  else if constexpr (PH == 11) run_gemm_job(p, Job{(const bf16_t*)(ws + OFF_HBUF), (const bf16_t*)(ws + OFF_WGU), (bf16_t*)(ws + OFF_ACT), 1024, T / 256, 22, 3}, smem);
  else if constexpr (PH == 12) run_gemm_job(p, Job{(const bf16_t*)(ws + OFF_ACT), (const bf16_t*)(ws + OFF_WDN), (bf16_t*)(ws + OFF_MIX), DFF, T / 256, 4, 2}, smem);
}

constexpr int LDS_BYTES = 131072;
__global__ void __launch_bounds__(512, 2) mega(P p, int ph_lo, int ph_hi) {
  extern __shared__ __attribute__((aligned(16))) char smem[];
  __shared__ u4 xb_words;
  if (threadIdx.x == 0) xb_words = u4{0u, 0u, 0u, 0u};
  __syncthreads();
  XcdBarrier xb = xcd_barrier_post((unsigned*)(p.ws + OFF_BAR), (volatile LAS unsigned*)&xb_words);
  if (ph_lo < 0) cg::this_grid().sync();
#define PHASE(n)                                          \
  if (PHSEL < 0 || PHSEL == n) {                          \
    if (ph_lo <= n && n < ph_hi) {                        \
      if (n > ph_lo) xcd_barrier(xb);                     \
      if (n == 1) { _Pragma("nounroll") for (int xs = 0; xs < XSYNC; ++xs) xcd_barrier(xb); } \
      const __attribute__((address_space(4))) char* kp = (const __attribute__((address_space(4))) char*)__builtin_amdgcn_kernarg_segment_ptr(); \
      asm volatile("" : "+s"(kp));                        \
      P lp;                                               \
      __builtin_memcpy(&lp, kp, sizeof(P));               \
      uniformize(lp);                                     \
      _Pragma("nounroll") for (int rep = 0; rep < (((REPMASK >> n) & 1) ? 2 : 1); ++rep) run_phase<n>(lp, smem, rep); \
    }                                                     \
  }
  PHASE(0) PHASE(1) PHASE(2) PHASE(3) PHASE(4) PHASE(5) PHASE(6) PHASE(7) PHASE(9) PHASE(10) PHASE(11) PHASE(12) PHASE(13)
}

extern "C" void kernel_launch(void* const* d_in, const int* in_sizes, int n_in, void* d_out, int out_size, void* d_ws,
                              size_t ws_size, hipStream_t stream) {
  static int grid_blocks = 0;
  if (!grid_blocks) {
    int dev = 0, cus = 0, per_cu = 0;
    hipGetDevice(&dev);
    hipDeviceGetAttribute(&cus, hipDeviceAttributeMultiprocessorCount, dev);
    hipFuncSetAttribute((const void*)mega, hipFuncAttributeMaxDynamicSharedMemorySize, LDS_BYTES);
    hipOccupancyMaxActiveBlocksPerMultiprocessor(&per_cu, mega, 512, LDS_BYTES);
    if (per_cu < 1) per_cu = 1;
    grid_blocks = cus * per_cu;
  }
  P p{};
  const float** f = (const float**)&p;
  for (int i = 0; i < 29; ++i) f[i] = (const float*)d_in[i];
  p.out = (float*)d_out;
  p.ws = (char*)d_ws;
#if MEGA
  hipMemsetAsync((char*)d_ws + OFF_BAR, 0, 16384, stream);
  int lo = 0, hi = NPH;
  void* args[] = {&p, &lo, &hi};
  hipError_t e = hipLaunchCooperativeKernel((void*)mega, dim3(grid_blocks), dim3(512), args, LDS_BYTES, stream);
  if (e != hipSuccess) fprintf(stderr, "cooperative launch failed: %s (grid %d)\n", hipGetErrorString(e), grid_blocks);
#else
  for (int ph = 0; ph < NPH; ++ph) hipLaunchKernelGGL(mega, dim3(grid_blocks), dim3(512), LDS_BYTES, stream, p, ph, ph + 1);
#endif
}
```

```cpp
#include <hip/hip_runtime.h>
#include <hip/hip_cooperative_groups.h>
#include <stdint.h>
#include <cstdio>
namespace cg = cooperative_groups;

#ifndef MEGA
#define MEGA 1
#endif
#ifndef PHSEL
#define PHSEL -1
#endif
#ifndef REPMASK
#define REPMASK 0
#endif
#ifndef REPG3
#define REPG3 1
#endif
#ifndef REPG1
#define REPG1 1
#endif
#ifndef XSYNC
#define XSYNC 0
#endif
#ifndef REPCMB
#define REPCMB 1
#endif

typedef unsigned short bf16_t;
using bf16x8 = __attribute__((ext_vector_type(8))) short;
using bf16x4 = __attribute__((ext_vector_type(4))) short;
using f32x4 = __attribute__((ext_vector_type(4))) float;
using u4 = __attribute__((ext_vector_type(4))) unsigned;
using u2 = __attribute__((ext_vector_type(2))) unsigned;
using f4 = __attribute__((ext_vector_type(4))) float;
using f32x16 = __attribute__((ext_vector_type(16))) float;
typedef __attribute__((ext_vector_type(2))) __bf16 bf2_t;
#define DI __device__ __forceinline__
#define VT ((int)(threadIdx.x & 255))
#define VB ((int)(blockIdx.x * 2 + (threadIdx.x >> 8)))
#define VN ((int)(gridDim.x * 2))

DI unsigned pk2(float a, float b) { bf2_t v; v[0] = (__bf16)a; v[1] = (__bf16)b; return __builtin_bit_cast(unsigned, v); }
DI bf16_t f2b(float a) { return __builtin_bit_cast(unsigned short, (__bf16)a); }
DI float b2f(unsigned b) { return __uint_as_float(b << 16); }
DI float blo(unsigned u) { return __uint_as_float(u << 16); }
DI float bhi(unsigned u) { return __uint_as_float(u & 0xffff0000u); }
DI float half_swap_max(float x) {
  auto rr = __builtin_amdgcn_permlane32_swap(__float_as_uint(x), __float_as_uint(x), false, false);
  return fmaxf(__uint_as_float(rr[0]), __uint_as_float(rr[1]));
}
DI float half_swap_sum(float x) {
  auto rr = __builtin_amdgcn_permlane32_swap(__float_as_uint(x), __float_as_uint(x), false, false);
  return __uint_as_float(rr[0]) + __uint_as_float(rr[1]);
}
DI float wave_sum(float v) {
#pragma unroll
  for (int o = 32; o > 0; o >>= 1) v += __shfl_xor(v, o);
  return v;
}

constexpr int T = 81920, TP = 16384, SS = 2048, D = 1024, MT = 8448, DFF = 2816;
constexpr int NCHUNK = T / 64;
constexpr int NIN = 3328;
constexpr float EPS = 1e-6f;
constexpr float LOG2E = 1.4426950408889634f;

constexpr size_t OFF_WIN = 0;
constexpr size_t OFF_WOUT = OFF_WIN + (size_t)NIN * 1024 * 2;
constexpr size_t OFF_WXQ = OFF_WOUT + 1024 * 1024 * 2;
constexpr size_t OFF_WXO = OFF_WXQ + 1024 * 1024 * 2;
constexpr size_t OFF_WXKV = OFF_WXO + 1024 * 1024 * 2;
constexpr size_t OFF_WGU = OFF_WXKV + 2048 * 1024 * 2;
constexpr size_t OFF_WDN = OFF_WGU + (size_t)5632 * 1024 * 2;
constexpr size_t OFF_HBUF = OFF_WDN + (size_t)1024 * 2816 * 2;
constexpr size_t OFF_GQ = OFF_HBUF + (size_t)T * 1024 * 2;
constexpr size_t OFF_GK = OFF_GQ + (size_t)T * 256 * 2;
constexpr size_t OFF_GV = OFF_GK + (size_t)T * 256 * 2;
constexpr size_t OFF_OG = OFF_GV + (size_t)T * 512 * 2;
constexpr size_t OFF_DQ = OFF_OG + (size_t)T * 512 * 2;
constexpr size_t OFF_DK = OFF_DQ + (size_t)T * 512 * 2;
constexpr size_t OFF_DVT = OFF_DK + (size_t)T * 512 * 2;
constexpr size_t OFF_GATES = OFF_DVT + (size_t)T * 512 * 2;
constexpr size_t OFF_UBUF = OFF_GATES + (size_t)T * 32 * 4;
constexpr size_t OFF_DEC = OFF_UBUF + (size_t)NCHUNK * 4 * 2 * 8192 * 2;
constexpr size_t OFF_MBUF = OFF_DEC + (size_t)NCHUNK * 4 * 2 * 64 * 4;
constexpr size_t OFF_KX = OFF_MBUF + (size_t)MT * 1024 * 2;
constexpr size_t OFF_VXT = OFF_KX + (size_t)MT * 1024 * 2;
constexpr size_t OFF_BAR = OFF_VXT + (size_t)MT * 1024 * 2;
constexpr size_t WS_END = OFF_BAR + 16384;
constexpr size_t OUT_QEF = 0;
constexpr size_t OUT_KEF = OUT_QEF + (size_t)T * 256 * 2;
constexpr size_t OUT_QEB = OUT_KEF + (size_t)T * 256 * 2;
constexpr size_t OUT_KEB = OUT_QEB + (size_t)T * 256 * 2;
constexpr size_t OFF_ODIFF = OFF_HBUF;
constexpr size_t OFF_MIXIN = OFF_DQ;
constexpr size_t OFF_MIX = OFF_UBUF;
constexpr size_t OFF_QX = OFF_MIXIN;
constexpr size_t OFF_XOIN = OFF_GQ;
constexpr size_t OFF_ACT = OFF_GQ;

struct P {
  const float *xp, *xs, *memp, *mems;
  const float *norm_mix_pre, *w_in, *w_gu_f, *b_g_f, *w_gu_b, *b_g_b, *gla_norm_w;
  const float *lq1, *lk1, *lq2, *lk2, *subln_w, *w_out, *norm_mix_post, *norm_x_pre, *norm_mem;
  const float *w_xq, *w_xkv, *w_xo, *norm_x_post, *norm_f_pre, *w_fg, *w_fu, *w_fd, *norm_f_post;
  float* out;
  char* ws;
};

DI int seq_start(int s) { return s == 0 ? 0 : TP + (s - 1) * SS; }
DI int seq_of_token(int t) { return t < TP ? 0 : 1 + (t - TP) / SS; }

DI void row_norm_bf16(const float* __restrict__ x, const float* __restrict__ w, bf16_t* __restrict__ out, int lane) {
  f4 v[4];
  float ss = 0.f;
#pragma unroll
  for (int i = 0; i < 4; ++i) {
    v[i] = ((const f4*)x)[i * 64 + lane];
    ss += v[i].x * v[i].x + v[i].y * v[i].y + v[i].z * v[i].z + v[i].w * v[i].w;
  }
  ss = wave_sum(ss);
  float rs = rsqrtf(ss * (1.f / 1024.f) + EPS);
#pragma unroll
  for (int i = 0; i < 4; ++i) {
    f4 ww = ((const f4*)w)[i * 64 + lane];
    u2 pk;
    pk.x = pk2(v[i].x * rs * ww.x, v[i].y * rs * ww.y);
    pk.y = pk2(v[i].z * rs * ww.z, v[i].w * rs * ww.w);
    ((u2*)out)[i * 64 + lane] = pk;
  }
}

template <bool XIN_F32, bool LAST>
DI void row_resid(const void* xin, const bf16_t* __restrict__ mix, const float* __restrict__ wpost,
                  const float* __restrict__ wnext, void* xout, bf16_t* __restrict__ hout, int lane) {
  f4 x[4], m[4];
  float ss = 0.f;
#pragma unroll
  for (int i = 0; i < 4; ++i) {
    if (XIN_F32) x[i] = ((const f4*)xin)[i * 64 + lane];
    else { u2 xu = ((const u2*)xin)[i * 64 + lane]; x[i].x = blo(xu.x); x[i].y = bhi(xu.x); x[i].z = blo(xu.y); x[i].w = bhi(xu.y); }
    u2 u = ((const u2*)mix)[i * 64 + lane];
    m[i].x = blo(u.x); m[i].y = bhi(u.x); m[i].z = blo(u.y); m[i].w = bhi(u.y);
    ss += m[i].x * m[i].x + m[i].y * m[i].y + m[i].z * m[i].z + m[i].w * m[i].w;
  }
  ss = wave_sum(ss);
  float rs = rsqrtf(ss * (1.f / 1024.f) + EPS);
  float ss1 = 0.f;
#pragma unroll
  for (int i = 0; i < 4; ++i) {
    f4 ww = ((const f4*)wpost)[i * 64 + lane];
    x[i].x += m[i].x * rs * ww.x; x[i].y += m[i].y * rs * ww.y;
    x[i].z += m[i].z * rs * ww.z; x[i].w += m[i].w * rs * ww.w;
    ss1 += x[i].x * x[i].x + x[i].y * x[i].y + x[i].z * x[i].z + x[i].w * x[i].w;
  }
  if (LAST) {
#pragma unroll
    for (int i = 0; i < 4; ++i) ((f4*)xout)[i * 64 + lane] = x[i];
  } else {
#pragma unroll
    for (int i = 0; i < 4; ++i) {
      u2 pk; pk.x = pk2(x[i].x, x[i].y); pk.y = pk2(x[i].z, x[i].w);
      ((u2*)xout)[i * 64 + lane] = pk;
    }
    ss1 = wave_sum(ss1);
    float rs1 = rsqrtf(ss1 * (1.f / 1024.f) + EPS);
#pragma unroll
    for (int i = 0; i < 4; ++i) {
      f4 ww = ((const f4*)wnext)[i * 64 + lane];
      u2 pk;
      pk.x = pk2(x[i].x * rs1 * ww.x, x[i].y * rs1 * ww.y);
      pk.y = pk2(x[i].z * rs1 * ww.z, x[i].w * rs1 * ww.w);
      ((u2*)hout)[i * 64 + lane] = pk;
    }
  }
}

constexpr int NR = 4;
DI void row_norm_bf16_xn(const float* __restrict__ x, const float* __restrict__ w, bf16_t* __restrict__ out, int lane) {
  f4 v[NR][4];
#pragma unroll
  for (int q = 0; q < NR; ++q)
#pragma unroll
    for (int i = 0; i < 4; ++i) v[q][i] = ((const f4*)(x + q * 1024))[i * 64 + lane];
  __builtin_amdgcn_sched_barrier(0);
#pragma unroll
  for (int q = 0; q < NR; ++q) {
    float ss = 0.f;
#pragma unroll
    for (int i = 0; i < 4; ++i) ss += v[q][i].x * v[q][i].x + v[q][i].y * v[q][i].y + v[q][i].z * v[q][i].z + v[q][i].w * v[q][i].w;
    ss = wave_sum(ss);
    float rs = rsqrtf(ss * (1.f / 1024.f) + EPS);
#pragma unroll
    for (int i = 0; i < 4; ++i) {
      f4 ww = ((const f4*)w)[i * 64 + lane];
      u2 pk;
      pk.x = pk2(v[q][i].x * rs * ww.x, v[q][i].y * rs * ww.y);
      pk.y = pk2(v[q][i].z * rs * ww.z, v[q][i].w * rs * ww.w);
      ((u2*)(out + q * 1024))[i * 64 + lane] = pk;
    }
  }
}

template <bool XIN_F32, bool LAST>
DI void row_resid_xn(const char* xin, int xin_stride, const bf16_t* __restrict__ mix, const float* __restrict__ wpost,
                     const float* __restrict__ wnext, char* xout, int xout_stride, bf16_t* __restrict__ hout, int lane) {
  f4 x[NR][4]; u2 mu[NR][4];
#pragma unroll
  for (int q = 0; q < NR; ++q) {
#pragma unroll
    for (int i = 0; i < 4; ++i) {
      if (XIN_F32) x[q][i] = ((const f4*)(xin + (long)q * xin_stride))[i * 64 + lane];
      else { u2 xu = ((const u2*)(xin + (long)q * xin_stride))[i * 64 + lane]; x[q][i].x = blo(xu.x); x[q][i].y = bhi(xu.x); x[q][i].z = blo(xu.y); x[q][i].w = bhi(xu.y); }
      mu[q][i] = ((const u2*)(mix + q * 1024))[i * 64 + lane];
    }
  }
  __builtin_amdgcn_sched_barrier(0);
#pragma unroll
  for (int q = 0; q < NR; ++q) {
    f4 m[4];
    float ss = 0.f;
#pragma unroll
    for (int i = 0; i < 4; ++i) {
      m[i].x = blo(mu[q][i].x); m[i].y = bhi(mu[q][i].x); m[i].z = blo(mu[q][i].y); m[i].w = bhi(mu[q][i].y);
      ss += m[i].x * m[i].x + m[i].y * m[i].y + m[i].z * m[i].z + m[i].w * m[i].w;
    }
    ss = wave_sum(ss);
    float rs = rsqrtf(ss * (1.f / 1024.f) + EPS);
    float ss1 = 0.f;
#pragma unroll
    for (int i = 0; i < 4; ++i) {
      f4 ww = ((const f4*)wpost)[i * 64 + lane];
      x[q][i].x += m[i].x * rs * ww.x; x[q][i].y += m[i].y * rs * ww.y;
      x[q][i].z += m[i].z * rs * ww.z; x[q][i].w += m[i].w * rs * ww.w;
      ss1 += x[q][i].x * x[q][i].x + x[q][i].y * x[q][i].y + x[q][i].z * x[q][i].z + x[q][i].w * x[q][i].w;
    }
    if (LAST) {
#pragma unroll
      for (int i = 0; i < 4; ++i) ((f4*)(xout + (long)q * xout_stride))[i * 64 + lane] = x[q][i];
    } else {
#pragma unroll
      for (int i = 0; i < 4; ++i) {
        u2 pk; pk.x = pk2(x[q][i].x, x[q][i].y); pk.y = pk2(x[q][i].z, x[q][i].w);
        ((u2*)(xout + (long)q * xout_stride))[i * 64 + lane] = pk;
      }
      ss1 = wave_sum(ss1);
      float rs1 = rsqrtf(ss1 * (1.f / 1024.f) + EPS);
#pragma unroll
      for (int i = 0; i < 4; ++i) {
        f4 ww = ((const f4*)wnext)[i * 64 + lane];
        u2 pk;
        pk.x = pk2(x[q][i].x * rs1 * ww.x, x[q][i].y * rs1 * ww.y);
        pk.y = pk2(x[q][i].z * rs1 * ww.z, x[q][i].w * rs1 * ww.w);
        ((u2*)(hout + q * 1024))[i * 64 + lane] = pk;
      }
    }
  }
}

template <class F>
DI void wt_conv(bf16_t* __restrict__ dst, int K, int N, int tile0, int& tile_base, char* smem, F src4) {
  float* tl = (float*)smem;
  const int tid = VT;
  const int ntn = N >> 6, ntk = K >> 6, nt = ntn * ntk;
  int first = (tile0 & ~1) - tile_base;
  const int stride = VN;
  if (first < 0) first += ((-first + stride - 1) / stride) * stride;
  for (int te = first; te < nt; te += stride) {
    const int t = te + (tile0 & 1);
    const bool live = t < nt;
    const int tn = live ? t % ntn : 0, tk = live ? t / ntn : 0;
    const int n0 = tn * 64, k0 = tk * 64;
    __syncthreads();
    if (live) {
      const int kk = tid >> 4, n4 = (tid & 15) * 4;
#pragma unroll
      for (int it = 0; it < 4; ++it) {
        const int k = kk + 16 * it;
        const float* sp = src4(k0 + k, n0 + n4);
        f4 v = sp ? *(const f4*)sp : f4{0.f, 0.f, 0.f, 0.f};
        tl[k * 65 + n4 + 0] = v.x; tl[k * 65 + n4 + 1] = v.y; tl[k * 65 + n4 + 2] = v.z; tl[k * 65 + n4 + 3] = v.w;
      }
    }
    __syncthreads();
    if (live) {
      const int n = tid >> 2, kq = (tid & 3) * 16;
      unsigned pk[8];
#pragma unroll
      for (int j = 0; j < 8; ++j) pk[j] = pk2(tl[(kq + 2 * j) * 65 + n], tl[(kq + 2 * j + 1) * 65 + n]);
      bf16_t* d = dst + (long)(n0 + n) * K + k0 + kq;
      *(u4*)d = u4{pk[0], pk[1], pk[2], pk[3]};
      *(u4*)(d + 8) = u4{pk[4], pk[5], pk[6], pk[7]};
    }
  }
  tile_base += nt;
}

DI void phase_prep(const P& p, char* smem) {
  char* ws = p.ws;
  int tb = 0;
  const int vb = VB;
  {
    const float* w = p.w_in;
    wt_conv((bf16_t*)(ws + OFF_WIN), 1024, NIN, vb, tb, smem, [=](int k, int n) -> const float* {
      int sc = n < 1024 ? n : (n < 3072 ? n + 32 : (n < 3104 ? n - 3072 + 1024 : -1));
      return sc < 0 ? nullptr : w + (long)k * 3104 + sc;
    });
  }
  { const float* w = p.w_out; wt_conv((bf16_t*)(ws + OFF_WOUT), 1024, 1024, vb, tb, smem, [=](int k, int n) -> const float* { return w + (long)k * 1024 + n; }); }
  { const float* w = p.w_xq;  wt_conv((bf16_t*)(ws + OFF_WXQ), 1024, 1024, vb, tb, smem, [=](int k, int n) -> const float* { return w + (long)k * 1024 + n; }); }
  { const float* w = p.w_xo;  wt_conv((bf16_t*)(ws + OFF_WXO), 1024, 1024, vb, tb, smem, [=](int k, int n) -> const float* { return w + (long)k * 1024 + n; }); }
  { const float* w = p.w_xkv; wt_conv((bf16_t*)(ws + OFF_WXKV), 1024, 2048, vb, tb, smem, [=](int k, int n) -> const float* { return w + (long)k * 2048 + n; }); }
  {
    const float* wg = p.w_fg; const float* wu = p.w_fu;
    wt_conv((bf16_t*)(ws + OFF_WGU), 1024, 5632, vb, tb, smem, [=](int k, int n) -> const float* {
      int pr = n >> 5, which = (n >> 4) & 1, j = n & 15;
      int sc = pr * 16 + j;
      return (which ? wu : wg) + (long)k * DFF + sc;
    });
  }
  { const float* w = p.w_fd; wt_conv((bf16_t*)(ws + OFF_WDN), DFF, 1024, vb, tb, smem, [=](int k, int n) -> const float* { return w + (long)k * 1024 + n; }); }
  const long gtid = (long)VB * 256 + VT;
  (void)gtid;
  const int lane = VT & 63;
  const int gw = VB * 4 + (VT >> 6);
  const int nw = VN * 4;
  for (int rg = gw; rg < MT / NR; rg += nw) {
    const int r = rg * NR;
    const float* src = r < 256 ? p.memp + (long)r * 1024 : p.mems + (long)(r - 256) * 1024;
    row_norm_bf16_xn(src, p.norm_mem, (bf16_t*)(ws + OFF_MBUF) + (long)r * 1024, lane);
  }
  for (int rg = gw; rg < T / NR; rg += nw) {
    const int r = rg * NR;
    const float* src = r < TP ? p.xp + (long)r * 1024 : p.xs + (long)(r - TP) * 1024;
    row_norm_bf16_xn(src, p.norm_mix_pre, (bf16_t*)(ws + OFF_HBUF) + (long)r * 1024, lane);
  }
}

constexpr int GROW = 144;
constexpr int G8_BM = 256, G8_BK = 64, G8_HALF = 128, G8_HT = G8_HALF * G8_BK;

DI int g8_lds_byte(int r, int c) {
  int st = (r >> 4) * 2 + (c >> 5), rr = r & 15, cc = c & 31, ob = rr * 64 + cc * 2;
  return st * 1024 + (ob ^ (((ob >> 9) & 1) << 5));
}
DI void g8_stage_rc(int b, int& R, int& C) {
  int st = b / 1024, sb = b % 1024, swz = sb ^ (((sb >> 9) & 1) << 5);
  R = (st >> 1) * 16 + swz / 64; C = (st & 1) * 32 + (swz % 64) / 2;
}

template <bool SWAP>
DI void g8_tile(const bf16_t* __restrict__ Ag, const bf16_t* __restrict__ Bg, int K, int brow, int bcol, bf16_t* shm,
                f32x4 (&acc)[2][2][4][2], const int tidx, const bool prestaged, const bool halfn = false) {
#define SA(b, h) (shm + ((b) * 2 + (h)) * G8_HT)
#define SB(b, h) (shm + (4 + (b) * 2 + (h)) * G8_HT)
#define STAGE(Pp, BASE, br, kt) do { const char* _gb = (const char*)(BASE + (long)(br) * K + (long)(kt) * G8_BK); \
    __builtin_amdgcn_global_load_lds((const unsigned*)(_gb + voff0), \
        (__attribute__((address_space(3))) unsigned*)((char*)(Pp) + tidx * 16), 16, 0, 0); \
    __builtin_amdgcn_global_load_lds((const unsigned*)(_gb + (long)K * 128 + voff0), \
        (__attribute__((address_space(3))) unsigned*)((char*)(Pp) + tidx * 16 + 8192), 16, 0, 0); } while (0)
#define LDA(dst, b, h) for (int m = 0; m < 4; ++m) for (int k = 0; k < 2; ++k) \
    dst[m][k] = *reinterpret_cast<const bf16x8*>((char*)SA(b, h) + g8_lds_byte(wr * 64 + m * 16 + fr, k * 32 + fq * 8))
#define LDB(dst, b, h) for (int n = 0; n < 2; ++n) for (int k = 0; k < 2; ++k) \
    dst[n][k] = *reinterpret_cast<const bf16x8*>((char*)SB(b, h) + g8_lds_byte(wc * 32 + n * 16 + fr, k * 32 + fq * 8))
#define MMA(ai, bj, Af, Bf) do { __builtin_amdgcn_s_setprio(1); \
    for (int m = 0; m < 4; ++m) for (int n = 0; n < 2; ++n) for (int k = 0; k < 2; ++k) \
      acc[ai][bj][m][n] = SWAP ? __builtin_amdgcn_mfma_f32_16x16x32_bf16(Bf[n][k], Af[m][k], acc[ai][bj][m][n], 0, 0, 0) \
                               : __builtin_amdgcn_mfma_f32_16x16x32_bf16(Af[m][k], Bf[n][k], acc[ai][bj][m][n], 0, 0, 0); \
    __builtin_amdgcn_s_setprio(0); } while (0)
#define WAIT_V(n) asm volatile("s_waitcnt vmcnt(" #n ")" ::: "memory")
#define WAIT_L(n) asm volatile("s_waitcnt lgkmcnt(" #n ")" ::: "memory")
#define BAR __builtin_amdgcn_s_barrier()
#define SCHED __builtin_amdgcn_sched_barrier(0)
  const int wid = __builtin_amdgcn_readfirstlane(tidx >> 6), lane = tidx & 63, wr = wid >> 2, wc = wid & 3, fr = lane & 15, fq = lane >> 4;
#pragma unroll
  for (int a = 0; a < 2; ++a)
#pragma unroll
    for (int b = 0; b < 2; ++b)
#pragma unroll
      for (int m = 0; m < 4; ++m)
#pragma unroll
        for (int n = 0; n < 2; ++n) acc[a][b][m][n] = f32x4{0.f, 0.f, 0.f, 0.f};
  bf16x8 At[4][2], B0[2][2], B1[2][2];
  const int nt = K / G8_BK;
  unsigned voff0;
  { int _r, _c; g8_stage_rc(tidx * 16, _r, _c); voff0 = (unsigned)(_r * K + _c) * 2u; }
  if (!prestaged) {
    STAGE(SB(0, 0), Bg, bcol, 0); STAGE(SA(0, 0), Ag, brow, 0);
    STAGE(SB(0, 1), Bg, bcol + G8_HALF, 0); STAGE(SA(0, 1), Ag, brow + G8_HALF, 0);
    if (wr == 1) BAR;
    WAIT_V(4); BAR;
  } else {
    if (wr == 1) BAR;
    WAIT_V(0); BAR;
  }
  STAGE(SB(1, 0), Bg, bcol, 1); STAGE(SA(1, 0), Ag, brow, 1); STAGE(SB(1, 1), Bg, bcol + G8_HALF, 1);
  WAIT_V(6); BAR;
  for (int t = 0; t < nt - 2; t += 2) {
    LDB(B0, 0, 0); SCHED; LDA(At, 0, 0); STAGE(SA(1, 1), Ag, brow + G8_HALF, t + 1);
    WAIT_L(8); BAR; WAIT_L(0); MMA(0, 0, At, B0); BAR; SCHED;
    LDB(B1, 0, 1); STAGE(SB(0, 0), Bg, bcol, t + 2);
    BAR; WAIT_L(0); if (!halfn) MMA(0, 1, At, B1); BAR;
    LDA(At, 0, 1); STAGE(SA(0, 0), Ag, brow, t + 2);
    BAR; WAIT_L(0); MMA(1, 0, At, B0); BAR; SCHED;
    STAGE(SB(0, 1), Bg, bcol + G8_HALF, t + 2);
    WAIT_V(6); BAR; if (!halfn) MMA(1, 1, At, B1); BAR;
    LDB(B0, 1, 0); SCHED; LDA(At, 1, 0); STAGE(SA(0, 1), Ag, brow + G8_HALF, t + 2);
    WAIT_L(8); BAR; WAIT_L(0); MMA(0, 0, At, B0); BAR; SCHED;
    LDB(B1, 1, 1); STAGE(SB(1, 0), Bg, bcol, t + 3);
    BAR; WAIT_L(0); if (!halfn) MMA(0, 1, At, B1); BAR;
    LDA(At, 1, 1); STAGE(SA(1, 0), Ag, brow, t + 3);
    BAR; WAIT_L(0); MMA(1, 0, At, B0); BAR; SCHED;
    STAGE(SB(1, 1), Bg, bcol + G8_HALF, t + 3);
    WAIT_V(6); BAR; if (!halfn) MMA(1, 1, At, B1); BAR;
  }
  { LDB(B0, 0, 0); LDA(At, 0, 0); STAGE(SA(1, 1), Ag, brow + G8_HALF, nt - 1);
    BAR; WAIT_L(0); MMA(0, 0, At, B0); BAR;
    LDB(B1, 0, 1); BAR; WAIT_L(0); if (!halfn) MMA(0, 1, At, B1); BAR;
    LDA(At, 0, 1); WAIT_V(4); BAR; WAIT_L(0); MMA(1, 0, At, B0); if (!halfn) MMA(1, 1, At, B1); BAR; }
  { LDB(B0, 1, 0); LDA(At, 1, 0); WAIT_V(2); BAR; WAIT_L(0); MMA(0, 0, At, B0); BAR;
    LDB(B1, 1, 1); WAIT_V(0); BAR; WAIT_L(0); if (!halfn) MMA(0, 1, At, B1); BAR;
    LDA(At, 1, 1); BAR; WAIT_L(0); MMA(1, 0, At, B0); if (!halfn) MMA(1, 1, At, B1); BAR; }
  if (wr == 0) BAR;
#undef SA
#undef SB
#undef STAGE
#undef LDA
#undef LDB
#undef MMA
}

DI void g8_stage0(const bf16_t* __restrict__ Ag, const bf16_t* __restrict__ Bg, int K, int brow, int bcol, bf16_t* shm, const int tidx) {
  unsigned voff0;
  { int _r, _c; g8_stage_rc(tidx * 16, _r, _c); voff0 = (unsigned)(_r * K + _c) * 2u; }
#define SA(b, h) (shm + ((b) * 2 + (h)) * G8_HT)
#define SB(b, h) (shm + (4 + (b) * 2 + (h)) * G8_HT)
#define STAGE(Pp, BASE, br, kt) do { const char* _gb = (const char*)(BASE + (long)(br) * K + (long)(kt) * G8_BK); \
    __builtin_amdgcn_global_load_lds((const unsigned*)(_gb + voff0), \
        (__attribute__((address_space(3))) unsigned*)((char*)(Pp) + tidx * 16), 16, 0, 0); \
    __builtin_amdgcn_global_load_lds((const unsigned*)(_gb + (long)K * 128 + voff0), \
        (__attribute__((address_space(3))) unsigned*)((char*)(Pp) + tidx * 16 + 8192), 16, 0, 0); } while (0)
  STAGE(SB(0, 0), Bg, bcol, 0); STAGE(SA(0, 0), Ag, brow, 0);
  STAGE(SB(0, 1), Bg, bcol + G8_HALF, 0); STAGE(SA(0, 1), Ag, brow + G8_HALF, 0);
#undef SA
#undef SB
#undef STAGE
}

struct Job {
  const bf16_t* A; const bf16_t* B; bf16_t* dst;
  int K, mtiles, ntiles, mode;
};

DI void g8_unit(int L, int nM, int nN, int& pm, int& pn) {
  const int nwg = nM * nN;
  int wgid = L;
  { const int q = nwg / 8, r = nwg % 8, xcd = wgid % 8, off = wgid / 8; wgid = (xcd < r ? xcd * (q + 1) : r * (q + 1) + (xcd - r) * q) + off; }
  const int nig = 8 * nN, gid = wgid / nig, fm = gid * 8, gsz = (nM - fm) < 8 ? (nM - fm) : 8;
  pm = fm + ((wgid % nig) % gsz); pn = (wgid % nig) / gsz;
}

DI void run_gemm_unit(const P& p, const Job& jb, int L, char* smem, const bool prestaged, const bool hasnext, const Job& jn, int Ln) {
  char* ws = p.ws;
  int tidx = threadIdx.x;
  asm volatile("" : "+v"(tidx));
  const int wid = __builtin_amdgcn_readfirstlane(tidx >> 6), lane = tidx & 63, wr = wid >> 2, wc = wid & 3;
  int fr = lane & 15, fq = lane >> 4;
  int pm, pn;
  g8_unit(L, jb.mtiles, jb.ntiles, pm, pn);
  const int m0 = pm * 256, n0 = pn * 256;
  f32x4 acc[2][2][4][2];
  const bool transposed = (jb.mode == 0 && ((n0 >= 2560 && n0 < 3072) || (n0 >= 512 && n0 < 1024))) || (jb.mode == 1 && n0 >= 1024);
  g8_tile<true>(jb.A, jb.B, jb.K, m0, n0, (bf16_t*)smem, acc, tidx, prestaged, jb.mode == 0 && n0 >= 3072);
  const bool early = hasnext && (jb.mode == 3);
  if (early) {
    int pm2, pn2;
    g8_unit(Ln, jn.mtiles, jn.ntiles, pm2, pn2);
    g8_stage0(jn.A, jn.B, jn.K, pm2 * 256, pn2 * 256, (bf16_t*)smem, tidx);
  }
  asm volatile("" : "+v"(fr), "+v"(fq));
  const bool gates = (jb.mode == 0 && n0 >= 3072);
  u4 outv[16];
  bf16_t* gdst = nullptr;
  long istride = 0;
  int nch = 16;
  if (gates) {
    if (wc == 0) {
      float* g = (float*)(ws + OFF_GATES);
#pragma unroll
      for (int ai = 0; ai < 2; ++ai)
#pragma unroll
        for (int m = 0; m < 4; ++m)
#pragma unroll
          for (int n = 0; n < 2; ++n) {
            int row = m0 + ai * 128 + wr * 64 + m * 16 + fr;
            *(f32x4*)(g + (long)row * 32 + n * 16 + fq * 4) = acc[ai][0][m][n];
          }
    }
    nch = 0;
  } else if (transposed) {
    bf16_t* dstT; long ldT; int nb;
    if (jb.mode == 0 && n0 < 1024) { dstT = (bf16_t*)(ws + OFF_GV); ldT = T; nb = 512; }
    else if (jb.mode == 0) { dstT = (bf16_t*)(ws + OFF_DVT); ldT = T; nb = 2560; }
    else { dstT = (bf16_t*)(ws + OFF_VXT); ldT = MT; nb = 1024; }
#pragma unroll
    for (int ai = 0; ai < 2; ++ai)
#pragma unroll
      for (int bj = 0; bj < 2; ++bj)
#pragma unroll
        for (int m = 0; m < 4; ++m)
#pragma unroll
          for (int n = 0; n < 2; ++n) {
            const int rowm = ai * 128 + wr * 64 + m * 16 + fr;
            f32x4 v = acc[ai][bj][m][n];
#pragma unroll
            for (int j = 0; j < 4; ++j) {
              const int colL = bj * 128 + wc * 32 + n * 16 + fq * 4 + j;
              *(bf16_t*)(smem + colL * 512 + (((rowm >> 3) ^ (colL & 31)) << 4) + (rowm & 7) * 2) = f2b(v[j]);
            }
          }
    __syncthreads();
#pragma unroll
    for (int i = 0; i < 16; ++i) {
      const int colL = (tidx >> 5) + 16 * i, c = tidx & 31;
      outv[i] = *(const u4*)(smem + colL * 512 + ((c ^ (colL & 31)) << 4));
    }
    gdst = dstT + (long)(n0 - nb + (tidx >> 5)) * ldT + m0 + (tidx & 31) * 8;
    istride = 16 * ldT;
  } else if (jb.mode == 3) {
#pragma unroll
    for (int ai = 0; ai < 2; ++ai)
#pragma unroll
      for (int bj = 0; bj < 2; ++bj)
#pragma unroll
        for (int m = 0; m < 4; ++m) {
          const int row = ai * 128 + wr * 64 + m * 16 + fr;
          f32x4 g = acc[ai][bj][m][0], u = acc[ai][bj][m][1];
          float o[4];
#pragma unroll
          for (int r = 0; r < 4; ++r) o[r] = g[r] * u[r] * __builtin_amdgcn_rcpf(1.f + __builtin_amdgcn_exp2f(-g[r] * LOG2E));
          u2 pk; pk.x = pk2(o[0], o[1]); pk.y = pk2(o[2], o[3]);
          const int chunk = bj * 8 + wc * 2 + (fq >> 1);
          *(u2*)(smem + row * 256 + (row >= 128 ? 65536 : 32768) + ((chunk ^ (row & 15)) << 4) + (fq & 1) * 8) = pk;
        }
    __syncthreads();
#pragma unroll
    for (int i = 0; i < 8; ++i) {
      const int row = (tidx >> 4) + 32 * i, c = tidx & 15;
      outv[i] = *(const u4*)(smem + row * 256 + (row >= 128 ? 65536 : 32768) + ((c ^ (row & 15)) << 4));
    }
    gdst = jb.dst + (long)(m0 + (tidx >> 4)) * DFF + (n0 >> 1) + (tidx & 15) * 8;
    istride = 32L * DFF;
    nch = 8;
  } else {
    bf16_t* dst; int ld; int nb;
    if (jb.mode == 2) { dst = jb.dst; ld = 1024; nb = 0; }
    else if (jb.mode == 1) { dst = (bf16_t*)(ws + OFF_KX); ld = 1024; nb = 0; }
    else {
      if (n0 < 256) { dst = (bf16_t*)(ws + OFF_GQ); ld = 256; nb = 0; }
      else if (n0 < 512) { dst = (bf16_t*)(ws + OFF_GK); ld = 256; nb = 256; }
      else if (n0 < 1536) { dst = (bf16_t*)(ws + OFF_OG); ld = 512; nb = 1024; }
      else if (n0 < 2048) { dst = (bf16_t*)(ws + OFF_DQ); ld = 512; nb = 1536; }
      else { dst = (bf16_t*)(ws + OFF_DK); ld = 512; nb = 2048; }
    }
    const bool rope = (jb.mode == 0) && (n0 >= 1536) && (n0 < 2560) && ((wc & 1) == 0);
    const float l2t = log2f(500000.f) * (1.f / 8.f);
#pragma unroll
    for (int ai = 0; ai < 2; ++ai)
#pragma unroll
      for (int bj = 0; bj < 2; ++bj)
#pragma unroll
        for (int m = 0; m < 4; ++m)
#pragma unroll
          for (int n = 0; n < 2; ++n) {
            const int row = ai * 128 + wr * 64 + m * 16 + fr;
            f32x4 v = acc[ai][bj][m][n];
            if (rope && n == 0) {
              const int grow = m0 + row;
              const int pos = grow < TP ? grow : ((grow - TP) & (SS - 1));
#pragma unroll
              for (int j = 0; j < 4; ++j) {
                auto rr = __builtin_amdgcn_permlane32_swap(__float_as_uint(v[j]), __float_as_uint(v[j]), false, false);
                const float pv = __uint_as_float(fq < 2 ? rr[1] : rr[0]);
                const int i = (fq & 1) * 4 + j;
                const float inv = exp2f(-(float)i * l2t);
                const float ang = (float)pos * inv;
                const float kk = rintf(ang * 0.15915494309189535f);
                const float frv = fmaf(ang, 0.15915494309189535f, -kk) + ang * 6.4206383e-9f;
                const float sn = __builtin_amdgcn_sinf(frv), cs = __builtin_amdgcn_cosf(frv);
                v[j] = fq < 2 ? v[j] * cs - pv * sn : v[j] * cs + pv * sn;
              }
            }
            u2 pk; pk.x = pk2(v[0], v[1]); pk.y = pk2(v[2], v[3]);
            const int chunk = bj * 16 + wc * 4 + n * 2 + (fq >> 1);
            *(u2*)(smem + row * 512 + ((chunk ^ (row & 31)) << 4) + (fq & 1) * 8) = pk;
          }
    __syncthreads();
#pragma unroll
    for (int i = 0; i < 16; ++i) {
      const int row = (tidx >> 5) + 16 * i, c = tidx & 31;
      outv[i] = *(const u4*)(smem + row * 512 + ((c ^ (row & 31)) << 4));
    }
    gdst = dst + (long)(m0 + (tidx >> 5)) * ld + (n0 - nb) + (tidx & 31) * 8;
    istride = 16L * ld;
  }
  __syncthreads();
  if (hasnext && !early) {
    int pm2, pn2;
    g8_unit(Ln, jn.mtiles, jn.ntiles, pm2, pn2);
    g8_stage0(jn.A, jn.B, jn.K, pm2 * 256, pn2 * 256, (bf16_t*)smem, tidx);
  }
#pragma unroll
  for (int i = 0; i < 16; ++i)
    if (i < nch) *(u4*)(gdst + (long)i * istride) = outv[i];
  if (!hasnext) asm volatile("s_waitcnt vmcnt(0)" ::: "memory");
}

DI void run_gemm_job(const P& p, const Job& jb, char* smem) {
  const int nu = jb.mtiles * jb.ntiles;
  const int G = gridDim.x;
  bool pre = false;
  for (int L = blockIdx.x; L < nu; L += G) {
    const bool hn = L + G < nu;
    run_gemm_unit(p, jb, L, smem, pre, hn, jb, L + G);
    pre = hn;
  }
}

constexpr int VROW = 136;

template <int DQK, bool PF>
DI void flash_item(const bf16_t* __restrict__ Q, int ldq, const bf16_t* __restrict__ Kp, int ldk,
                   const bf16_t* __restrict__ Vt, long ldvt, int nkeys, float c, bf16_t* __restrict__ O, int ldo,
                   char* smem) {
  constexpr int KROW = (DQK + 8) * 2;
  constexpr int KCH = 64 * DQK * 2 / 16 / 256;
  constexpr int CPR = DQK / 8;
  char* Ks = smem;
  char* Vs = smem + 64 * KROW;
  const int tid = VT, lane = tid & 63, w = tid >> 6, r = lane & 31, h = lane >> 5;
  bf16x8 qf[DQK / 16];
  {
    const bf16_t* qrow = Q + (long)(w * 32 + r) * ldq + 8 * h;
#pragma unroll
    for (int ks = 0; ks < DQK / 16; ++ks) qf[ks] = *(const bf16x8*)(qrow + 16 * ks);
  }
  f32x16 o[4];
#pragma unroll
  for (int i = 0; i < 4; ++i)
#pragma unroll
    for (int j = 0; j < 16; ++j) o[i][j] = 0.f;
  float m_run = -1e30f, l_run = 0.f;
  u4 kreg[KCH], vreg[4];
#define FL_GLOAD(kt_) \
  _Pragma("unroll") for (int i = 0; i < KCH; ++i) { \
    int cc = tid + 256 * i, row = cc / CPR, kc = cc % CPR; \
    kreg[i] = *(const u4*)(Kp + (long)((kt_) * 64 + row) * ldk + kc * 8); \
  } \
  _Pragma("unroll") for (int i = 0; i < 4; ++i) { \
    int cc = tid + 256 * i, row = cc >> 3, kc = cc & 7; \
    vreg[i] = *(const u4*)(Vt + (long)row * ldvt + (kt_) * 64 + kc * 8); \
  }
#define FL_LSTORE() \
  _Pragma("unroll") for (int i = 0; i < KCH; ++i) { \
    int cc = tid + 256 * i, row = cc / CPR, kc = cc % CPR; \
    *(u4*)(Ks + row * KROW + kc * 16) = kreg[i]; \
  } \
  _Pragma("unroll") for (int i = 0; i < 4; ++i) { \
    int cc = tid + 256 * i, row = cc >> 3, kc = cc & 7; \
    *(u2*)(Vs + row * VROW + kc * 16) = u2{vreg[i].x, vreg[i].y}; \
    *(u2*)(Vs + row * VROW + kc * 16 + 8) = u2{vreg[i].z, vreg[i].w}; \
  }
  const int nt = nkeys >> 6;
  if (PF) { FL_GLOAD(0) }
  for (int kt = 0; kt < nt; ++kt) {
    __syncthreads();
    if (PF) {
      FL_LSTORE()
    } else {
#pragma unroll
      for (int g = 0; g < KCH / 4; ++g) {
        u4 tmp[4];
#pragma unroll
        for (int i = 0; i < 4; ++i) {
          int cc = tid + 256 * (g * 4 + i), row = cc / CPR, kc = cc % CPR;
          tmp[i] = *(const u4*)(Kp + (long)(kt * 64 + row) * ldk + kc * 8);
        }
#pragma unroll
        for (int i = 0; i < 4; ++i) {
          int cc = tid + 256 * (g * 4 + i), row = cc / CPR, kc = cc % CPR;
          *(u4*)(Ks + row * KROW + kc * 16) = tmp[i];
        }
        __builtin_amdgcn_sched_barrier(0);
      }
      {
        u4 tmp[4];
#pragma unroll
        for (int i = 0; i < 4; ++i) {
          int cc = tid + 256 * i, row = cc >> 3, kc = cc & 7;
          tmp[i] = *(const u4*)(Vt + (long)row * ldvt + kt * 64 + kc * 8);
        }
#pragma unroll
        for (int i = 0; i < 4; ++i) {
          int cc = tid + 256 * i, row = cc >> 3, kc = cc & 7;
          *(u2*)(Vs + row * VROW + kc * 16) = u2{tmp[i].x, tmp[i].y};
          *(u2*)(Vs + row * VROW + kc * 16 + 8) = u2{tmp[i].z, tmp[i].w};
        }
      }
    }
    __syncthreads();
    if (PF && kt + 1 < nt) { FL_GLOAD(kt + 1) }
    f32x16 s[2];
#pragma unroll
    for (int kb = 0; kb < 2; ++kb)
#pragma unroll
      for (int j = 0; j < 16; ++j) s[kb][j] = 0.f;
#pragma unroll
    for (int kg = 0; kg < DQK / 64; ++kg) {
      bf16x8 kf[4][2];
#pragma unroll
      for (int k4 = 0; k4 < 4; ++k4)
#pragma unroll
        for (int kb = 0; kb < 2; ++kb)
          kf[k4][kb] = *(const bf16x8*)(Ks + (32 * kb + r) * KROW + (16 * (kg * 4 + k4) + 8 * h) * 2);
#pragma unroll
      for (int k4 = 0; k4 < 4; ++k4)
#pragma unroll
        for (int kb = 0; kb < 2; ++kb)
          s[kb] = __builtin_amdgcn_mfma_f32_32x32x16_bf16(kf[k4][kb], qf[kg * 4 + k4], s[kb], 0, 0, 0);
      __builtin_amdgcn_sched_group_barrier(0x100, 8, 0);
      __builtin_amdgcn_sched_group_barrier(0x008, 8, 0);
      __builtin_amdgcn_sched_barrier(0);
    }
    bf16x8 vf0[2][4];
#pragma unroll
    for (int st = 0; st < 2; ++st)
#pragma unroll
      for (int dvb = 0; dvb < 4; ++dvb) {
        const char* vp = Vs + (32 * dvb + r) * VROW + (16 * st + 4 * h) * 2;
        bf16x4 lo = *(const bf16x4*)vp;
        bf16x4 hi = *(const bf16x4*)(vp + 16);
        vf0[st][dvb] = __builtin_shufflevector(lo, hi, 0, 1, 2, 3, 4, 5, 6, 7);
      }
    __builtin_amdgcn_sched_barrier(0);
    float mx = s[0][0];
#pragma unroll
    for (int kb = 0; kb < 2; ++kb)
#pragma unroll
      for (int j = 0; j < 16; ++j) mx = fmaxf(mx, s[kb][j]);
    mx = half_swap_max(mx);
    const float m_new = fmaxf(m_run, mx * c);
    if (__builtin_amdgcn_ballot_w64(m_new > m_run) != 0ull) {
      const float alpha = __builtin_amdgcn_exp2f(m_run - m_new);
      m_run = m_new;
      l_run *= alpha;
#pragma unroll
      for (int i = 0; i < 4; ++i)
#pragma unroll
        for (int j = 0; j < 16; ++j) o[i][j] *= alpha;
    }
    float ps = 0.f;
#pragma unroll
    for (int kb = 0; kb < 2; ++kb)
#pragma unroll
      for (int j = 0; j < 16; ++j) {
        float pv = __builtin_amdgcn_exp2f(s[kb][j] * c - m_run);
        s[kb][j] = pv;
        ps += pv;
      }
    l_run += ps;
    bf16x8 pf[2][2];
#pragma unroll
    for (int kb = 0; kb < 2; ++kb)
#pragma unroll
      for (int st = 0; st < 2; ++st) {
        u4 pu;
        pu.x = pk2(s[kb][8 * st + 0], s[kb][8 * st + 1]);
        pu.y = pk2(s[kb][8 * st + 2], s[kb][8 * st + 3]);
        pu.z = pk2(s[kb][8 * st + 4], s[kb][8 * st + 5]);
        pu.w = pk2(s[kb][8 * st + 6], s[kb][8 * st + 7]);
        pf[kb][st] = __builtin_bit_cast(bf16x8, pu);
      }
    __builtin_amdgcn_sched_barrier(0);
    bf16x8 vf1[2][4];
#pragma unroll
    for (int st = 0; st < 2; ++st)
#pragma unroll
      for (int dvb = 0; dvb < 4; ++dvb) {
        const char* vp = Vs + (32 * dvb + r) * VROW + (32 + 16 * st + 4 * h) * 2;
        bf16x4 lo = *(const bf16x4*)vp;
        bf16x4 hi = *(const bf16x4*)(vp + 16);
        vf1[st][dvb] = __builtin_shufflevector(lo, hi, 0, 1, 2, 3, 4, 5, 6, 7);
      }
#pragma unroll
    for (int st = 0; st < 2; ++st)
#pragma unroll
      for (int dvb = 0; dvb < 4; ++dvb) o[dvb] = __builtin_amdgcn_mfma_f32_32x32x16_bf16(vf0[st][dvb], pf[0][st], o[dvb], 0, 0, 0);
    __builtin_amdgcn_sched_group_barrier(0x100, 16, 0);
    __builtin_amdgcn_sched_group_barrier(0x008, 8, 0);
    __builtin_amdgcn_sched_barrier(0);
#pragma unroll
    for (int st = 0; st < 2; ++st)
#pragma unroll
      for (int dvb = 0; dvb < 4; ++dvb) o[dvb] = __builtin_amdgcn_mfma_f32_32x32x16_bf16(vf1[st][dvb], pf[1][st], o[dvb], 0, 0, 0);
  }
  float l = half_swap_sum(l_run);
  float inv = 1.f / l;
  bf16_t* orow = O + (long)(w * 32 + r) * ldo;
#pragma unroll
  for (int dvb = 0; dvb < 4; ++dvb)
#pragma unroll
    for (int g = 0; g < 4; g += 2) {
      unsigned p0 = pk2(o[dvb][4 * g + 0] * inv, o[dvb][4 * g + 1] * inv), p1 = pk2(o[dvb][4 * g + 2] * inv, o[dvb][4 * g + 3] * inv);
      unsigned q0 = pk2(o[dvb][4 * g + 4] * inv, o[dvb][4 * g + 5] * inv), q1 = pk2(o[dvb][4 * g + 6] * inv, o[dvb][4 * g + 7] * inv);
      auto s0 = __builtin_amdgcn_permlane32_swap(p0, q0, false, false);
      auto s1 = __builtin_amdgcn_permlane32_swap(p1, q1, false, false);
      *(u4*)(orow + 32 * dvb + 8 * (g + h)) = u4{s0[0], s1[0], s0[1], s1[1]};
    }
  __syncthreads();
}

template <int DQK>
DI void flash256x_core(const bf16x8 (&qf)[DQK / 16], const bf16_t* __restrict__ Kp, int ldk,
                      const bf16_t* __restrict__ Vt, long ldvt, int nkeys, float c, bf16_t* __restrict__ O, int ldo,
                      char* smem) {
  constexpr int KROW = (DQK + 8) * 2;
  constexpr int BUFB = 64 * KROW + 128 * VROW;
  constexpr int KCH = DQK / 64;
  constexpr int CPR = DQK / 8;
  int tid = threadIdx.x;
  asm volatile("" : "+v"(tid));
  const int lane = tid & 63, w = tid >> 6, r = lane & 31, h = lane >> 5;
  f32x16 o[4];
#pragma unroll
  for (int i = 0; i < 4; ++i)
#pragma unroll
    for (int j = 0; j < 16; ++j) o[i][j] = 0.f;
  float m_run = -1e30f, l_run = 0.f;
  const bf16_t* vg0 = Vt + (long)(tid >> 3) * ldvt + (tid & 7) * 8;
  const bf16_t* vg1 = Vt + (long)(64 + (tid >> 3)) * ldvt + (tid & 7) * 8;
  const int vso0 = 64 * KROW + (tid >> 3) * VROW + (tid & 7) * 16;
  const int vso1 = vso0 + 64 * VROW;
  u4 kr[KCH], vr0, vr1;
#define F2_GLOAD(kt_) { _Pragma("unroll") for (int i_ = 0; i_ < KCH; ++i_) { int cc_ = tid + 512 * i_; \
      kr[i_] = *(const u4*)(Kp + (long)((kt_) * 64 + cc_ / CPR) * ldk + (cc_ % CPR) * 8); } \
    vr0 = *(const u4*)(vg0 + (kt_) * 64); vr1 = *(const u4*)(vg1 + (kt_) * 64); }
#define F2_LSTORE(buf_) { char* bb = smem + (buf_) * BUFB; \
    _Pragma("unroll") for (int i_ = 0; i_ < KCH; ++i_) { int cc_ = tid + 512 * i_; *(u4*)(bb + (cc_ / CPR) * KROW + (cc_ % CPR) * 16) = kr[i_]; } \
    *(u2*)(bb + vso0) = u2{vr0.x, vr0.y}; *(u2*)(bb + vso0 + 8) = u2{vr0.z, vr0.w}; \
    *(u2*)(bb + vso1) = u2{vr1.x, vr1.y}; *(u2*)(bb + vso1 + 8) = u2{vr1.z, vr1.w}; }
  const int nt = nkeys >> 6;
  F2_GLOAD(0)
  __syncthreads();
  F2_LSTORE(0)
  if (nt > 1) F2_GLOAD(1)
  __syncthreads();
  for (int kt = 0; kt < nt; ++kt) {
    const char* Ks = smem + (kt & 1) * BUFB;
    const char* Vs = Ks + 64 * KROW;
    f32x16 s[2];
#pragma unroll
    for (int kb = 0; kb < 2; ++kb)
#pragma unroll
      for (int j = 0; j < 16; ++j) s[kb][j] = 0.f;
    constexpr int KG = (DQK == 64) ? 4 : 2;
    __builtin_amdgcn_s_setprio(1);
#pragma unroll
    for (int kg = 0; kg < DQK / 16 / KG; ++kg) {
      bf16x8 kf[KG][2];
#pragma unroll
      for (int k4 = 0; k4 < KG; ++k4)
#pragma unroll
        for (int kb = 0; kb < 2; ++kb) kf[k4][kb] = *(const bf16x8*)(Ks + (32 * kb + r) * KROW + (16 * (kg * KG + k4) + 8 * h) * 2);
#pragma unroll
      for (int k4 = 0; k4 < KG; ++k4)
#pragma unroll
        for (int kb = 0; kb < 2; ++kb) s[kb] = __builtin_amdgcn_mfma_f32_32x32x16_bf16(kf[k4][kb], qf[kg * KG + k4], s[kb], 0, 0, 0);
      __builtin_amdgcn_sched_group_barrier(0x100, 2 * KG, 0);
      __builtin_amdgcn_sched_group_barrier(0x008, 2 * KG, 0);
      __builtin_amdgcn_sched_barrier(0);
    }
    __builtin_amdgcn_s_setprio(0);
    bf16x8 vf0[2][4];
    if constexpr (DQK == 64) {
#pragma unroll
      for (int st = 0; st < 2; ++st)
#pragma unroll
        for (int dvb = 0; dvb < 4; ++dvb) {
          const char* vp = Vs + (32 * dvb + r) * VROW + (16 * st + 4 * h) * 2;
          bf16x4 lo = *(const bf16x4*)vp;
          bf16x4 hi = *(const bf16x4*)(vp + 16);
          vf0[st][dvb] = __builtin_shufflevector(lo, hi, 0, 1, 2, 3, 4, 5, 6, 7);
        }
      __builtin_amdgcn_sched_barrier(0);
    }
    float mx = s[0][0];
#pragma unroll
    for (int kb = 0; kb < 2; ++kb)
#pragma unroll
      for (int j = 0; j < 16; ++j) mx = fmaxf(mx, s[kb][j]);
    mx = half_swap_max(mx);
    const float mxs = mx * c;
    if (__builtin_amdgcn_ballot_w64(mxs > m_run + 8.f) != 0ull) {
      const float m_new = fmaxf(m_run, mxs);
      const float alpha = __builtin_amdgcn_exp2f(m_run - m_new);
      m_run = m_new;
      l_run *= alpha;
#pragma unroll
      for (int i = 0; i < 4; ++i)
#pragma unroll
        for (int j = 0; j < 16; ++j) o[i][j] *= alpha;
    }
    float ps = 0.f;
#pragma unroll
    for (int kb = 0; kb < 2; ++kb)
#pragma unroll
      for (int j = 0; j < 16; ++j) {
        float pv = __builtin_amdgcn_exp2f(s[kb][j] * c - m_run);
        s[kb][j] = pv;
        ps += pv;
      }
    l_run += ps;
    bf16x8 pf[2][2];
#pragma unroll
    for (int kb = 0; kb < 2; ++kb)
#pragma unroll
      for (int st = 0; st < 2; ++st) {
        u4 pu;
        pu.x = pk2(s[kb][8 * st + 0], s[kb][8 * st + 1]);
        pu.y = pk2(s[kb][8 * st + 2], s[kb][8 * st + 3]);
        pu.z = pk2(s[kb][8 * st + 4], s[kb][8 * st + 5]);
        pu.w = pk2(s[kb][8 * st + 6], s[kb][8 * st + 7]);
        pf[kb][st] = __builtin_bit_cast(bf16x8, pu);
      }
    __builtin_amdgcn_sched_barrier(0);
    if (kt + 1 < nt) {
      F2_LSTORE((kt + 1) & 1)
      if (kt + 2 < nt) F2_GLOAD(kt + 2)
    }
    __builtin_amdgcn_sched_barrier(0);
    __builtin_amdgcn_s_setprio(1);
    if constexpr (DQK == 64) {
      bf16x8 vf1[2][4];
#pragma unroll
      for (int st = 0; st < 2; ++st)
#pragma unroll
        for (int dvb = 0; dvb < 4; ++dvb) {
          const char* vp = Vs + (32 * dvb + r) * VROW + (32 + 16 * st + 4 * h) * 2;
          bf16x4 lo = *(const bf16x4*)vp;
          bf16x4 hi = *(const bf16x4*)(vp + 16);
          vf1[st][dvb] = __builtin_shufflevector(lo, hi, 0, 1, 2, 3, 4, 5, 6, 7);
        }
#pragma unroll
      for (int st = 0; st < 2; ++st)
#pragma unroll
        for (int dvb = 0; dvb < 4; ++dvb) o[dvb] = __builtin_amdgcn_mfma_f32_32x32x16_bf16(vf0[st][dvb], pf[0][st], o[dvb], 0, 0, 0);
      __builtin_amdgcn_sched_group_barrier(0x100, 16, 0);
      __builtin_amdgcn_sched_group_barrier(0x008, 8, 0);
      __builtin_amdgcn_sched_barrier(0);
#pragma unroll
      for (int st = 0; st < 2; ++st)
#pragma unroll
        for (int dvb = 0; dvb < 4; ++dvb) o[dvb] = __builtin_amdgcn_mfma_f32_32x32x16_bf16(vf1[st][dvb], pf[1][st], o[dvb], 0, 0, 0);
    } else {
#pragma unroll
      for (int kb = 0; kb < 2; ++kb)
#pragma unroll
        for (int st = 0; st < 2; ++st) {
          bf16x8 vf[4];
#pragma unroll
          for (int dvb = 0; dvb < 4; ++dvb) {
            const char* vp = Vs + (32 * dvb + r) * VROW + (32 * kb + 16 * st + 4 * h) * 2;
            bf16x4 lo = *(const bf16x4*)vp;
            bf16x4 hi = *(const bf16x4*)(vp + 16);
            vf[dvb] = __builtin_shufflevector(lo, hi, 0, 1, 2, 3, 4, 5, 6, 7);
          }
#pragma unroll
          for (int dvb = 0; dvb < 4; ++dvb) o[dvb] = __builtin_amdgcn_mfma_f32_32x32x16_bf16(vf[dvb], pf[kb][st], o[dvb], 0, 0, 0);
          __builtin_amdgcn_sched_group_barrier(0x100, 8, 0);
          __builtin_amdgcn_sched_group_barrier(0x008, 4, 0);
          __builtin_amdgcn_sched_barrier(0);
        }
    }
    __builtin_amdgcn_s_setprio(0);
    __syncthreads();
  }
  float l = half_swap_sum(l_run);
  float inv = 1.f / l;
  bf16_t* orow = O + (long)(w * 32 + r) * ldo;
#pragma unroll
  for (int dvb = 0; dvb < 4; ++dvb)
#pragma unroll
    for (int g = 0; g < 4; g += 2) {
      unsigned p0 = pk2(o[dvb][4 * g + 0] * inv, o[dvb][4 * g + 1] * inv), p1 = pk2(o[dvb][4 * g + 2] * inv, o[dvb][4 * g + 3] * inv);
      unsigned q0 = pk2(o[dvb][4 * g + 4] * inv, o[dvb][4 * g + 5] * inv), q1 = pk2(o[dvb][4 * g + 6] * inv, o[dvb][4 * g + 7] * inv);
      auto s0 = __builtin_amdgcn_permlane32_swap(p0, q0, false, false);
      auto s1 = __builtin_amdgcn_permlane32_swap(p1, q1, false, false);
      *(u4*)(orow + 32 * dvb + 8 * (g + h)) = u4{s0[0], s1[0], s0[1], s1[1]};
    }
#undef F2_GLOAD
#undef F2_LSTORE
}

template <int DQK>
DI void flash256_item(const bf16_t* __restrict__ Q, int ldq, const bf16_t* __restrict__ Kp, int ldk,
                      const bf16_t* __restrict__ Vt, long ldvt, int nkeys, float c, bf16_t* __restrict__ O, int ldo,
                      char* smem) {
  constexpr int KROW = (DQK + 8) * 2;
  constexpr int BUFB = 64 * KROW + 128 * VROW;
  constexpr int NBUF = (DQK == 64) ? 3 : 2;
  constexpr int KCH = DQK / 64;
  constexpr int CPR = DQK / 8;
  constexpr int KG = (DQK == 64) ? 4 : 2;
  const int tid = threadIdx.x, lane = tid & 63, w = __builtin_amdgcn_readfirstlane(tid >> 6), r = lane & 31, h = lane >> 5;
  const bool skew = (DQK == 64) && (w >= 4);
  bf16x8 qf[DQK / 16];
  {
    const bf16_t* qrow = Q + (long)(w * 32 + r) * ldq + 8 * h;
#pragma unroll
    for (int ks = 0; ks < DQK / 16; ++ks) qf[ks] = *(const bf16x8*)(qrow + 16 * ks);
  }
  f32x16 o[4];
#pragma unroll
  for (int i = 0; i < 4; ++i)
#pragma unroll
    for (int j = 0; j < 16; ++j) o[i][j] = 0.f;
  float m_run = -1e30f, l_run = 0.f;
  const bf16_t* vg0 = Vt + (long)(tid >> 3) * ldvt + (tid & 7) * 8;
  const bf16_t* vg1 = Vt + (long)(64 + (tid >> 3)) * ldvt + (tid & 7) * 8;
  const int vso0 = 64 * KROW + (tid >> 3) * VROW + (tid & 7) * 16;
  const int vso1 = vso0 + 64 * VROW;
  const int nt = nkeys >> 6;
  u4 kr[KCH], vr0, vr1;
  bf16x8 pf[2][2];
  f32x16 s[2];
#define F2_GLOAD(kt_) { const int t_ = min((kt_), nt - 1); _Pragma("unroll") for (int i_ = 0; i_ < KCH; ++i_) { int cc_ = tid + 512 * i_; \
      kr[i_] = *(const u4*)(Kp + (long)(t_ * 64 + cc_ / CPR) * ldk + (cc_ % CPR) * 8); } \
    vr0 = *(const u4*)(vg0 + t_ * 64); vr1 = *(const u4*)(vg1 + t_ * 64); }
#define F2_LSTORE(buf_) { char* bb = smem + (buf_) * BUFB; \
    _Pragma("unroll") for (int i_ = 0; i_ < KCH; ++i_) { int cc_ = tid + 512 * i_; *(u4*)(bb + (cc_ / CPR) * KROW + (cc_ % CPR) * 16) = kr[i_]; } \
    *(u2*)(bb + vso0) = u2{vr0.x, vr0.y}; *(u2*)(bb + vso0 + 8) = u2{vr0.z, vr0.w}; \
    *(u2*)(bb + vso1) = u2{vr1.x, vr1.y}; *(u2*)(bb + vso1 + 8) = u2{vr1.z, vr1.w}; }
#define SEC_STAGE(kt_, nxt_) { F2_LSTORE(nxt_) F2_GLOAD((kt_) + 2) __builtin_amdgcn_sched_barrier(0); }
#define SEC_QK(cur_) { const char* Ks_ = smem + (cur_) * BUFB; \
    _Pragma("unroll") for (int kb = 0; kb < 2; ++kb) _Pragma("unroll") for (int j = 0; j < 16; ++j) s[kb][j] = 0.f; \
    __builtin_amdgcn_s_setprio(1); \
    _Pragma("unroll") for (int kg = 0; kg < DQK / 16 / KG; ++kg) { \
      bf16x8 kf[KG][2]; \
      _Pragma("unroll") for (int k4 = 0; k4 < KG; ++k4) _Pragma("unroll") for (int kb = 0; kb < 2; ++kb) \
        kf[k4][kb] = *(const bf16x8*)(Ks_ + (32 * kb + r) * KROW + (16 * (kg * KG + k4) + 8 * h) * 2); \
      _Pragma("unroll") for (int k4 = 0; k4 < KG; ++k4) _Pragma("unroll") for (int kb = 0; kb < 2; ++kb) \
        s[kb] = __builtin_amdgcn_mfma_f32_32x32x16_bf16(kf[k4][kb], qf[kg * KG + k4], s[kb], 0, 0, 0); \
      __builtin_amdgcn_sched_group_barrier(0x100, 2 * KG, 0); \
      __builtin_amdgcn_sched_group_barrier(0x008, 2 * KG, 0); \
      __builtin_amdgcn_sched_barrier(0); \
    } \
    __builtin_amdgcn_s_setprio(0); }
#define SEC_SOFTMAX() { \
    float mx = s[0][0]; \
    _Pragma("unroll") for (int kb = 0; kb < 2; ++kb) _Pragma("unroll") for (int j = 0; j < 16; ++j) mx = fmaxf(mx, s[kb][j]); \
    mx = half_swap_max(mx); \
    const float mxs = mx * c; \
    if (__builtin_amdgcn_ballot_w64(mxs > m_run + 8.f) != 0ull) { \
      const float m_new = fmaxf(m_run, mxs); \
      const float alpha = __builtin_amdgcn_exp2f(m_run - m_new); \
      m_run = m_new; l_run *= alpha; \
      _Pragma("unroll") for (int i = 0; i < 4; ++i) _Pragma("unroll") for (int j = 0; j < 16; ++j) o[i][j] *= alpha; \
    } \
    float ps = 0.f; \
    _Pragma("unroll") for (int kb = 0; kb < 2; ++kb) _Pragma("unroll") for (int j = 0; j < 16; ++j) { \
        float pv = __builtin_amdgcn_exp2f(s[kb][j] * c - m_run); s[kb][j] = pv; ps += pv; } \
    l_run += ps; \
    _Pragma("unroll") for (int kb = 0; kb < 2; ++kb) _Pragma("unroll") for (int st = 0; st < 2; ++st) { \
        u4 pu; \
        pu.x = pk2(s[kb][8 * st + 0], s[kb][8 * st + 1]); pu.y = pk2(s[kb][8 * st + 2], s[kb][8 * st + 3]); \
        pu.z = pk2(s[kb][8 * st + 4], s[kb][8 * st + 5]); pu.w = pk2(s[kb][8 * st + 6], s[kb][8 * st + 7]); \
        pf[kb][st] = __builtin_bit_cast(bf16x8, pu); } \
    __builtin_amdgcn_sched_barrier(0); }
#define SEC_PV(vb_) { const char* Vs_ = smem + (vb_) * BUFB + 64 * KROW; \
    constexpr int SB_ = (DQK == 64) ? 2 : 1;     \
    __builtin_amdgcn_s_setprio(1); \
    _Pragma("unroll") for (int kbs = 0; kbs < 4 / SB_; ++kbs) { \
      bf16x8 vf[SB_][4]; \
      _Pragma("unroll") for (int sb = 0; sb < SB_; ++sb) _Pragma("unroll") for (int dvb = 0; dvb < 4; ++dvb) { \
          const char* vp = Vs_ + (32 * dvb + r) * VROW + (16 * (kbs * SB_ + sb) + 4 * h) * 2; \
          bf16x4 lo = *(const bf16x4*)vp; bf16x4 hi = *(const bf16x4*)(vp + 16); \
          vf[sb][dvb] = __builtin_shufflevector(lo, hi, 0, 1, 2, 3, 4, 5, 6, 7); } \
      _Pragma("unroll") for (int sb = 0; sb < SB_; ++sb) _Pragma("unroll") for (int dvb = 0; dvb < 4; ++dvb) \
          o[dvb] = __builtin_amdgcn_mfma_f32_32x32x16_bf16(vf[sb][dvb], pf[(kbs * SB_ + sb) >> 1][(kbs * SB_ + sb) & 1], o[dvb], 0, 0, 0); \
      __builtin_amdgcn_sched_group_barrier(0x100, 8 * SB_, 0); \
      __builtin_amdgcn_sched_group_barrier(0x008, 4 * SB_, 0); \
      __builtin_amdgcn_sched_barrier(0); \
    } \
    __builtin_amdgcn_s_setprio(0); }
  F2_GLOAD(0)
  __syncthreads();
  F2_LSTORE(0)
  F2_GLOAD(1)
  __syncthreads();
  int cur = 0, prv = 0;
  if (!skew) {
    for (int kt = 0; kt < nt; ++kt) {
      const int nxt = cur == NBUF - 1 ? 0 : cur + 1;
      SEC_QK(cur)
      SEC_SOFTMAX()
      SEC_STAGE(kt, nxt)
      SEC_PV(cur)
      __syncthreads();
      cur = nxt;
    }
  } else {
    for (int kt = 0; kt < nt; ++kt) {
      const int nxt = cur == NBUF - 1 ? 0 : cur + 1;
      if (kt > 0) SEC_PV(prv)
      SEC_STAGE(kt, nxt)
      SEC_QK(cur)
      SEC_SOFTMAX()
      __syncthreads();
      prv = cur; cur = nxt;
    }
    SEC_PV(prv)
  }
  float l = half_swap_sum(l_run);
  float inv = 1.f / l;
  bf16_t* orow = O + (long)(w * 32 + r) * ldo;
#pragma unroll
  for (int dvb = 0; dvb < 4; ++dvb)
#pragma unroll
    for (int g = 0; g < 4; g += 2) {
      unsigned p0 = pk2(o[dvb][4 * g + 0] * inv, o[dvb][4 * g + 1] * inv), p1 = pk2(o[dvb][4 * g + 2] * inv, o[dvb][4 * g + 3] * inv);
      unsigned q0 = pk2(o[dvb][4 * g + 4] * inv, o[dvb][4 * g + 5] * inv), q1 = pk2(o[dvb][4 * g + 6] * inv, o[dvb][4 * g + 7] * inv);
      auto s0 = __builtin_amdgcn_permlane32_swap(p0, q0, false, false);
      auto s1 = __builtin_amdgcn_permlane32_swap(p1, q1, false, false);
      *(u4*)(orow + 32 * dvb + 8 * (g + h)) = u4{s0[0], s1[0], s0[1], s1[1]};
    }
#undef F2_GLOAD
#undef F2_LSTORE
#undef SEC_STAGE
#undef SEC_QK
#undef SEC_SOFTMAX
#undef SEC_PV
}

constexpr int GL_GS = 0;
constexpr int GL_TOT = 8192;
constexpr int GL_B1 = 10240;
constexpr int GL_B2 = 19456;
constexpr int GL_VT = 28672;
constexpr int GL_AS = 47104;

DI float fexp(float x) { return __builtin_amdgcn_exp2f(x * LOG2E); }
DI float log_sigmoid(float z) { return fminf(z, 0.f) - __logf(1.f + fexp(-fabsf(z))); }

DI void gla_gates(const P& p, int t0, int hh, char* smem, float (&bfv)[16], float (&bbv)[16], float& totf, float& totb) {
  const int tid = VT, d = tid & 63, tg = tid >> 6;
  float* gs = (float*)(smem + GL_GS);
  float* tots = (float*)(smem + GL_TOT);
  const float* gates = (const float*)(p.ws + OFF_GATES) + (long)t0 * 32;
  __syncthreads();
  ((f4*)gs)[tid * 2] = ((const f4*)gates)[tid * 2];
  ((f4*)gs)[tid * 2 + 1] = ((const f4*)gates)[tid * 2 + 1];
  float wf[16], wb[16];
#pragma unroll
  for (int r = 0; r < 16; ++r) {
    wf[r] = p.w_gu_f[r * 256 + hh * 64 + d];
    wb[r] = p.w_gu_b[r * 256 + hh * 64 + d];
  }
  const float biasf = p.b_g_f[hh * 64 + d], biasb = p.b_g_b[hh * 64 + d];
  __syncthreads();
#pragma unroll
  for (int j = 0; j < 16; ++j) {
    const float* gr = gs + (tg * 16 + j) * 32;
    float zf = biasf, zb = biasb;
#pragma unroll
    for (int r = 0; r < 16; ++r) { zf += gr[r] * wf[r]; zb += gr[16 + r] * wb[r]; }
    bfv[j] = log_sigmoid(zf) * (1.f / 16.f);
    bbv[j] = log_sigmoid(zb) * (1.f / 16.f);
  }
  float run = 0.f;
#pragma unroll
  for (int j = 0; j < 16; ++j) { run += bfv[j]; bfv[j] = run; }
  tots[(0 * 4 + tg) * 64 + d] = run;
  run = 0.f;
#pragma unroll
  for (int j = 15; j >= 0; --j) { run += bbv[j]; bbv[j] = run; }
  tots[(1 * 4 + tg) * 64 + d] = run;
  __syncthreads();
  float offf = 0.f, offb = 0.f;
  totf = 0.f; totb = 0.f;
#pragma unroll
  for (int g = 0; g < 4; ++g) {
    float a = tots[(0 * 4 + g) * 64 + d], b = tots[(1 * 4 + g) * 64 + d];
    totf += a; totb += b;
    if (g < tg) offf += a;
    if (g > tg) offb += b;
  }
#pragma unroll
  for (int j = 0; j < 16; ++j) { bfv[j] += offf; bbv[j] += offb; }
}

DI void gla_g1_item(const P& p, int cgi, int hh, char* smem) {
  const int tid = VT, lane = tid & 63, w = tid >> 6, d = tid & 63, tg = tid >> 6;
  const int r16 = lane & 15, q4 = lane >> 4;
  const int t0 = cgi * 64;
  float bfv[16], bbv[16], totf, totb;
  gla_gates(p, t0, hh, smem, bfv, bbv, totf, totb);
  {
    const long rowoff = (long)(t0 + tg * 16) * 256 + hh * 64 + d;
    const bf16_t* gq = (const bf16_t*)(p.ws + OFF_GQ) + rowoff;
    const bf16_t* gk = (const bf16_t*)(p.ws + OFF_GK) + rowoff;
    bf16_t* qef = (bf16_t*)((char*)p.out + OUT_QEF) + rowoff;
    bf16_t* kef = (bf16_t*)((char*)p.out + OUT_KEF) + rowoff;
    bf16_t* qeb = (bf16_t*)((char*)p.out + OUT_QEB) + rowoff;
    bf16_t* keb = (bf16_t*)((char*)p.out + OUT_KEB) + rowoff;
    float qv[16], kv[16];
#pragma unroll
    for (int j = 0; j < 16; ++j) { qv[j] = b2f(gq[(long)j * 256]) * 0.125f; kv[j] = b2f(gk[(long)j * 256]); }
    unsigned pf[8], pb[8];
#pragma unroll
    for (int j = 0; j < 16; ++j) {
      float ef = fexp(bfv[j]), eb = fexp(bbv[j]);
      qef[(long)j * 256] = f2b(qv[j] * ef);
      qeb[(long)j * 256] = f2b(qv[j] * eb);
      kef[(long)j * 256] = f2b(kv[j] * fexp(-bfv[j]));
      keb[(long)j * 256] = f2b(kv[j] * fexp(-bbv[j]));
    }
#pragma unroll
    for (int j = 0; j < 8; ++j) {
      pf[j] = pk2(kv[2 * j] * fexp(totf - bfv[2 * j]), kv[2 * j + 1] * fexp(totf - bfv[2 * j + 1]));
      pb[j] = pk2(kv[2 * j] * fexp(totb - bbv[2 * j]), kv[2 * j + 1] * fexp(totb - bbv[2 * j + 1]));
    }
    char* d1 = smem + GL_B1 + d * GROW + tg * 32;
    char* d2 = smem + GL_B2 + d * GROW + tg * 32;
    *(u4*)(d1) = u4{pf[0], pf[1], pf[2], pf[3]};
    *(u4*)(d1 + 16) = u4{pf[4], pf[5], pf[6], pf[7]};
    *(u4*)(d2) = u4{pb[0], pb[1], pb[2], pb[3]};
    *(u4*)(d2 + 16) = u4{pb[4], pb[5], pb[6], pb[7]};
  }
  if (tg == 0) {
    float* dec = (float*)(p.ws + OFF_DEC) + (long)((cgi * 4 + hh) * 2) * 64;
    dec[d] = fexp(totf);
    dec[64 + d] = fexp(totb);
  }
  const bf16_t* gvt = (const bf16_t*)(p.ws + OFF_GV) + (long)(hh * 128 + 32 * w + r16) * T + t0 + q4 * 8;
  bf16x8 af[2][2];
#pragma unroll
  for (int i = 0; i < 2; ++i)
#pragma unroll
    for (int ks = 0; ks < 2; ++ks) af[i][ks] = *(const bf16x8*)(gvt + (long)(16 * i) * T + ks * 32);
  __syncthreads();
#pragma unroll
  for (int dir = 0; dir < 2; ++dir) {
    const char* kb = smem + (dir ? GL_B2 : GL_B1);
    f32x4 acc[2][4];
#pragma unroll
    for (int i = 0; i < 2; ++i)
#pragma unroll
      for (int j = 0; j < 4; ++j) acc[i][j] = f32x4{0.f, 0.f, 0.f, 0.f};
#pragma unroll
    for (int ks = 0; ks < 2; ++ks) {
      bf16x8 bfr[4];
#pragma unroll
      for (int j = 0; j < 4; ++j) bfr[j] = *(const bf16x8*)(kb + (16 * j + r16) * GROW + (ks * 32 + q4 * 8) * 2);
#pragma unroll
      for (int i = 0; i < 2; ++i)
#pragma unroll
        for (int j = 0; j < 4; ++j) acc[i][j] = __builtin_amdgcn_mfma_f32_16x16x32_bf16(af[i][ks], bfr[j], acc[i][j], 0, 0, 0);
    }
    bf16_t* U = (bf16_t*)(p.ws + OFF_UBUF) + (long)((cgi * 4 + hh) * 2 + dir) * 8192;
#pragma unroll
    for (int i = 0; i < 2; ++i)
#pragma unroll
      for (int j = 0; j < 4; ++j)
#pragma unroll
        for (int r = 0; r < 4; ++r) {
          int v = 32 * w + 16 * i + 4 * q4 + r, dd = 16 * j + r16;
          U[v * 64 + dd] = f2b(acc[i][j][r]);
        }
  }
}

DI void gla_g3_wave(const P& p, int cgi, int hh, int slab, char* wsm) {
  const int lane = VT & 63, r16 = lane & 15, q4 = lane >> 4;
  const int t0 = cgi * 64;
  f32x4 o[8];
#pragma unroll
  for (int j = 0; j < 8; ++j) o[j] = f32x4{0.f, 0.f, 0.f, 0.f};
  const bf16_t* gvt = (const bf16_t*)(p.ws + OFF_GV) + (long)(hh * 128 + r16) * T + t0 + q4 * 8;
  const bf16_t* og = (const bf16_t*)(p.ws + OFF_OG);
#pragma unroll
  for (int dir = 0; dir < 2; ++dir) {
    const bf16_t* QE = (const bf16_t*)((const char*)p.out + (dir ? OUT_QEB : OUT_QEF)) + (long)t0 * 256 + hh * 64 + q4 * 8;
    const bf16_t* KE = (const bf16_t*)((const char*)p.out + (dir ? OUT_KEB : OUT_KEF)) + (long)t0 * 256 + hh * 64 + q4 * 8;
    const bf16_t* S = (const bf16_t*)(p.ws + OFF_UBUF) + (long)((cgi * 4 + hh) * 2 + dir) * 8192;
    bf16x8 qf[2], kf[2][4], vf[8], sf[8];
#pragma unroll
    for (int ks = 0; ks < 2; ++ks) qf[ks] = *(const bf16x8*)(QE + (long)(16 * slab + r16) * 256 + ks * 32);
#pragma unroll
    for (int ks = 0; ks < 2; ++ks)
#pragma unroll
      for (int j = 0; j < 4; ++j) kf[ks][j] = *(const bf16x8*)(KE + (long)(16 * j + r16) * 256 + ks * 32);
#pragma unroll
    for (int j = 0; j < 8; ++j) {
      vf[j] = *(const bf16x8*)(gvt + (long)(16 * j) * T);
      sf[j] = *(const bf16x8*)(S + (16 * j + r16) * 64 + q4 * 8);
    }
    __builtin_amdgcn_sched_barrier(0);
    f32x4 a[4];
#pragma unroll
    for (int j = 0; j < 4; ++j) a[j] = f32x4{0.f, 0.f, 0.f, 0.f};
#pragma unroll
    for (int ks = 0; ks < 2; ++ks)
#pragma unroll
      for (int j = 0; j < 4; ++j) a[j] = __builtin_amdgcn_mfma_f32_16x16x32_bf16(qf[ks], kf[ks][j], a[j], 0, 0, 0);
    __builtin_amdgcn_wave_barrier();
    bf16_t* As = (bf16_t*)wsm;
#pragma unroll
    for (int j = 0; j < 4; ++j)
#pragma unroll
      for (int r = 0; r < 4; ++r) {
        int il = 4 * q4 + r, i = 16 * slab + il, jj = 16 * j + r16;
        bool keep = dir ? (jj >= i) : (jj <= i);
        As[il * 72 + jj] = f2b(keep ? a[j][r] : 0.f);
      }
    __builtin_amdgcn_wave_barrier();
    asm volatile("s_waitcnt lgkmcnt(0)" ::: "memory");
    bf16x8 af[2];
#pragma unroll
    for (int ks = 0; ks < 2; ++ks) af[ks] = *(const bf16x8*)(wsm + r16 * GROW + (ks * 32 + q4 * 8) * 2);
    bf16x8 vf2[8], sf2[8];
#pragma unroll
    for (int j = 0; j < 8; ++j) {
      vf2[j] = *(const bf16x8*)(gvt + (long)(16 * j) * T + 32);
      sf2[j] = *(const bf16x8*)(S + (16 * j + r16) * 64 + 32 + q4 * 8);
    }
    __builtin_amdgcn_sched_barrier(0);
#pragma unroll
    for (int j = 0; j < 8; ++j) {
      o[j] = __builtin_amdgcn_mfma_f32_16x16x32_bf16(af[0], vf[j], o[j], 0, 0, 0);
      o[j] = __builtin_amdgcn_mfma_f32_16x16x32_bf16(qf[0], sf[j], o[j], 0, 0, 0);
    }
    __builtin_amdgcn_sched_barrier(0);
#pragma unroll
    for (int j = 0; j < 8; ++j) {
      o[j] = __builtin_amdgcn_mfma_f32_16x16x32_bf16(af[1], vf2[j], o[j], 0, 0, 0);
      o[j] = __builtin_amdgcn_mfma_f32_16x16x32_bf16(qf[1], sf2[j], o[j], 0, 0, 0);
    }
    __builtin_amdgcn_sched_barrier(0);
  }
  float gv[8][4];
#pragma unroll
  for (int j = 0; j < 8; ++j)
#pragma unroll
    for (int r = 0; r < 4; ++r) gv[j][r] = b2f(og[(long)(t0 + 16 * slab + 4 * q4 + r) * 512 + hh * 128 + 16 * j + r16]);
  __builtin_amdgcn_sched_barrier(0);
  float ss[4];
#pragma unroll
  for (int r = 0; r < 4; ++r) {
    float sq = 0.f;
#pragma unroll
    for (int j = 0; j < 8; ++j) sq += o[j][r] * o[j][r];
    sq += __shfl_xor(sq, 1); sq += __shfl_xor(sq, 2); sq += __shfl_xor(sq, 4); sq += __shfl_xor(sq, 8);
    ss[r] = rsqrtf(sq * (1.f / 128.f) + EPS);
  }
  bf16_t* mixin = (bf16_t*)(p.ws + OFF_MIXIN);
#pragma unroll
  for (int j = 0; j < 8; ++j) {
    const int v = 16 * j + r16;
    const float gw = p.gla_norm_w[v];
#pragma unroll
    for (int r = 0; r < 4; ++r) {
      const int tok = t0 + 16 * slab + 4 * q4 + r;
      float g = gv[j][r];
      float val = o[j][r] * ss[r] * gw * (g / (1.f + fexp(-g)));
      mixin[(long)tok * 1024 + hh * 128 + v] = f2b(val);
    }
  }
}

DI void gla_g3_block(const P& p, int cgi, int hh, char* smem) {
  constexpr int O_QE = 0, O_KE = 9216, O_S = 18432, DIRB = 36864, O_VT = 73728, O_AS = 92160;
  const int tid = threadIdx.x, lane = tid & 63, w = __builtin_amdgcn_readfirstlane(tid >> 6), dir = w >> 2, slab = w & 3;
  const int r16 = lane & 15, q4 = lane >> 4;
  const int t0 = cgi * 64;
  const int row8 = tid >> 3, kc = tid & 7;
  const bf16_t* outb = (const bf16_t*)p.out;
  u4 ld[10];
  {
    const long qoff = (long)(t0 + row8) * 256 + hh * 64 + kc * 8;
    ld[0] = *(const u4*)((const bf16_t*)((const char*)outb + OUT_QEF) + qoff);
    ld[1] = *(const u4*)((const bf16_t*)((const char*)outb + OUT_KEF) + qoff);
    ld[4] = *(const u4*)((const bf16_t*)((const char*)outb + OUT_QEB) + qoff);
    ld[5] = *(const u4*)((const bf16_t*)((const char*)outb + OUT_KEB) + qoff);
    const bf16_t* S0 = (const bf16_t*)(p.ws + OFF_UBUF) + (long)((cgi * 4 + hh) * 2) * 8192 + row8 * 64 + kc * 8;
    ld[2] = *(const u4*)(S0);
    ld[3] = *(const u4*)(S0 + 64 * 64);
    ld[6] = *(const u4*)(S0 + 8192);
    ld[7] = *(const u4*)(S0 + 8192 + 64 * 64);
    const bf16_t* gvt = (const bf16_t*)(p.ws + OFF_GV) + (long)(hh * 128 + row8) * T + t0 + kc * 8;
    ld[8] = *(const u4*)(gvt);
    ld[9] = *(const u4*)(gvt + (long)64 * T);
  }
  __syncthreads();
  {
    const int so = row8 * GROW + kc * 16;
    *(u4*)(smem + O_QE + so) = ld[0];
    *(u4*)(smem + O_KE + so) = ld[1];
    *(u4*)(smem + O_S + so) = ld[2];
    *(u4*)(smem + O_S + 64 * GROW + so) = ld[3];
    *(u4*)(smem + DIRB + O_QE + so) = ld[4];
    *(u4*)(smem + DIRB + O_KE + so) = ld[5];
    *(u4*)(smem + DIRB + O_S + so) = ld[6];
    *(u4*)(smem + DIRB + O_S + 64 * GROW + so) = ld[7];
    *(u4*)(smem + O_VT + so) = ld[8];
    *(u4*)(smem + O_VT + 64 * GROW + so) = ld[9];
  }
  __syncthreads();
  const char* base = smem + dir * DIRB;
  f32x4 o[8];
#pragma unroll
  for (int j = 0; j < 8; ++j) o[j] = f32x4{0.f, 0.f, 0.f, 0.f};
  bf16x8 qf[2];
#pragma unroll
  for (int ks = 0; ks < 2; ++ks) qf[ks] = *(const bf16x8*)(base + O_QE + (16 * slab + r16) * GROW + (ks * 32 + q4 * 8) * 2);
  {
    f32x4 a[4];
#pragma unroll
    for (int j = 0; j < 4; ++j) a[j] = f32x4{0.f, 0.f, 0.f, 0.f};
#pragma unroll
    for (int ks = 0; ks < 2; ++ks)
#pragma unroll
      for (int j = 0; j < 4; ++j) {
        bf16x8 kf = *(const bf16x8*)(base + O_KE + (16 * j + r16) * GROW + (ks * 32 + q4 * 8) * 2);
        a[j] = __builtin_amdgcn_mfma_f32_16x16x32_bf16(qf[ks], kf, a[j], 0, 0, 0);
      }
    bf16_t* As = (bf16_t*)(smem + O_AS + dir * 9216);
#pragma unroll
    for (int j = 0; j < 4; ++j)
#pragma unroll
      for (int r = 0; r < 4; ++r) {
        int i = 16 * slab + 4 * q4 + r, jj = 16 * j + r16;
        bool keep = dir ? (jj >= i) : (jj <= i);
        As[i * 72 + jj] = f2b(keep ? a[j][r] : 0.f);
      }
  }
  __builtin_amdgcn_wave_barrier();
  asm volatile("s_waitcnt lgkmcnt(0)" ::: "memory");
#pragma unroll
  for (int ks = 0; ks < 2; ++ks) {
    bf16x8 af = *(const bf16x8*)(smem + O_AS + dir * 9216 + (16 * slab + r16) * GROW + (ks * 32 + q4 * 8) * 2);
#pragma unroll
    for (int j = 0; j < 8; ++j) {
      bf16x8 vf = *(const bf16x8*)(smem + O_VT + (16 * j + r16) * GROW + (ks * 32 + q4 * 8) * 2);
      o[j] = __builtin_amdgcn_mfma_f32_16x16x32_bf16(af, vf, o[j], 0, 0, 0);
      bf16x8 sf = *(const bf16x8*)(base + O_S + (16 * j + r16) * GROW + (ks * 32 + q4 * 8) * 2);
      o[j] = __builtin_amdgcn_mfma_f32_16x16x32_bf16(qf[ks], sf, o[j], 0, 0, 0);
    }
  }
  __syncthreads();
  float* ob = (float*)smem;
  if (dir == 1) {
#pragma unroll
    for (int j = 0; j < 8; ++j)
#pragma unroll
      for (int r = 0; r < 4; ++r) ob[(16 * slab + 4 * q4 + r) * 132 + 16 * j + r16] = o[j][r];
  }
  float gv[8][4];
  if (dir == 0) {
    const bf16_t* og = (const bf16_t*)(p.ws + OFF_OG);
#pragma unroll
    for (int j = 0; j < 8; ++j)
#pragma unroll
      for (int r = 0; r < 4; ++r) gv[j][r] = b2f(og[(long)(t0 + 16 * slab + 4 * q4 + r) * 512 + hh * 128 + 16 * j + r16]);
  }
  __syncthreads();
  if (dir == 0) {
#pragma unroll
    for (int j = 0; j < 8; ++j)
#pragma unroll
      for (int r = 0; r < 4; ++r) o[j][r] += ob[(16 * slab + 4 * q4 + r) * 132 + 16 * j + r16];
    float ss[4];
#pragma unroll
    for (int r = 0; r < 4; ++r) {
      float sq = 0.f;
#pragma unroll
      for (int j = 0; j < 8; ++j) sq += o[j][r] * o[j][r];
      sq += __shfl_xor(sq, 1); sq += __shfl_xor(sq, 2); sq += __shfl_xor(sq, 4); sq += __shfl_xor(sq, 8);
      ss[r] = rsqrtf(sq * (1.f / 128.f) + EPS);
    }
    bf16_t* mixin = (bf16_t*)(p.ws + OFF_MIXIN);
#pragma unroll
    for (int j = 0; j < 8; ++j) {
      const int v = 16 * j + r16;
      const float gw = p.gla_norm_w[v];
#pragma unroll
      for (int r = 0; r < 4; ++r) {
        const int tok = t0 + 16 * slab + 4 * q4 + r;
        float g = gv[j][r];
        float val = o[j][r] * ss[r] * gw * (g / (1.f + fexp(-g)));
        mixin[(long)tok * 1024 + hh * 128 + v] = f2b(val);
      }
    }
  }
}

DI void gla_scan_item(const P& p, int cbase, int nch, int hh, int dir, int sub) {
  const int e = (sub * 256 + VT) * 2;
  const int d = e & 63;
  bf16_t* U = (bf16_t*)(p.ws + OFF_UBUF);
  const float* dec = (const float*)(p.ws + OFF_DEC);
  float st0 = 0.f, st1 = 0.f;
  for (int n0 = 0; n0 < nch; n0 += 32) {
    unsigned u[32]; u2 dc[32];
#pragma unroll
    for (int j = 0; j < 32; ++j) {
      int n = n0 + j;
      int cgi = cbase + (dir ? nch - 1 - n : n);
      long base = (long)((cgi * 4 + hh) * 2 + dir);
      u[j] = *(const unsigned*)(U + base * 8192 + e);
      dc[j] = *(const u2*)(dec + base * 64 + d);
    }
#pragma unroll
    for (int j = 0; j < 32; ++j) {
      int n = n0 + j;
      int cgi = cbase + (dir ? nch - 1 - n : n);
      long base = (long)((cgi * 4 + hh) * 2 + dir);
      *(unsigned*)(U + base * 8192 + e) = pk2(st0, st1);
      st0 = __uint_as_float(dc[j].x) * st0 + blo(u[j]);
      st1 = __uint_as_float(dc[j].y) * st1 + bhi(u[j]);
    }
  }
}

DI void phase_rope_g1(const P& p, char* smem) {
  _Pragma("nounroll") for (int rp = 0; rp < REPG1; ++rp)
  for (int b0 = 0; b0 < NCHUNK * 4; b0 += VN) { int it = min(b0 + VB, NCHUNK * 4 - 1); gla_g1_item(p, it >> 2, it & 3, smem); }
}

DI void phase_attn_scan(const P& p, char* smem_block, int rep) {
  const int NSCAN_P = 128, NSCAN_S = 4096, NATT_P = 512, NATT_S = 2048;
  const float c = 0.125f * LOG2E;
  if (!rep) {
    for (int it = VB; it < NSCAN_P + NSCAN_S; it += VN) {
      if (it < NSCAN_P) {
        int sub = it & 15, ch = it >> 4;
        gla_scan_item(p, 0, 256, ch >> 1, ch & 1, sub);
      } else {
        int i2 = it - NSCAN_P;
        int sub = i2 & 15, ch = i2 >> 4;
        int sq = ch >> 3;
        gla_scan_item(p, 256 + sq * 32, 32, (ch >> 1) & 3, ch & 1, sub);
      }
    }
  }
  for (int i3 = blockIdx.x; i3 < NATT_P + NATT_S; i3 += gridDim.x) {
    int vh, qb, sq, nkeys;
    if (i3 < NATT_P) { vh = i3 & 7; qb = i3 >> 3; sq = 0; nkeys = TP; }
    else { int i4 = i3 - NATT_P; vh = i4 & 7; int rest = i4 >> 3; qb = rest & 7; sq = 1 + (rest >> 3); nkeys = SS; }
    const int ts = seq_start(sq);
    const int tq = ts + qb * 256;
    const bf16_t* Q = (const bf16_t*)(p.ws + OFF_DQ) + (long)tq * 512 + vh * 64;
    const bf16_t* K = (const bf16_t*)(p.ws + OFF_DK) + (long)ts * 512 + vh * 64;
    const bf16_t* Vt = (const bf16_t*)(p.ws + OFF_DVT) + (long)((vh >> 1) * 128) * T + ts;
    bf16_t* O = (bf16_t*)(p.ws + OFF_ODIFF) + (long)tq * 1024 + vh * 128;
    flash256_item<64>(Q, 512, K, 512, Vt, (long)T, nkeys, c, O, 1024, smem_block);
  }
}

DI void phase_g3_combine(const P& p, char* smem_block) {
  _Pragma("nounroll") for (int rp = 0; rp < REPG3; ++rp)
  for (int it = blockIdx.x; it < NCHUNK * 4; it += gridDim.x) gla_g3_block(p, it >> 2, it & 3, smem_block);
  const int lane = VT & 63;
  float lam;
  {
    float a = p.lq1[lane] * p.lk1[lane], b = p.lq2[lane] * p.lk2[lane];
    a = wave_sum(a); b = wave_sum(b);
    lam = expf(a) - expf(b) + 0.2f;
  }
  const float post = 1.f - 0.2f;
  const bf16_t* od = (const bf16_t*)(p.ws + OFF_ODIFF);
  bf16_t* mixin = (bf16_t*)(p.ws + OFF_MIXIN);
  const int hh = lane >> 4, c8 = (lane & 15) * 8;
  float sw[8];
#pragma unroll
  for (int j = 0; j < 8; ++j) sw[j] = p.subln_w[c8 + j] * post;
  _Pragma("nounroll") for (int rp = 0; rp < REPCMB; ++rp)
  for (int t = VB * 4 + (VT >> 6); t < T; t += VN * 4) {
    u4 a = *(const u4*)(od + (long)t * 1024 + (hh * 2) * 128 + c8);
    u4 b = *(const u4*)(od + (long)t * 1024 + (hh * 2 + 1) * 128 + c8);
    float v[8];
    v[0] = blo(a.x) - lam * blo(b.x); v[1] = bhi(a.x) - lam * bhi(b.x);
    v[2] = blo(a.y) - lam * blo(b.y); v[3] = bhi(a.y) - lam * bhi(b.y);
    v[4] = blo(a.z) - lam * blo(b.z); v[5] = bhi(a.z) - lam * bhi(b.z);
    v[6] = blo(a.w) - lam * blo(b.w); v[7] = bhi(a.w) - lam * bhi(b.w);
    float s = 0.f;
#pragma unroll
    for (int j = 0; j < 8; ++j) s += v[j] * v[j];
    s += __shfl_xor(s, 1); s += __shfl_xor(s, 2); s += __shfl_xor(s, 4); s += __shfl_xor(s, 8);
    float rs = rsqrtf(s * (1.f / 128.f) + EPS);
    u4 pk;
    pk.x = pk2(v[0] * rs * sw[0], v[1] * rs * sw[1]);
    pk.y = pk2(v[2] * rs * sw[2], v[3] * rs * sw[3]);
    pk.z = pk2(v[4] * rs * sw[4], v[5] * rs * sw[5]);
    pk.w = pk2(v[6] * rs * sw[6], v[7] * rs * sw[7]);
    *(u4*)(mixin + (long)t * 1024 + 512 + hh * 128 + c8) = pk;
  }
}

template <int WHICH>
DI void phase_rows(const P& p) {
  const int lane = VT & 63;
  const bf16_t* mix = (const bf16_t*)(p.ws + OFF_MIX);
  bf16_t* hb = (bf16_t*)(p.ws + OFF_HBUF);
  for (int tg = VB * 4 + (VT >> 6); tg < T / NR; tg += VN * 4) {
    const int t = tg * NR;
    char* xo = (char*)(p.out + (long)t * 1024);
    char* xres = xo + 2048;
    const bf16_t* m = mix + (long)t * 1024;
    bf16_t* h = hb + (long)t * 1024;
    if (WHICH == 0) {
      const float* xin = t < TP ? p.xp + (long)t * 1024 : p.xs + (long)(t - TP) * 1024;
      row_resid_xn<true, false>((const char*)xin, 4096, m, p.norm_mix_post, p.norm_x_pre, xres, 4096, h, lane);
    } else if (WHICH == 1) {
      row_resid_xn<false, false>(xres, 4096, m, p.norm_x_post, p.norm_f_pre, xres, 4096, h, lane);
    } else {
      row_resid_xn<false, true>(xres, 4096, m, p.norm_f_post, nullptr, xo, 4096, nullptr, lane);
    }
  }
}

DI void phase_xq_xattn(const P& p, char* smem) {
  char* ws = p.ws;
  const bf16_t* A = (const bf16_t*)(ws + OFF_HBUF);
  const bf16_t* B = (const bf16_t*)(ws + OFF_WXQ);
  const float c = 0.0625f * LOG2E;
  for (int L = blockIdx.x; L < (T / 256) * 4; L += gridDim.x) {
    int tidx = threadIdx.x;
    asm volatile("" : "+v"(tidx));
    const int wid = __builtin_amdgcn_readfirstlane(tidx >> 6), lane = tidx & 63, wr = wid >> 2, wc = wid & 3;
    int fr = lane & 15, fq = lane >> 4;
    int pm, pn;
    g8_unit(L, T / 256, 4, pm, pn);
    const int m0 = pm * 256;
    bf16x8 qf[16];
    {
      f32x4 acc[2][2][4][2];
      g8_tile<true>(A, B, 1024, m0, pn * 256, (bf16_t*)smem, acc, tidx, false);
      asm volatile("" : "+v"(fr), "+v"(fq));
#pragma unroll
      for (int ai = 0; ai < 2; ++ai)
#pragma unroll
        for (int bj = 0; bj < 2; ++bj)
#pragma unroll
          for (int m = 0; m < 4; ++m)
#pragma unroll
            for (int n = 0; n < 2; ++n) {
              const int row = ai * 128 + wr * 64 + m * 16 + fr;
              f32x4 v = acc[ai][bj][m][n];
              u2 pk; pk.x = pk2(v[0], v[1]); pk.y = pk2(v[2], v[3]);
              const int chunk = bj * 16 + wc * 4 + n * 2 + (fq >> 1);
              *(u2*)(smem + row * 512 + ((chunk ^ (row & 31)) << 4) + (fq & 1) * 8) = pk;
            }
    }
    __syncthreads();
    {
      const int row = wid * 32 + (lane & 31), hh = lane >> 5;
#pragma unroll
      for (int ks = 0; ks < 16; ++ks) qf[ks] = *(const bf16x8*)(smem + row * 512 + (((2 * ks + hh) ^ (row & 31)) << 4));
    }
    __syncthreads();
    const int sq = seq_of_token(m0);
    const bf16_t* K = (const bf16_t*)(ws + OFF_KX) + (long)(sq * 256) * 1024 + pn * 256;
#pragma unroll
    for (int half = 0; half < 2; ++half) {
      const bf16_t* Vt = (const bf16_t*)(ws + OFF_VXT) + (long)(pn * 256 + half * 128) * MT + sq * 256;
      bf16_t* O = (bf16_t*)(ws + OFF_XOIN) + (long)m0 * 1024 + pn * 256 + half * 128;
      flash256x_core<256>(qf, K, 1024, Vt, (long)MT, 256, c, O, 1024, smem);
    }
  }
}

constexpr int NPH = 14;

#define XB_TMO      128
#define XB_XCNT(j)  (256  + 64 * (j))
#define XB_XSUB(j)  (1280 + 64 * (j))
#define XB_XGEN(j)  (2304 + 64 * (j))
#define XB_TOP      3328
#define XB_TOPGEN   3392
#define XCD_BAR_WORDS 3456
#define XB_SPIN_CAP (1u << 18)
#define LAS __attribute__((address_space(3)))

__device__ __forceinline__ unsigned xb_ld(unsigned* p)              { return __hip_atomic_load(p, __ATOMIC_RELAXED, __HIP_MEMORY_SCOPE_AGENT); }
__device__ __forceinline__ unsigned xb_add(unsigned* p, unsigned v) { return __hip_atomic_fetch_add(p, v, __ATOMIC_RELAXED, __HIP_MEMORY_SCOPE_AGENT); }
__device__ __forceinline__ unsigned xb_xcc_id() { return (unsigned)__builtin_amdgcn_s_getreg((3 << 11) | 20) & 0xFu; }
#define XB_SPIN(cond, bar) do { unsigned _sp = 0; while (cond) { __builtin_amdgcn_s_sleep(1); \
    if ((++_sp & 255u) == 0u) { if (xb_ld(&(bar)[XB_TMO])) break; if (_sp > XB_SPIN_CAP) { atomicAdd(&(bar)[XB_TMO], 1u); break; } } } } while (0)

struct XcdBarrier {
    unsigned* bar; unsigned x;
    volatile LAS unsigned* st;
};

__device__ __forceinline__ XcdBarrier xcd_barrier_post(unsigned* bar, volatile LAS unsigned* st) {
    XcdBarrier b; b.bar = bar; b.x = xb_xcc_id(); b.st = st;
    if (threadIdx.x == 0) (void)xb_add(&bar[XB_XCNT(b.x)], 1u);
    return b;
}
__device__ __forceinline__ void xcd_barrier_complete(unsigned* bar, unsigned x, unsigned& nloc, unsigned& nx) {
    const unsigned G = gridDim.x * gridDim.y * gridDim.z;
    unsigned sum, cnt, mine, sp = 0u;
    for (;;) {
        sum = 0u; cnt = 0u; mine = 0u;
#pragma unroll
        for (unsigned j = 0; j < 16; ++j) { const unsigned c = xb_ld(&bar[XB_XCNT(j)]); sum += c; cnt += (c > 0u) ? 1u : 0u; mine = (j == x) ? c : mine; }
        if (sum == G) break;
        __builtin_amdgcn_s_sleep(1);
        if ((++sp & 255u) == 0u) { if (xb_ld(&bar[XB_TMO])) break; if (sp > XB_SPIN_CAP) { atomicAdd(&bar[XB_TMO], 1u); break; } }
    }
    nloc = mine > 0u ? mine : 1u; nx = cnt > 0u ? cnt : 1u;
}

__device__ __forceinline__ void xcd_barrier(const XcdBarrier& b) {
    asm volatile("s_waitcnt vmcnt(0)" ::: "memory");
    __syncthreads();
    if (threadIdx.x == 0) {
        unsigned* bar = b.bar;
        __builtin_amdgcn_s_waitcnt(0);
        unsigned nloc = b.st[0], nx = b.st[1];
        if (nloc == 0u) { xcd_barrier_complete(bar, b.x, nloc, nx); b.st[0] = nloc; b.st[1] = nx; }
        const unsigned old = xb_add(&bar[XB_XSUB(b.x)], 1u);
        const unsigned gen = old / nloc;
        if (old + 1u == (gen + 1u) * nloc) {
            __builtin_amdgcn_fence(__ATOMIC_RELEASE, "agent");
            asm volatile("s_waitcnt vmcnt(0)" ::: "memory");
            const unsigned og = xb_add(&bar[XB_TOP], 1u);
            const unsigned tg = og / nx;
            if (og + 1u == (tg + 1u) * nx) xb_add(&bar[XB_TOPGEN], 1u);
            else XB_SPIN(xb_ld(&bar[XB_TOPGEN]) == tg, bar);
            __builtin_amdgcn_fence(__ATOMIC_ACQUIRE, "agent");
            xb_add(&bar[XB_XGEN(b.x)], 1u);
            asm volatile("s_waitcnt vmcnt(0)" ::: "memory");
        } else {
            XB_SPIN(xb_ld(&bar[XB_XGEN(b.x)]) == gen, bar);
            __builtin_amdgcn_fence(__ATOMIC_ACQUIRE, "agent");
            asm volatile("s_waitcnt vmcnt(0)" ::: "memory");
        }
    }
    __syncthreads();
}


DI unsigned long long uni64(unsigned long long v) {
  unsigned lo = __builtin_amdgcn_readfirstlane((unsigned)v), hi = __builtin_amdgcn_readfirstlane((unsigned)(v >> 32));
  return ((unsigned long long)hi << 32) | lo;
}
#define UNI_F(field) lp.field = (const float*)(const __attribute__((address_space(1))) float*)uni64((unsigned long long)lp.field);
DI void uniformize(P& lp) {
  UNI_F(xp) UNI_F(xs) UNI_F(memp) UNI_F(mems)
  UNI_F(norm_mix_pre) UNI_F(w_in) UNI_F(w_gu_f) UNI_F(b_g_f) UNI_F(w_gu_b) UNI_F(b_g_b) UNI_F(gla_norm_w)
  UNI_F(lq1) UNI_F(lk1) UNI_F(lq2) UNI_F(lk2) UNI_F(subln_w) UNI_F(w_out) UNI_F(norm_mix_post) UNI_F(norm_x_pre) UNI_F(norm_mem)
  UNI_F(w_xq) UNI_F(w_xkv) UNI_F(w_xo) UNI_F(norm_x_post) UNI_F(norm_f_pre) UNI_F(w_fg) UNI_F(w_fu) UNI_F(w_fd) UNI_F(norm_f_post)
  lp.out = (float*)(__attribute__((address_space(1))) float*)uni64((unsigned long long)lp.out);
  lp.ws = (char*)(__attribute__((address_space(1))) char*)uni64((unsigned long long)lp.ws);
}

template <int PH>
DI void run_phase(const P& p, char* smem, int rep) {
  char* ws = p.ws;
  if constexpr (PH == 0) phase_prep(p, smem + (threadIdx.x >> 8) * 65536);
  else if constexpr (PH == 2) phase_rope_g1(p, smem + (threadIdx.x >> 8) * 65536);
  else if constexpr (PH == 3) phase_attn_scan(p, smem, rep);
  else if constexpr (PH == 4) phase_g3_combine(p, smem);
  else if constexpr (PH == 6) phase_rows<0>(p);
  else if constexpr (PH == 8) {   }
  else if constexpr (PH == 10) phase_rows<1>(p);
  else if constexpr (PH == 13) phase_rows<2>(p);
  else if constexpr (PH == 1) {
    const Job j0{(const bf16_t*)(ws + OFF_HBUF), (const bf16_t*)(ws + OFF_WIN), nullptr, 1024, T / 256, NIN / 256, 0};
    const Job j1{(const bf16_t*)(ws + OFF_MBUF), (const bf16_t*)(ws + OFF_WXKV), nullptr, 1024, MT / 256, 8, 1};
    const int n0 = j0.mtiles * j0.ntiles, n1 = j1.mtiles * j1.ntiles;
    const int G = gridDim.x;
    bool pre = false;
    for (int L = blockIdx.x; L < n0 + n1; L += G) {
      const bool first = L < n0;
      Job jb;
      jb.A = first ? j0.A : j1.A; jb.B = first ? j0.B : j1.B; jb.dst = nullptr; jb.K = 1024;
      jb.mtiles = first ? j0.mtiles : j1.mtiles; jb.ntiles = first ? j0.ntiles : j1.ntiles; jb.mode = first ? 0 : 1;
      const int L2 = L + G;
      const bool hn = L2 < n0 + n1;
      const bool first2 = L2 < n0;
      Job jn;
      jn.A = first2 ? j0.A : j1.A; jn.B = first2 ? j0.B : j1.B; jn.dst = nullptr; jn.K = 1024;
      jn.mtiles = first2 ? j0.mtiles : j1.mtiles; jn.ntiles = first2 ? j0.ntiles : j1.ntiles; jn.mode = first2 ? 0 : 1;
      run_gemm_unit(p, jb, first ? L : L - n0, smem, pre, hn, jn, first2 ? L2 : L2 - n0);
      pre = hn;
    }
  }
  else if constexpr (PH == 5) run_gemm_job(p, Job{(const bf16_t*)(ws + OFF_MIXIN), (const bf16_t*)(ws + OFF_WOUT), (bf16_t*)(ws + OFF_MIX), 1024, T / 256, 4, 2}, smem);
  else if constexpr (PH == 7) phase_xq_xattn(p, smem);
  else if constexpr (PH == 9) run_gemm_job(p, Job{(const bf16_t*)(ws + OFF_XOIN), (const bf16_t*)(ws + OFF_WXO), (bf16_t*)(ws + OFF_MIX), 1024, T / 256, 4, 2}, smem);
  else if constexpr (PH == 11) run_gemm_job(p, Job{(const bf16_t*)(ws + OFF_HBUF), (const bf16_t*)(ws + OFF_WGU), (bf16_t*)(ws + OFF_ACT), 1024, T / 256, 22, 3}, smem);
  else if constexpr (PH == 12) run_gemm_job(p, Job{(const bf16_t*)(ws + OFF_ACT), (const bf16_t*)(ws + OFF_WDN), (bf16_t*)(ws + OFF_MIX), DFF, T / 256, 4, 2}, smem);
}

constexpr int LDS_BYTES = 131072;
__global__ void __launch_bounds__(512, 2) mega(P p, int ph_lo, int ph_hi) {
  extern __shared__ __attribute__((aligned(16))) char smem[];
  __shared__ u4 xb_words;
  if (threadIdx.x == 0) xb_words = u4{0u, 0u, 0u, 0u};
  __syncthreads();
  XcdBarrier xb = xcd_barrier_post((unsigned*)(p.ws + OFF_BAR), (volatile LAS unsigned*)&xb_words);
  if (ph_lo < 0) cg::this_grid().sync();
#define PHASE(n)                                          \
  if (PHSEL < 0 || PHSEL == n) {                          \
    if (ph_lo <= n && n < ph_hi) {                        \
      if (n > ph_lo) xcd_barrier(xb);                     \
      if (n == 1) { _Pragma("nounroll") for (int xs = 0; xs < XSYNC; ++xs) xcd_barrier(xb); } \
      const __attribute__((address_space(4))) char* kp = (const __attribute__((address_space(4))) char*)__builtin_amdgcn_kernarg_segment_ptr(); \
      asm volatile("" : "+s"(kp));                        \
      P lp;                                               \
      __builtin_memcpy(&lp, kp, sizeof(P));               \
      uniformize(lp);                                     \
      _Pragma("nounroll") for (int rep = 0; rep < (((REPMASK >> n) & 1) ? 2 : 1); ++rep) run_phase<n>(lp, smem, rep); \
    }                                                     \
  }
  PHASE(0) PHASE(1) PHASE(2) PHASE(3) PHASE(4) PHASE(5) PHASE(6) PHASE(7) PHASE(9) PHASE(10) PHASE(11) PHASE(12) PHASE(13)
}

extern "C" void kernel_launch(void* const* d_in, const int* in_sizes, int n_in, void* d_out, int out_size, void* d_ws,
                              size_t ws_size, hipStream_t stream) {
  static int grid_blocks = 0;
  if (!grid_blocks) {
    int dev = 0, cus = 0, per_cu = 0;
    hipGetDevice(&dev);
    hipDeviceGetAttribute(&cus, hipDeviceAttributeMultiprocessorCount, dev);
    hipFuncSetAttribute((const void*)mega, hipFuncAttributeMaxDynamicSharedMemorySize, LDS_BYTES);
    hipOccupancyMaxActiveBlocksPerMultiprocessor(&per_cu, mega, 512, LDS_BYTES);
    if (per_cu < 1) per_cu = 1;
    grid_blocks = cus * per_cu;
  }
  P p{};
  const float** f = (const float**)&p;
  for (int i = 0; i < 29; ++i) f[i] = (const float*)d_in[i];
  p.out = (float*)d_out;
  p.ws = (char*)d_ws;
#if MEGA
  hipMemsetAsync((char*)d_ws + OFF_BAR, 0, 16384, stream);
  int lo = 0, hi = NPH;
  void* args[] = {&p, &lo, &hi};
  hipError_t e = hipLaunchCooperativeKernel((void*)mega, dim3(grid_blocks), dim3(512), args, LDS_BYTES, stream);
  if (e != hipSuccess) fprintf(stderr, "cooperative launch failed: %s (grid %d)\n", hipGetErrorString(e), grid_blocks);
#else
  for (int ph = 0; ph < NPH; ++ph) hipLaunchKernelGGL(mega, dim3(grid_blocks), dim3(512), LDS_BYTES, stream, p, ph, ph + 1);
#endif
}
```

```cpp
#include <hip/hip_runtime.h>
#include <hip/hip_cooperative_groups.h>
#include <stdint.h>
#include <cstdio>
namespace cg = cooperative_groups;

#ifndef MEGA
#define MEGA 1
#endif
#ifndef PHSEL
#define PHSEL -1
#endif
#ifndef REPMASK
#define REPMASK 0
#endif
#ifndef REPG3
#define REPG3 1
#endif
#ifndef REPG1
#define REPG1 1
#endif
#ifndef XSYNC
#define XSYNC 0
#endif
#ifndef REPCMB
#define REPCMB 1
#endif

typedef unsigned short bf16_t;
using bf16x8 = __attribute__((ext_vector_type(8))) short;
using bf16x4 = __attribute__((ext_vector_type(4))) short;
using f32x4 = __attribute__((ext_vector_type(4))) float;
using u4 = __attribute__((ext_vector_type(4))) unsigned;
using u2 = __attribute__((ext_vector_type(2))) unsigned;
using f4 = __attribute__((ext_vector_type(4))) float;
using f32x16 = __attribute__((ext_vector_type(16))) float;
typedef __attribute__((ext_vector_type(2))) __bf16 bf2_t;
#define DI __device__ __forceinline__
#define VT ((int)(threadIdx.x & 255))
#define VB ((int)(blockIdx.x * 2 + (threadIdx.x >> 8)))
#define VN ((int)(gridDim.x * 2))

DI unsigned pk2(float a, float b) { bf2_t v; v[0] = (__bf16)a; v[1] = (__bf16)b; return __builtin_bit_cast(unsigned, v); }
DI bf16_t f2b(float a) { return __builtin_bit_cast(unsigned short, (__bf16)a); }
DI float b2f(unsigned b) { return __uint_as_float(b << 16); }
DI float blo(unsigned u) { return __uint_as_float(u << 16); }
DI float bhi(unsigned u) { return __uint_as_float(u & 0xffff0000u); }
DI float half_swap_max(float x) {
  auto rr = __builtin_amdgcn_permlane32_swap(__float_as_uint(x), __float_as_uint(x), false, false);
  return fmaxf(__uint_as_float(rr[0]), __uint_as_float(rr[1]));
}
DI float half_swap_sum(float x) {
  auto rr = __builtin_amdgcn_permlane32_swap(__float_as_uint(x), __float_as_uint(x), false, false);
  return __uint_as_float(rr[0]) + __uint_as_float(rr[1]);
}
DI float wave_sum(float v) {
#pragma unroll
  for (int o = 32; o > 0; o >>= 1) v += __shfl_xor(v, o);
  return v;
}

constexpr int T = 81920, TP = 16384, SS = 2048, D = 1024, MT = 8448, DFF = 2816;
constexpr int NCHUNK = T / 64;
constexpr int NIN = 3328;
constexpr float EPS = 1e-6f;
constexpr float LOG2E = 1.4426950408889634f;

constexpr size_t OFF_WIN = 0;
constexpr size_t OFF_WOUT = OFF_WIN + (size_t)NIN * 1024 * 2;
constexpr size_t OFF_WXQ = OFF_WOUT + 1024 * 1024 * 2;
constexpr size_t OFF_WXO = OFF_WXQ + 1024 * 1024 * 2;
constexpr size_t OFF_WXKV = OFF_WXO + 1024 * 1024 * 2;
constexpr size_t OFF_WGU = OFF_WXKV + 2048 * 1024 * 2;
constexpr size_t OFF_WDN = OFF_WGU + (size_t)5632 * 1024 * 2;
constexpr size_t OFF_HBUF = OFF_WDN + (size_t)1024 * 2816 * 2;
constexpr size_t OFF_GQ = OFF_HBUF + (size_t)T * 1024 * 2;
constexpr size_t OFF_GK = OFF_GQ + (size_t)T * 256 * 2;
constexpr size_t OFF_GV = OFF_GK + (size_t)T * 256 * 2;
constexpr size_t OFF_OG = OFF_GV + (size_t)T * 512 * 2;
constexpr size_t OFF_DQ = OFF_OG + (size_t)T * 512 * 2;
constexpr size_t OFF_DK = OFF_DQ + (size_t)T * 512 * 2;
constexpr size_t OFF_DVT = OFF_DK + (size_t)T * 512 * 2;
constexpr size_t OFF_GATES = OFF_DVT + (size_t)T * 512 * 2;
constexpr size_t OFF_UBUF = OFF_GATES + (size_t)T * 32 * 4;
constexpr size_t OFF_DEC = OFF_UBUF + (size_t)NCHUNK * 4 * 2 * 8192 * 2;
constexpr size_t OFF_MBUF = OFF_DEC + (size_t)NCHUNK * 4 * 2 * 64 * 4;
constexpr size_t OFF_KX = OFF_MBUF + (size_t)MT * 1024 * 2;
constexpr size_t OFF_VXT = OFF_KX + (size_t)MT * 1024 * 2;
constexpr size_t OFF_BAR = OFF_VXT + (size_t)MT * 1024 * 2;
constexpr size_t WS_END = OFF_BAR + 16384;
constexpr size_t OUT_QEF = 0;
constexpr size_t OUT_KEF = OUT_QEF + (size_t)T * 256 * 2;
constexpr size_t OUT_QEB = OUT_KEF + (size_t)T * 256 * 2;
constexpr size_t OUT_KEB = OUT_QEB + (size_t)T * 256 * 2;
constexpr size_t OFF_ODIFF = OFF_HBUF;
constexpr size_t OFF_MIXIN = OFF_DQ;
constexpr size_t OFF_MIX = OFF_UBUF;
constexpr size_t OFF_QX = OFF_MIXIN;
constexpr size_t OFF_XOIN = OFF_GQ;
constexpr size_t OFF_ACT = OFF_GQ;

struct P {
  const float *xp, *xs, *memp, *mems;
  const float *norm_mix_pre, *w_in, *w_gu_f, *b_g_f, *w_gu_b, *b_g_b, *gla_norm_w;
  const float *lq1, *lk1, *lq2, *lk2, *subln_w, *w_out, *norm_mix_post, *norm_x_pre, *norm_mem;
  const float *w_xq, *w_xkv, *w_xo, *norm_x_post, *norm_f_pre, *w_fg, *w_fu, *w_fd, *norm_f_post;
  float* out;
  char* ws;
};

DI int seq_start(int s) { return s == 0 ? 0 : TP + (s - 1) * SS; }
DI int seq_of_token(int t) { return t < TP ? 0 : 1 + (t - TP) / SS; }

DI void row_norm_bf16(const float* __restrict__ x, const float* __restrict__ w, bf16_t* __restrict__ out, int lane) {
  f4 v[4];
  float ss = 0.f;
#pragma unroll
  for (int i = 0; i < 4; ++i) {
    v[i] = ((const f4*)x)[i * 64 + lane];
    ss += v[i].x * v[i].x + v[i].y * v[i].y + v[i].z * v[i].z + v[i].w * v[i].w;
  }
  ss = wave_sum(ss);
  float rs = rsqrtf(ss * (1.f / 1024.f) + EPS);
#pragma unroll
  for (int i = 0; i < 4; ++i) {
    f4 ww = ((const f4*)w)[i * 64 + lane];
    u2 pk;
    pk.x = pk2(v[i].x * rs * ww.x, v[i].y * rs * ww.y);
    pk.y = pk2(v[i].z * rs * ww.z, v[i].w * rs * ww.w);
    ((u2*)out)[i * 64 + lane] = pk;
  }
}

template <bool XIN_F32, bool LAST>
DI void row_resid(const void* xin, const bf16_t* __restrict__ mix, const float* __restrict__ wpost,
                  const float* __restrict__ wnext, void* xout, bf16_t* __restrict__ hout, int lane) {
  f4 x[4], m[4];
  float ss = 0.f;
#pragma unroll
  for (int i = 0; i < 4; ++i) {
    if (XIN_F32) x[i] = ((const f4*)xin)[i * 64 + lane];
    else { u2 xu = ((const u2*)xin)[i * 64 + lane]; x[i].x = blo(xu.x); x[i].y = bhi(xu.x); x[i].z = blo(xu.y); x[i].w = bhi(xu.y); }
    u2 u = ((const u2*)mix)[i * 64 + lane];
    m[i].x = blo(u.x); m[i].y = bhi(u.x); m[i].z = blo(u.y); m[i].w = bhi(u.y);
    ss += m[i].x * m[i].x + m[i].y * m[i].y + m[i].z * m[i].z + m[i].w * m[i].w;
  }
  ss = wave_sum(ss);
  float rs = rsqrtf(ss * (1.f / 1024.f) + EPS);
  float ss1 = 0.f;
#pragma unroll
  for (int i = 0; i < 4; ++i) {
    f4 ww = ((const f4*)wpost)[i * 64 + lane];
    x[i].x += m[i].x * rs * ww.x; x[i].y += m[i].y * rs * ww.y;
    x[i].z += m[i].z * rs * ww.z; x[i].w += m[i].w * rs * ww.w;
    ss1 += x[i].x * x[i].x + x[i].y * x[i].y + x[i].z * x[i].z + x[i].w * x[i].w;
  }
  if (LAST) {
#pragma unroll
    for (int i = 0; i < 4; ++i) ((f4*)xout)[i * 64 + lane] = x[i];
  } else {
#pragma unroll
    for (int i = 0; i < 4; ++i) {
      u2 pk; pk.x = pk2(x[i].x, x[i].y); pk.y = pk2(x[i].z, x[i].w);
      ((u2*)xout)[i * 64 + lane] = pk;
    }
    ss1 = wave_sum(ss1);
    float rs1 = rsqrtf(ss1 * (1.f / 1024.f) + EPS);
#pragma unroll
    for (int i = 0; i < 4; ++i) {
      f4 ww = ((const f4*)wnext)[i * 64 + lane];
      u2 pk;
      pk.x = pk2(x[i].x * rs1 * ww.x, x[i].y * rs1 * ww.y);
      pk.y = pk2(x[i].z * rs1 * ww.z, x[i].w * rs1 * ww.w);
      ((u2*)hout)[i * 64 + lane] = pk;
    }
  }
}

constexpr int NR = 4;
DI void row_norm_bf16_xn(const float* __restrict__ x, const float* __restrict__ w, bf16_t* __restrict__ out, int lane) {
  f4 v[NR][4];
#pragma unroll
  for (int q = 0; q < NR; ++q)
#pragma unroll
    for (int i = 0; i < 4; ++i) v[q][i] = ((const f4*)(x + q * 1024))[i * 64 + lane];
  __builtin_amdgcn_sched_barrier(0);
#pragma unroll
  for (int q = 0; q < NR; ++q) {
    float ss = 0.f;
#pragma unroll
    for (int i = 0; i < 4; ++i) ss += v[q][i].x * v[q][i].x + v[q][i].y * v[q][i].y + v[q][i].z * v[q][i].z + v[q][i].w * v[q][i].w;
    ss = wave_sum(ss);
    float rs = rsqrtf(ss * (1.f / 1024.f) + EPS);
#pragma unroll
    for (int i = 0; i < 4; ++i) {
      f4 ww = ((const f4*)w)[i * 64 + lane];
      u2 pk;
      pk.x = pk2(v[q][i].x * rs * ww.x, v[q][i].y * rs * ww.y);
      pk.y = pk2(v[q][i].z * rs * ww.z, v[q][i].w * rs * ww.w);
      ((u2*)(out + q * 1024))[i * 64 + lane] = pk;
    }
  }
}

template <bool XIN_F32, bool LAST>
DI void row_resid_xn(const char* xin, int xin_stride, const bf16_t* __restrict__ mix, const float* __restrict__ wpost,
                     const float* __restrict__ wnext, char* xout, int xout_stride, bf16_t* __restrict__ hout, int lane) {
  f4 x[NR][4]; u2 mu[NR][4];
#pragma unroll
  for (int q = 0; q < NR; ++q) {
#pragma unroll
    for (int i = 0; i < 4; ++i) {
      if (XIN_F32) x[q][i] = ((const f4*)(xin + (long)q * xin_stride))[i * 64 + lane];
      else { u2 xu = ((const u2*)(xin + (long)q * xin_stride))[i * 64 + lane]; x[q][i].x = blo(xu.x); x[q][i].y = bhi(xu.x); x[q][i].z = blo(xu.y); x[q][i].w = bhi(xu.y); }
      mu[q][i] = ((const u2*)(mix + q * 1024))[i * 64 + lane];
    }
  }
  __builtin_amdgcn_sched_barrier(0);
#pragma unroll
  for (int q = 0; q < NR; ++q) {
    f4 m[4];
    float ss = 0.f;
#pragma unroll
    for (int i = 0; i < 4; ++i) {
      m[i].x = blo(mu[q][i].x); m[i].y = bhi(mu[q][i].x); m[i].z = blo(mu[q][i].y); m[i].w = bhi(mu[q][i].y);
      ss += m[i].x * m[i].x + m[i].y * m[i].y + m[i].z * m[i].z + m[i].w * m[i].w;
    }
    ss = wave_sum(ss);
    float rs = rsqrtf(ss * (1.f / 1024.f) + EPS);
    float ss1 = 0.f;
#pragma unroll
    for (int i = 0; i < 4; ++i) {
      f4 ww = ((const f4*)wpost)[i * 64 + lane];
      x[q][i].x += m[i].x * rs * ww.x; x[q][i].y += m[i].y * rs * ww.y;
      x[q][i].z += m[i].z * rs * ww.z; x[q][i].w += m[i].w * rs * ww.w;
      ss1 += x[q][i].x * x[q][i].x + x[q][i].y * x[q][i].y + x[q][i].z * x[q][i].z + x[q][i].w * x[q][i].w;
    }
    if (LAST) {
#pragma unroll
      for (int i = 0; i < 4; ++i) ((f4*)(xout + (long)q * xout_stride))[i * 64 + lane] = x[q][i];
    } else {
#pragma unroll
      for (int i = 0; i < 4; ++i) {
        u2 pk; pk.x = pk2(x[q][i].x, x[q][i].y); pk.y = pk2(x[q][i].z, x[q][i].w);
        ((u2*)(xout + (long)q * xout_stride))[i * 64 + lane] = pk;
      }
      ss1 = wave_sum(ss1);
      float rs1 = rsqrtf(ss1 * (1.f / 1024.f) + EPS);
#pragma unroll
      for (int i = 0; i < 4; ++i) {
        f4 ww = ((const f4*)wnext)[i * 64 + lane];
        u2 pk;
        pk.x = pk2(x[q][i].x * rs1 * ww.x, x[q][i].y * rs1 * ww.y);
        pk.y = pk2(x[q][i].z * rs1 * ww.z, x[q][i].w * rs1 * ww.w);
        ((u2*)(hout + q * 1024))[i * 64 + lane] = pk;
      }
    }
  }
}

template <class F>
DI void wt_conv(bf16_t* __restrict__ dst, int K, int N, int tile0, int& tile_base, char* smem, F src4) {
  float* tl = (float*)smem;
  const int tid = VT;
  const int ntn = N >> 6, ntk = K >> 6, nt = ntn * ntk;
  int first = (tile0 & ~1) - tile_base;
  const int stride = VN;
  if (first < 0) first += ((-first + stride - 1) / stride) * stride;
  for (int te = first; te < nt; te += stride) {
    const int t = te + (tile0 & 1);
    const bool live = t < nt;
    const int tn = live ? t % ntn : 0, tk = live ? t / ntn : 0;
    const int n0 = tn * 64, k0 = tk * 64;
    __syncthreads();
    if (live) {
      const int kk = tid >> 4, n4 = (tid & 15) * 4;
#pragma unroll
      for (int it = 0; it < 4; ++it) {
        const int k = kk + 16 * it;
        const float* sp = src4(k0 + k, n0 + n4);
        f4 v = sp ? *(const f4*)sp : f4{0.f, 0.f, 0.f, 0.f};
        tl[k * 65 + n4 + 0] = v.x; tl[k * 65 + n4 + 1] = v.y; tl[k * 65 + n4 + 2] = v.z; tl[k * 65 + n4 + 3] = v.w;
      }
    }
    __syncthreads();
    if (live) {
      const int n = tid >> 2, kq = (tid & 3) * 16;
      unsigned pk[8];
#pragma unroll
      for (int j = 0; j < 8; ++j) pk[j] = pk2(tl[(kq + 2 * j) * 65 + n], tl[(kq + 2 * j + 1) * 65 + n]);
      bf16_t* d = dst + (long)(n0 + n) * K + k0 + kq;
      *(u4*)d = u4{pk[0], pk[1], pk[2], pk[3]};
      *(u4*)(d + 8) = u4{pk[4], pk[5], pk[6], pk[7]};
    }
  }
  tile_base += nt;
}

DI void phase_prep(const P& p, char* smem) {
  char* ws = p.ws;
  int tb = 0;
  const int vb = VB;
  {
    const float* w = p.w_in;
    wt_conv((bf16_t*)(ws + OFF_WIN), 1024, NIN, vb, tb, smem, [=](int k, int n) -> const float* {
      int sc = n < 1024 ? n : (n < 3072 ? n + 32 : (n < 3104 ? n - 3072 + 1024 : -1));
      return sc < 0 ? nullptr : w + (long)k * 3104 + sc;
    });
  }
  { const float* w = p.w_out; wt_conv((bf16_t*)(ws + OFF_WOUT), 1024, 1024, vb, tb, smem, [=](int k, int n) -> const float* { return w + (long)k * 1024 + n; }); }
  { const float* w = p.w_xq;  wt_conv((bf16_t*)(ws + OFF_WXQ), 1024, 1024, vb, tb, smem, [=](int k, int n) -> const float* { return w + (long)k * 1024 + n; }); }
  { const float* w = p.w_xo;  wt_conv((bf16_t*)(ws + OFF_WXO), 1024, 1024, vb, tb, smem, [=](int k, int n) -> const float* { return w + (long)k * 1024 + n; }); }
  { const float* w = p.w_xkv; wt_conv((bf16_t*)(ws + OFF_WXKV), 1024, 2048, vb, tb, smem, [=](int k, int n) -> const float* { return w + (long)k * 2048 + n; }); }
  {
    const float* wg = p.w_fg; const float* wu = p.w_fu;
    wt_conv((bf16_t*)(ws + OFF_WGU), 1024, 5632, vb, tb, smem, [=](int k, int n) -> const float* {
      int pr = n >> 5, which = (n >> 4) & 1, j = n & 15;
      int sc = pr * 16 + j;
      return (which ? wu : wg) + (long)k * DFF + sc;
    });
  }
  { const float* w = p.w_fd; wt_conv((bf16_t*)(ws + OFF_WDN), DFF, 1024, vb, tb, smem, [=](int k, int n) -> const float* { return w + (long)k * 1024 + n; }); }
  const long gtid = (long)VB * 256 + VT;
  (void)gtid;
  const int lane = VT & 63;
  const int gw = VB * 4 + (VT >> 6);
  const int nw = VN * 4;
  for (int rg = gw; rg < MT / NR; rg += nw) {
    const int r = rg * NR;
    const float* src = r < 256 ? p.memp + (long)r * 1024 : p.mems + (long)(r - 256) * 1024;
    row_norm_bf16_xn(src, p.norm_mem, (bf16_t*)(ws + OFF_MBUF) + (long)r * 1024, lane);
  }
  for (int rg = gw; rg < T / NR; rg += nw) {
    const int r = rg * NR;
    const float* src = r < TP ? p.xp + (long)r * 1024 : p.xs + (long)(r - TP) * 1024;
    row_norm_bf16_xn(src, p.norm_mix_pre, (bf16_t*)(ws + OFF_HBUF) + (long)r * 1024, lane);
  }
}

constexpr int GROW = 144;
constexpr int G8_BM = 256, G8_BK = 64, G8_HALF = 128, G8_HT = G8_HALF * G8_BK;

DI int g8_lds_byte(int r, int c) {
  int st = (r >> 4) * 2 + (c >> 5), rr = r & 15, cc = c & 31, ob = rr * 64 + cc * 2;
  return st * 1024 + (ob ^ (((ob >> 9) & 1) << 5));
}
DI void g8_stage_rc(int b, int& R, int& C) {
  int st = b / 1024, sb = b % 1024, swz = sb ^ (((sb >> 9) & 1) << 5);
  R = (st >> 1) * 16 + swz / 64; C = (st & 1) * 32 + (swz % 64) / 2;
}

template <bool SWAP>
DI void g8_tile(const bf16_t* __restrict__ Ag, const bf16_t* __restrict__ Bg, int K, int brow, int bcol, bf16_t* shm,
                f32x4 (&acc)[2][2][4][2], const int tidx, const bool prestaged, const bool halfn = false) {
#define SA(b, h) (shm + ((b) * 2 + (h)) * G8_HT)
#define SB(b, h) (shm + (4 + (b) * 2 + (h)) * G8_HT)
#define STAGE(Pp, BASE, br, kt) do { const char* _gb = (const char*)(BASE + (long)(br) * K + (long)(kt) * G8_BK); \
    __builtin_amdgcn_global_load_lds((const unsigned*)(_gb + voff0), \
        (__attribute__((address_space(3))) unsigned*)((char*)(Pp) + tidx * 16), 16, 0, 0); \
    __builtin_amdgcn_global_load_lds((const unsigned*)(_gb + (long)K * 128 + voff0), \
        (__attribute__((address_space(3))) unsigned*)((char*)(Pp) + tidx * 16 + 8192), 16, 0, 0); } while (0)
#define LDA(dst, b, h) for (int m = 0; m < 4; ++m) for (int k = 0; k < 2; ++k) \
    dst[m][k] = *reinterpret_cast<const bf16x8*>((char*)SA(b, h) + g8_lds_byte(wr * 64 + m * 16 + fr, k * 32 + fq * 8))
#define LDB(dst, b, h) for (int n = 0; n < 2; ++n) for (int k = 0; k < 2; ++k) \
    dst[n][k] = *reinterpret_cast<const bf16x8*>((char*)SB(b, h) + g8_lds_byte(wc * 32 + n * 16 + fr, k * 32 + fq * 8))
#define MMA(ai, bj, Af, Bf) do { __builtin_amdgcn_s_setprio(1); \
    for (int m = 0; m < 4; ++m) for (int n = 0; n < 2; ++n) for (int k = 0; k < 2; ++k) \
      acc[ai][bj][m][n] = SWAP ? __builtin_amdgcn_mfma_f32_16x16x32_bf16(Bf[n][k], Af[m][k], acc[ai][bj][m][n], 0, 0, 0) \
                               : __builtin_amdgcn_mfma_f32_16x16x32_bf16(Af[m][k], Bf[n][k], acc[ai][bj][m][n], 0, 0, 0); \
    __builtin_amdgcn_s_setprio(0); } while (0)
#define WAIT_V(n) asm volatile("s_waitcnt vmcnt(" #n ")" ::: "memory")
#define WAIT_L(n) asm volatile("s_waitcnt lgkmcnt(" #n ")" ::: "memory")
#define BAR __builtin_amdgcn_s_barrier()
#define SCHED __builtin_amdgcn_sched_barrier(0)
  const int wid = __builtin_amdgcn_readfirstlane(tidx >> 6), lane = tidx & 63, wr = wid >> 2, wc = wid & 3, fr = lane & 15, fq = lane >> 4;
#pragma unroll
  for (int a = 0; a < 2; ++a)
#pragma unroll
    for (int b = 0; b < 2; ++b)
#pragma unroll
      for (int m = 0; m < 4; ++m)
#pragma unroll
        for (int n = 0; n < 2; ++n) acc[a][b][m][n] = f32x4{0.f, 0.f, 0.f, 0.f};
  bf16x8 At[4][2], B0[2][2], B1[2][2];
  const int nt = K / G8_BK;
  unsigned voff0;
  { int _r, _c; g8_stage_rc(tidx * 16, _r, _c); voff0 = (unsigned)(_r * K + _c) * 2u; }
  if (!prestaged) {
    STAGE(SB(0, 0), Bg, bcol, 0); STAGE(SA(0, 0), Ag, brow, 0);
    STAGE(SB(0, 1), Bg, bcol + G8_HALF, 0); STAGE(SA(0, 1), Ag, brow + G8_HALF, 0);
    if (wr == 1) BAR;
    WAIT_V(4); BAR;
  } else {
    if (wr == 1) BAR;
    WAIT_V(0); BAR;
  }
  STAGE(SB(1, 0), Bg, bcol, 1); STAGE(SA(1, 0), Ag, brow, 1); STAGE(SB(1, 1), Bg, bcol + G8_HALF, 1);
  WAIT_V(6); BAR;
  for (int t = 0; t < nt - 2; t += 2) {
    LDB(B0, 0, 0); SCHED; LDA(At, 0, 0); STAGE(SA(1, 1), Ag, brow + G8_HALF, t + 1);
    WAIT_L(8); BAR; WAIT_L(0); MMA(0, 0, At, B0); BAR; SCHED;
    LDB(B1, 0, 1); STAGE(SB(0, 0), Bg, bcol, t + 2);
    BAR; WAIT_L(0); if (!halfn) MMA(0, 1, At, B1); BAR;
    LDA(At, 0, 1); STAGE(SA(0, 0), Ag, brow, t + 2);
    BAR; WAIT_L(0); MMA(1, 0, At, B0); BAR; SCHED;
    STAGE(SB(0, 1), Bg, bcol + G8_HALF, t + 2);
    WAIT_V(6); BAR; if (!halfn) MMA(1, 1, At, B1); BAR;
    LDB(B0, 1, 0); SCHED; LDA(At, 1, 0); STAGE(SA(0, 1), Ag, brow + G8_HALF, t + 2);
    WAIT_L(8); BAR; WAIT_L(0); MMA(0, 0, At, B0); BAR; SCHED;
    LDB(B1, 1, 1); STAGE(SB(1, 0), Bg, bcol, t + 3);
    BAR; WAIT_L(0); if (!halfn) MMA(0, 1, At, B1); BAR;
    LDA(At, 1, 1); STAGE(SA(1, 0), Ag, brow, t + 3);
    BAR; WAIT_L(0); MMA(1, 0, At, B0); BAR; SCHED;
    STAGE(SB(1, 1), Bg, bcol + G8_HALF, t + 3);
    WAIT_V(6); BAR; if (!halfn) MMA(1, 1, At, B1); BAR;
  }
  { LDB(B0, 0, 0); LDA(At, 0, 0); STAGE(SA(1, 1), Ag, brow + G8_HALF, nt - 1);
    BAR; WAIT_L(0); MMA(0, 0, At, B0); BAR;
    LDB(B1, 0, 1); BAR; WAIT_L(0); if (!halfn) MMA(0, 1, At, B1); BAR;
    LDA(At, 0, 1); WAIT_V(4); BAR; WAIT_L(0); MMA(1, 0, At, B0); if (!halfn) MMA(1, 1, At, B1); BAR; }
  { LDB(B0, 1, 0); LDA(At, 1, 0); WAIT_V(2); BAR; WAIT_L(0); MMA(0, 0, At, B0); BAR;
    LDB(B1, 1, 1); WAIT_V(0); BAR; WAIT_L(0); if (!halfn) MMA(0, 1, At, B1); BAR;
    LDA(At, 1, 1); BAR; WAIT_L(0); MMA(1, 0, At, B0); if (!halfn) MMA(1, 1, At, B1); BAR; }
  if (wr == 0) BAR;
#undef SA
#undef SB
#undef STAGE
#undef LDA
#undef LDB
#undef MMA
}

DI void g8_stage0(const bf16_t* __restrict__ Ag, const bf16_t* __restrict__ Bg, int K, int brow, int bcol, bf16_t* shm, const int tidx) {
  unsigned voff0;
  { int _r, _c; g8_stage_rc(tidx * 16, _r, _c); voff0 = (unsigned)(_r * K + _c) * 2u; }
#define SA(b, h) (shm + ((b) * 2 + (h)) * G8_HT)
#define SB(b, h) (shm + (4 + (b) * 2 + (h)) * G8_HT)
#define STAGE(Pp, BASE, br, kt) do { const char* _gb = (const char*)(BASE + (long)(br) * K + (long)(kt) * G8_BK); \
    __builtin_amdgcn_global_load_lds((const unsigned*)(_gb + voff0), \
        (__attribute__((address_space(3))) unsigned*)((char*)(Pp) + tidx * 16), 16, 0, 0); \
    __builtin_amdgcn_global_load_lds((const unsigned*)(_gb + (long)K * 128 + voff0), \
        (__attribute__((address_space(3))) unsigned*)((char*)(Pp) + tidx * 16 + 8192), 16, 0, 0); } while (0)
  STAGE(SB(0, 0), Bg, bcol, 0); STAGE(SA(0, 0), Ag, brow, 0);
  STAGE(SB(0, 1), Bg, bcol + G8_HALF, 0); STAGE(SA(0, 1), Ag, brow + G8_HALF, 0);
#undef SA
#undef SB
#undef STAGE
}

struct Job {
  const bf16_t* A; const bf16_t* B; bf16_t* dst;
  int K, mtiles, ntiles, mode;
};

DI void g8_unit(int L, int nM, int nN, int& pm, int& pn) {
  const int nwg = nM * nN;
  int wgid = L;
  { const int q = nwg / 8, r = nwg % 8, xcd = wgid % 8, off = wgid / 8; wgid = (xcd < r ? xcd * (q + 1) : r * (q + 1) + (xcd - r) * q) + off; }
  const int nig = 8 * nN, gid = wgid / nig, fm = gid * 8, gsz = (nM - fm) < 8 ? (nM - fm) : 8;
  pm = fm + ((wgid % nig) % gsz); pn = (wgid % nig) / gsz;
}

DI void run_gemm_unit(const P& p, const Job& jb, int L, char* smem, const bool prestaged, const bool hasnext, const Job& jn, int Ln) {
  char* ws = p.ws;
  int tidx = threadIdx.x;
  asm volatile("" : "+v"(tidx));
  const int wid = __builtin_amdgcn_readfirstlane(tidx >> 6), lane = tidx & 63, wr = wid >> 2, wc = wid & 3;
  int fr = lane & 15, fq = lane >> 4;
  int pm, pn;
  g8_unit(L, jb.mtiles, jb.ntiles, pm, pn);
  const int m0 = pm * 256, n0 = pn * 256;
  f32x4 acc[2][2][4][2];
  const bool transposed = (jb.mode == 0 && ((n0 >= 2560 && n0 < 3072) || (n0 >= 512 && n0 < 1024))) || (jb.mode == 1 && n0 >= 1024);
  g8_tile<true>(jb.A, jb.B, jb.K, m0, n0, (bf16_t*)smem, acc, tidx, prestaged, jb.mode == 0 && n0 >= 3072);
  const bool early = hasnext && (jb.mode == 3);
  if (early) {
    int pm2, pn2;
    g8_unit(Ln, jn.mtiles, jn.ntiles, pm2, pn2);
    g8_stage0(jn.A, jn.B, jn.K, pm2 * 256, pn2 * 256, (bf16_t*)smem, tidx);
  }
  asm volatile("" : "+v"(fr), "+v"(fq));
  const bool gates = (jb.mode == 0 && n0 >= 3072);
  u4 outv[16];
  bf16_t* gdst = nullptr;
  long istride = 0;
  int nch = 16;
  if (gates) {
    if (wc == 0) {
      float* g = (float*)(ws + OFF_GATES);
#pragma unroll
      for (int ai = 0; ai < 2; ++ai)
#pragma unroll
        for (int m = 0; m < 4; ++m)
#pragma unroll
          for (int n = 0; n < 2; ++n) {
            int row = m0 + ai * 128 + wr * 64 + m * 16 + fr;
            *(f32x4*)(g + (long)row * 32 + n * 16 + fq * 4) = acc[ai][0][m][n];
          }
    }
    nch = 0;
  } else if (transposed) {
    bf16_t* dstT; long ldT; int nb;
    if (jb.mode == 0 && n0 < 1024) { dstT = (bf16_t*)(ws + OFF_GV); ldT = T; nb = 512; }
    else if (jb.mode == 0) { dstT = (bf16_t*)(ws + OFF_DVT); ldT = T; nb = 2560; }
    else { dstT = (bf16_t*)(ws + OFF_VXT); ldT = MT; nb = 1024; }
#pragma unroll
    for (int ai = 0; ai < 2; ++ai)
#pragma unroll
      for (int bj = 0; bj < 2; ++bj)
#pragma unroll
        for (int m = 0; m < 4; ++m)
#pragma unroll
          for (int n = 0; n < 2; ++n) {
            const int rowm = ai * 128 + wr * 64 + m * 16 + fr;
            f32x4 v = acc[ai][bj][m][n];
#pragma unroll
            for (int j = 0; j < 4; ++j) {
              const int colL = bj * 128 + wc * 32 + n * 16 + fq * 4 + j;
              *(bf16_t*)(smem + colL * 512 + (((rowm >> 3) ^ (colL & 31)) << 4) + (rowm & 7) * 2) = f2b(v[j]);
            }
          }
    __syncthreads();
#pragma unroll
    for (int i = 0; i < 16; ++i) {
      const int colL = (tidx >> 5) + 16 * i, c = tidx & 31;
      outv[i] = *(const u4*)(smem + colL * 512 + ((c ^ (colL & 31)) << 4));
    }
    gdst = dstT + (long)(n0 - nb + (tidx >> 5)) * ldT + m0 + (tidx & 31) * 8;
    istride = 16 * ldT;
  } else if (jb.mode == 3) {
#pragma unroll
    for (int ai = 0; ai < 2; ++ai)
#pragma unroll
      for (int bj = 0; bj < 2; ++bj)
#pragma unroll
        for (int m = 0; m < 4; ++m) {
          const int row = ai * 128 + wr * 64 + m * 16 + fr;
          f32x4 g = acc[ai][bj][m][0], u = acc[ai][bj][m][1];
          float o[4];
#pragma unroll
          for (int r = 0; r < 4; ++r) o[r] = g[r] * u[r] * __builtin_amdgcn_rcpf(1.f + __builtin_amdgcn_exp2f(-g[r] * LOG2E));
          u2 pk; pk.x = pk2(o[0], o[1]); pk.y = pk2(o[2], o[3]);
          const int chunk = bj * 8 + wc * 2 + (fq >> 1);
          *(u2*)(smem + row * 256 + (row >= 128 ? 65536 : 32768) + ((chunk ^ (row & 15)) << 4) + (fq & 1) * 8) = pk;
        }
    __syncthreads();
#pragma unroll
    for (int i = 0; i < 8; ++i) {
      const int row = (tidx >> 4) + 32 * i, c = tidx & 15;
      outv[i] = *(const u4*)(smem + row * 256 + (row >= 128 ? 65536 : 32768) + ((c ^ (row & 15)) << 4));
    }
    gdst = jb.dst + (long)(m0 + (tidx >> 4)) * DFF + (n0 >> 1) + (tidx & 15) * 8;
    istride = 32L * DFF;
    nch = 8;
  } else {
    bf16_t* dst; int ld; int nb;
    if (jb.mode == 2) { dst = jb.dst; ld = 1024; nb = 0; }
    else if (jb.mode == 1) { dst = (bf16_t*)(ws + OFF_KX); ld = 1024; nb = 0; }
    else {
      if (n0 < 256) { dst = (bf16_t*)(ws + OFF_GQ); ld = 256; nb = 0; }
      else if (n0 < 512) { dst = (bf16_t*)(ws + OFF_GK); ld = 256; nb = 256; }
      else if (n0 < 1536) { dst = (bf16_t*)(ws + OFF_OG); ld = 512; nb = 1024; }
      else if (n0 < 2048) { dst = (bf16_t*)(ws + OFF_DQ); ld = 512; nb = 1536; }
      else { dst = (bf16_t*)(ws + OFF_DK); ld = 512; nb = 2048; }
    }
    const bool rope = (jb.mode == 0) && (n0 >= 1536) && (n0 < 2560) && ((wc & 1) == 0);
    const float l2t = log2f(500000.f) * (1.f / 8.f);
#pragma unroll
    for (int ai = 0; ai < 2; ++ai)
#pragma unroll
      for (int bj = 0; bj < 2; ++bj)
#pragma unroll
        for (int m = 0; m < 4; ++m)
#pragma unroll
          for (int n = 0; n < 2; ++n) {
            const int row = ai * 128 + wr * 64 + m * 16 + fr;
            f32x4 v = acc[ai][bj][m][n];
            if (rope && n == 0) {
              const int grow = m0 + row;
              const int pos = grow < TP ? grow : ((grow - TP) & (SS - 1));
#pragma unroll
              for (int j = 0; j < 4; ++j) {
                auto rr = __builtin_amdgcn_permlane32_swap(__float_as_uint(v[j]), __float_as_uint(v[j]), false, false);
                const float pv = __uint_as_float(fq < 2 ? rr[1] : rr[0]);
                const int i = (fq & 1) * 4 + j;
                const float inv = exp2f(-(float)i * l2t);
                const float ang = (float)pos * inv;
                const float kk = rintf(ang * 0.15915494309189535f);
                const float frv = fmaf(ang, 0.15915494309189535f, -kk) + ang * 6.4206383e-9f;
                const float sn = __builtin_amdgcn_sinf(frv), cs = __builtin_amdgcn_cosf(frv);
                v[j] = fq < 2 ? v[j] * cs - pv * sn : v[j] * cs + pv * sn;
              }
            }
            u2 pk; pk.x = pk2(v[0], v[1]); pk.y = pk2(v[2], v[3]);
            const int chunk = bj * 16 + wc * 4 + n * 2 + (fq >> 1);
            *(u2*)(smem + row * 512 + ((chunk ^ (row & 31)) << 4) + (fq & 1) * 8) = pk;
          }
    __syncthreads();
#pragma unroll
    for (int i = 0; i < 16; ++i) {
      const int row = (tidx >> 5) + 16 * i, c = tidx & 31;
      outv[i] = *(const u4*)(smem + row * 512 + ((c ^ (row & 31)) << 4));
    }
    gdst = dst + (long)(m0 + (tidx >> 5)) * ld + (n0 - nb) + (tidx & 31) * 8;
    istride = 16L * ld;
  }
  __syncthreads();
  if (hasnext && !early) {
    int pm2, pn2;
    g8_unit(Ln, jn.mtiles, jn.ntiles, pm2, pn2);
    g8_stage0(jn.A, jn.B, jn.K, pm2 * 256, pn2 * 256, (bf16_t*)smem, tidx);
  }
#pragma unroll
  for (int i = 0; i < 16; ++i)
    if (i < nch) *(u4*)(gdst + (long)i * istride) = outv[i];
  if (!hasnext) asm volatile("s_waitcnt vmcnt(0)" ::: "memory");
}

DI void run_gemm_job(const P& p, const Job& jb, char* smem) {
  const int nu = jb.mtiles * jb.ntiles;
  const int G = gridDim.x;
  bool pre = false;
  for (int L = blockIdx.x; L < nu; L += G) {
    const bool hn = L + G < nu;
    run_gemm_unit(p, jb, L, smem, pre, hn, jb, L + G);
    pre = hn;
  }
}

constexpr int VROW = 136;

template <int DQK, bool PF>
DI void flash_item(const bf16_t* __restrict__ Q, int ldq, const bf16_t* __restrict__ Kp, int ldk,
                   const bf16_t* __restrict__ Vt, long ldvt, int nkeys, float c, bf16_t* __restrict__ O, int ldo,
                   char* smem) {
  constexpr int KROW = (DQK + 8) * 2;
  constexpr int KCH = 64 * DQK * 2 / 16 / 256;
  constexpr int CPR = DQK / 8;
  char* Ks = smem;
  char* Vs = smem + 64 * KROW;
  const int tid = VT, lane = tid & 63, w = tid >> 6, r = lane & 31, h = lane >> 5;
  bf16x8 qf[DQK / 16];
  {
    const bf16_t* qrow = Q + (long)(w * 32 + r) * ldq + 8 * h;
#pragma unroll
    for (int ks = 0; ks < DQK / 16; ++ks) qf[ks] = *(const bf16x8*)(qrow + 16 * ks);
  }
  f32x16 o[4];
#pragma unroll
  for (int i = 0; i < 4; ++i)
#pragma unroll
    for (int j = 0; j < 16; ++j) o[i][j] = 0.f;
  float m_run = -1e30f, l_run = 0.f;
  u4 kreg[KCH], vreg[4];
#define FL_GLOAD(kt_) \
  _Pragma("unroll") for (int i = 0; i < KCH; ++i) { \
    int cc = tid + 256 * i, row = cc / CPR, kc = cc % CPR; \
    kreg[i] = *(const u4*)(Kp + (long)((kt_) * 64 + row) * ldk + kc * 8); \
  } \
  _Pragma("unroll") for (int i = 0; i < 4; ++i) { \
    int cc = tid + 256 * i, row = cc >> 3, kc = cc & 7; \
    vreg[i] = *(const u4*)(Vt + (long)row * ldvt + (kt_) * 64 + kc * 8); \
  }
#define FL_LSTORE() \
  _Pragma("unroll") for (int i = 0; i < KCH; ++i) { \
    int cc = tid + 256 * i, row = cc / CPR, kc = cc % CPR; \
    *(u4*)(Ks + row * KROW + kc * 16) = kreg[i]; \
  } \
  _Pragma("unroll") for (int i = 0; i < 4; ++i) { \
    int cc = tid + 256 * i, row = cc >> 3, kc = cc & 7; \
    *(u2*)(Vs + row * VROW + kc * 16) = u2{vreg[i].x, vreg[i].y}; \
    *(u2*)(Vs + row * VROW + kc * 16 + 8) = u2{vreg[i].z, vreg[i].w}; \
  }
  const int nt = nkeys >> 6;
  if (PF) { FL_GLOAD(0) }
  for (int kt = 0; kt < nt; ++kt) {
    __syncthreads();
    if (PF) {
      FL_LSTORE()
    } else {
#pragma unroll
      for (int g = 0; g < KCH / 4; ++g) {
        u4 tmp[4];
#pragma unroll
        for (int i = 0; i < 4; ++i) {
          int cc = tid + 256 * (g * 4 + i), row = cc / CPR, kc = cc % CPR;
          tmp[i] = *(const u4*)(Kp + (long)(kt * 64 + row) * ldk + kc * 8);
        }
#pragma unroll
        for (int i = 0; i < 4; ++i) {
          int cc = tid + 256 * (g * 4 + i), row = cc / CPR, kc = cc % CPR;
          *(u4*)(Ks + row * KROW + kc * 16) = tmp[i];
        }
        __builtin_amdgcn_sched_barrier(0);
      }
      {
        u4 tmp[4];
#pragma unroll
        for (int i = 0; i < 4; ++i) {
          int cc = tid + 256 * i, row = cc >> 3, kc = cc & 7;
          tmp[i] = *(const u4*)(Vt + (long)row * ldvt + kt * 64 + kc * 8);
        }
#pragma unroll
        for (int i = 0; i < 4; ++i) {
          int cc = tid + 256 * i, row = cc >> 3, kc = cc & 7;
          *(u2*)(Vs + row * VROW + kc * 16) = u2{tmp[i].x, tmp[i].y};
          *(u2*)(Vs + row * VROW + kc * 16 + 8) = u2{tmp[i].z, tmp[i].w};
        }
      }
    }
    __syncthreads();
    if (PF && kt + 1 < nt) { FL_GLOAD(kt + 1) }
    f32x16 s[2];
#pragma unroll
    for (int kb = 0; kb < 2; ++kb)
#pragma unroll
      for (int j = 0; j < 16; ++j) s[kb][j] = 0.f;
#pragma unroll
    for (int kg = 0; kg < DQK / 64; ++kg) {
      bf16x8 kf[4][2];
#pragma unroll
      for (int k4 = 0; k4 < 4; ++k4)
#pragma unroll
        for (int kb = 0; kb < 2; ++kb)
          kf[k4][kb] = *(const bf16x8*)(Ks + (32 * kb + r) * KROW + (16 * (kg * 4 + k4) + 8 * h) * 2);
#pragma unroll
      for (int k4 = 0; k4 < 4; ++k4)
#pragma unroll
        for (int kb = 0; kb < 2; ++kb)
          s[kb] = __builtin_amdgcn_mfma_f32_32x32x16_bf16(kf[k4][kb], qf[kg * 4 + k4], s[kb], 0, 0, 0);
      __builtin_amdgcn_sched_group_barrier(0x100, 8, 0);
      __builtin_amdgcn_sched_group_barrier(0x008, 8, 0);
      __builtin_amdgcn_sched_barrier(0);
    }
    bf16x8 vf0[2][4];
#pragma unroll
    for (int st = 0; st < 2; ++st)
#pragma unroll
      for (int dvb = 0; dvb < 4; ++dvb) {
        const char* vp = Vs + (32 * dvb + r) * VROW + (16 * st + 4 * h) * 2;
        bf16x4 lo = *(const bf16x4*)vp;
        bf16x4 hi = *(const bf16x4*)(vp + 16);
        vf0[st][dvb] = __builtin_shufflevector(lo, hi, 0, 1, 2, 3, 4, 5, 6, 7);
      }
    __builtin_amdgcn_sched_barrier(0);
    float mx = s[0][0];
#pragma unroll
    for (int kb = 0; kb < 2; ++kb)
#pragma unroll
      for (int j = 0; j < 16; ++j) mx = fmaxf(mx, s[kb][j]);
    mx = half_swap_max(mx);
    const float m_new = fmaxf(m_run, mx * c);
    if (__builtin_amdgcn_ballot_w64(m_new > m_run) != 0ull) {
      const float alpha = __builtin_amdgcn_exp2f(m_run - m_new);
      m_run = m_new;
      l_run *= alpha;
#pragma unroll
      for (int i = 0; i < 4; ++i)
#pragma unroll
        for (int j = 0; j < 16; ++j) o[i][j] *= alpha;
    }
    float ps = 0.f;
#pragma unroll
    for (int kb = 0; kb < 2; ++kb)
#pragma unroll
      for (int j = 0; j < 16; ++j) {
        float pv = __builtin_amdgcn_exp2f(s[kb][j] * c - m_run);
        s[kb][j] = pv;
        ps += pv;
      }
    l_run += ps;
    bf16x8 pf[2][2];
#pragma unroll
    for (int kb = 0; kb < 2; ++kb)
#pragma unroll
      for (int st = 0; st < 2; ++st) {
        u4 pu;
        pu.x = pk2(s[kb][8 * st + 0], s[kb][8 * st + 1]);
        pu.y = pk2(s[kb][8 * st + 2], s[kb][8 * st + 3]);
        pu.z = pk2(s[kb][8 * st + 4], s[kb][8 * st + 5]);
        pu.w = pk2(s[kb][8 * st + 6], s[kb][8 * st + 7]);
        pf[kb][st] = __builtin_bit_cast(bf16x8, pu);
      }
    __builtin_amdgcn_sched_barrier(0);
    bf16x8 vf1[2][4];
#pragma unroll
    for (int st = 0; st < 2; ++st)
#pragma unroll
      for (int dvb = 0; dvb < 4; ++dvb) {
        const char* vp = Vs + (32 * dvb + r) * VROW + (32 + 16 * st + 4 * h) * 2;
        bf16x4 lo = *(const bf16x4*)vp;
        bf16x4 hi = *(const bf16x4*)(vp + 16);
        vf1[st][dvb] = __builtin_shufflevector(lo, hi, 0, 1, 2, 3, 4, 5, 6, 7);
      }
#pragma unroll
    for (int st = 0; st < 2; ++st)
#pragma unroll
      for (int dvb = 0; dvb < 4; ++dvb) o[dvb] = __builtin_amdgcn_mfma_f32_32x32x16_bf16(vf0[st][dvb], pf[0][st], o[dvb], 0, 0, 0);
    __builtin_amdgcn_sched_group_barrier(0x100, 16, 0);
    __builtin_amdgcn_sched_group_barrier(0x008, 8, 0);
    __builtin_amdgcn_sched_barrier(0);
#pragma unroll
    for (int st = 0; st < 2; ++st)
#pragma unroll
      for (int dvb = 0; dvb < 4; ++dvb) o[dvb] = __builtin_amdgcn_mfma_f32_32x32x16_bf16(vf1[st][dvb], pf[1][st], o[dvb], 0, 0, 0);
  }
  float l = half_swap_sum(l_run);
  float inv = 1.f / l;
  bf16_t* orow = O + (long)(w * 32 + r) * ldo;
#pragma unroll
  for (int dvb = 0; dvb < 4; ++dvb)
#pragma unroll
    for (int g = 0; g < 4; g += 2) {
      unsigned p0 = pk2(o[dvb][4 * g + 0] * inv, o[dvb][4 * g + 1] * inv), p1 = pk2(o[dvb][4 * g + 2] * inv, o[dvb][4 * g + 3] * inv);
      unsigned q0 = pk2(o[dvb][4 * g + 4] * inv, o[dvb][4 * g + 5] * inv), q1 = pk2(o[dvb][4 * g + 6] * inv, o[dvb][4 * g + 7] * inv);
      auto s0 = __builtin_amdgcn_permlane32_swap(p0, q0, false, false);
      auto s1 = __builtin_amdgcn_permlane32_swap(p1, q1, false, false);
      *(u4*)(orow + 32 * dvb + 8 * (g + h)) = u4{s0[0], s1[0], s0[1], s1[1]};
    }
  __syncthreads();
}

template <int DQK>
DI void flash256x_core(const bf16x8 (&qf)[DQK / 16], const bf16_t* __restrict__ Kp, int ldk,
                      const bf16_t* __restrict__ Vt, long ldvt, int nkeys, float c, bf16_t* __restrict__ O, int ldo,
                      char* smem) {
  constexpr int KROW = (DQK + 8) * 2;
  constexpr int BUFB = 64 * KROW + 128 * VROW;
  constexpr int KCH = DQK / 64;
  constexpr int CPR = DQK / 8;
  int tid = threadIdx.x;
  asm volatile("" : "+v"(tid));
  const int lane = tid & 63, w = tid >> 6, r = lane & 31, h = lane >> 5;
  f32x16 o[4];
#pragma unroll
  for (int i = 0; i < 4; ++i)
#pragma unroll
    for (int j = 0; j < 16; ++j) o[i][j] = 0.f;
  float m_run = -1e30f, l_run = 0.f;
  const bf16_t* vg0 = Vt + (long)(tid >> 3) * ldvt + (tid & 7) * 8;
  const bf16_t* vg1 = Vt + (long)(64 + (tid >> 3)) * ldvt + (tid & 7) * 8;
  const int vso0 = 64 * KROW + (tid >> 3) * VROW + (tid & 7) * 16;
  const int vso1 = vso0 + 64 * VROW;
  u4 kr[KCH], vr0, vr1;
#define F2_GLOAD(kt_) { _Pragma("unroll") for (int i_ = 0; i_ < KCH; ++i_) { int cc_ = tid + 512 * i_; \
      kr[i_] = *(const u4*)(Kp + (long)((kt_) * 64 + cc_ / CPR) * ldk + (cc_ % CPR) * 8); } \
    vr0 = *(const u4*)(vg0 + (kt_) * 64); vr1 = *(const u4*)(vg1 + (kt_) * 64); }
#define F2_LSTORE(buf_) { char* bb = smem + (buf_) * BUFB; \
    _Pragma("unroll") for (int i_ = 0; i_ < KCH; ++i_) { int cc_ = tid + 512 * i_; *(u4*)(bb + (cc_ / CPR) * KROW + (cc_ % CPR) * 16) = kr[i_]; } \
    *(u2*)(bb + vso0) = u2{vr0.x, vr0.y}; *(u2*)(bb + vso0 + 8) = u2{vr0.z, vr0.w}; \
    *(u2*)(bb + vso1) = u2{vr1.x, vr1.y}; *(u2*)(bb + vso1 + 8) = u2{vr1.z, vr1.w}; }
  const int nt = nkeys >> 6;
  F2_GLOAD(0)
  __syncthreads();
  F2_LSTORE(0)
  if (nt > 1) F2_GLOAD(1)
  __syncthreads();
  for (int kt = 0; kt < nt; ++kt) {
    const char* Ks = smem + (kt & 1) * BUFB;
    const char* Vs = Ks + 64 * KROW;
    f32x16 s[2];
#pragma unroll
    for (int kb = 0; kb < 2; ++kb)
#pragma unroll
      for (int j = 0; j < 16; ++j) s[kb][j] = 0.f;
    constexpr int KG = (DQK == 64) ? 4 : 2;
    __builtin_amdgcn_s_setprio(1);
#pragma unroll
    for (int kg = 0; kg < DQK / 16 / KG; ++kg) {
      bf16x8 kf[KG][2];
#pragma unroll
      for (int k4 = 0; k4 < KG; ++k4)
#pragma unroll
        for (int kb = 0; kb < 2; ++kb) kf[k4][kb] = *(const bf16x8*)(Ks + (32 * kb + r) * KROW + (16 * (kg * KG + k4) + 8 * h) * 2);
#pragma unroll
      for (int k4 = 0; k4 < KG; ++k4)
#pragma unroll
        for (int kb = 0; kb < 2; ++kb) s[kb] = __builtin_amdgcn_mfma_f32_32x32x16_bf16(kf[k4][kb], qf[kg * KG + k4], s[kb], 0, 0, 0);
      __builtin_amdgcn_sched_group_barrier(0x100, 2 * KG, 0);
      __builtin_amdgcn_sched_group_barrier(0x008, 2 * KG, 0);
      __builtin_amdgcn_sched_barrier(0);
    }
    __builtin_amdgcn_s_setprio(0);
    bf16x8 vf0[2][4];
    if constexpr (DQK == 64) {
#pragma unroll
      for (int st = 0; st < 2; ++st)
#pragma unroll
        for (int dvb = 0; dvb < 4; ++dvb) {
          const char* vp = Vs + (32 * dvb + r) * VROW + (16 * st + 4 * h) * 2;
          bf16x4 lo = *(const bf16x4*)vp;
          bf16x4 hi = *(const bf16x4*)(vp + 16);
          vf0[st][dvb] = __builtin_shufflevector(lo, hi, 0, 1, 2, 3, 4, 5, 6, 7);
        }
      __builtin_amdgcn_sched_barrier(0);
    }
    float mx = s[0][0];
#pragma unroll
    for (int kb = 0; kb < 2; ++kb)
#pragma unroll
      for (int j = 0; j < 16; ++j) mx = fmaxf(mx, s[kb][j]);
    mx = half_swap_max(mx);
    const float mxs = mx * c;
    if (__builtin_amdgcn_ballot_w64(mxs > m_run + 8.f) != 0ull) {
      const float m_new = fmaxf(m_run, mxs);
      const float alpha = __builtin_amdgcn_exp2f(m_run - m_new);
      m_run = m_new;
      l_run *= alpha;
#pragma unroll
      for (int i = 0; i < 4; ++i)
#pragma unroll
        for (int j = 0; j < 16; ++j) o[i][j] *= alpha;
    }
    float ps = 0.f;
#pragma unroll
    for (int kb = 0; kb < 2; ++kb)
#pragma unroll
      for (int j = 0; j < 16; ++j) {
        float pv = __builtin_amdgcn_exp2f(s[kb][j] * c - m_run);
        s[kb][j] = pv;
        ps += pv;
      }
    l_run += ps;
    bf16x8 pf[2][2];
#pragma unroll
    for (int kb = 0; kb < 2; ++kb)
#pragma unroll
      for (int st = 0; st < 2; ++st) {
        u4 pu;
        pu.x = pk2(s[kb][8 * st + 0], s[kb][8 * st + 1]);
        pu.y = pk2(s[kb][8 * st + 2], s[kb][8 * st + 3]);
        pu.z = pk2(s[kb][8 * st + 4], s[kb][8 * st + 5]);
        pu.w = pk2(s[kb][8 * st + 6], s[kb][8 * st + 7]);
        pf[kb][st] = __builtin_bit_cast(bf16x8, pu);
      }
    __builtin_amdgcn_sched_barrier(0);
    if (kt + 1 < nt) {
      F2_LSTORE((kt + 1) & 1)
      if (kt + 2 < nt) F2_GLOAD(kt + 2)
    }
    __builtin_amdgcn_sched_barrier(0);
    __builtin_amdgcn_s_setprio(1);
    if constexpr (DQK == 64) {
      bf16x8 vf1[2][4];
#pragma unroll
      for (int st = 0; st < 2; ++st)
#pragma unroll
        for (int dvb = 0; dvb < 4; ++dvb) {
          const char* vp = Vs + (32 * dvb + r) * VROW + (32 + 16 * st + 4 * h) * 2;
          bf16x4 lo = *(const bf16x4*)vp;
          bf16x4 hi = *(const bf16x4*)(vp + 16);
          vf1[st][dvb] = __builtin_shufflevector(lo, hi, 0, 1, 2, 3, 4, 5, 6, 7);
        }
#pragma unroll
      for (int st = 0; st < 2; ++st)
#pragma unroll
        for (int dvb = 0; dvb < 4; ++dvb) o[dvb] = __builtin_amdgcn_mfma_f32_32x32x16_bf16(vf0[st][dvb], pf[0][st], o[dvb], 0, 0, 0);
      __builtin_amdgcn_sched_group_barrier(0x100, 16, 0);
      __builtin_amdgcn_sched_group_barrier(0x008, 8, 0);
      __builtin_amdgcn_sched_barrier(0);
#pragma unroll
      for (int st = 0; st < 2; ++st)
#pragma unroll
        for (int dvb = 0; dvb < 4; ++dvb) o[dvb] = __builtin_amdgcn_mfma_f32_32x32x16_bf16(vf1[st][dvb], pf[1][st], o[dvb], 0, 0, 0);
    } else {
#pragma unroll
      for (int kb = 0; kb < 2; ++kb)
#pragma unroll
        for (int st = 0; st < 2; ++st) {
          bf16x8 vf[4];
#pragma unroll
          for (int dvb = 0; dvb < 4; ++dvb) {
            const char* vp = Vs + (32 * dvb + r) * VROW + (32 * kb + 16 * st + 4 * h) * 2;
            bf16x4 lo = *(const bf16x4*)vp;
            bf16x4 hi = *(const bf16x4*)(vp + 16);
            vf[dvb] = __builtin_shufflevector(lo, hi, 0, 1, 2, 3, 4, 5, 6, 7);
          }
#pragma unroll
          for (int dvb = 0; dvb < 4; ++dvb) o[dvb] = __builtin_amdgcn_mfma_f32_32x32x16_bf16(vf[dvb], pf[kb][st], o[dvb], 0, 0, 0);
          __builtin_amdgcn_sched_group_barrier(0x100, 8, 0);
          __builtin_amdgcn_sched_group_barrier(0x008, 4, 0);
          __builtin_amdgcn_sched_barrier(0);
        }
    }
    __builtin_amdgcn_s_setprio(0);
    __syncthreads();
  }
  float l = half_swap_sum(l_run);
  float inv = 1.f / l;
  bf16_t* orow = O + (long)(w * 32 + r) * ldo;
#pragma unroll
  for (int dvb = 0; dvb < 4; ++dvb)
#pragma unroll
    for (int g = 0; g < 4; g += 2) {
      unsigned p0 = pk2(o[dvb][4 * g + 0] * inv, o[dvb][4 * g + 1] * inv), p1 = pk2(o[dvb][4 * g + 2] * inv, o[dvb][4 * g + 3] * inv);
      unsigned q0 = pk2(o[dvb][4 * g + 4] * inv, o[dvb][4 * g + 5] * inv), q1 = pk2(o[dvb][4 * g + 6] * inv, o[dvb][4 * g + 7] * inv);
      auto s0 = __builtin_amdgcn_permlane32_swap(p0, q0, false, false);
      auto s1 = __builtin_amdgcn_permlane32_swap(p1, q1, false, false);
      *(u4*)(orow + 32 * dvb + 8 * (g + h)) = u4{s0[0], s1[0], s0[1], s1[1]};
    }
#undef F2_GLOAD
#undef F2_LSTORE
}

template <int DQK>
DI void flash256_item(const bf16_t* __restrict__ Q, int ldq, const bf16_t* __restrict__ Kp, int ldk,
                      const bf16_t* __restrict__ Vt, long ldvt, int nkeys, float c, bf16_t* __restrict__ O, int ldo,
                      char* smem) {
  constexpr int KROW = (DQK + 8) * 2;
  constexpr int BUFB = 64 * KROW + 128 * VROW;
  constexpr int NBUF = (DQK == 64) ? 3 : 2;
  constexpr int KCH = DQK / 64;
  constexpr int CPR = DQK / 8;
  constexpr int KG = (DQK == 64) ? 4 : 2;
  const int tid = threadIdx.x, lane = tid & 63, w = __builtin_amdgcn_readfirstlane(tid >> 6), r = lane & 31, h = lane >> 5;
  const bool skew = (DQK == 64) && (w >= 4);
  bf16x8 qf[DQK / 16];
  {
    const bf16_t* qrow = Q + (long)(w * 32 + r) * ldq + 8 * h;
#pragma unroll
    for (int ks = 0; ks < DQK / 16; ++ks) qf[ks] = *(const bf16x8*)(qrow + 16 * ks);
  }
  f32x16 o[4];
#pragma unroll
  for (int i = 0; i < 4; ++i)
#pragma unroll
    for (int j = 0; j < 16; ++j) o[i][j] = 0.f;
  float m_run = -1e30f, l_run = 0.f;
  const bf16_t* vg0 = Vt + (long)(tid >> 3) * ldvt + (tid & 7) * 8;
  const bf16_t* vg1 = Vt + (long)(64 + (tid >> 3)) * ldvt + (tid & 7) * 8;
  const int vso0 = 64 * KROW + (tid >> 3) * VROW + (tid & 7) * 16;
  const int vso1 = vso0 + 64 * VROW;
  const int nt = nkeys >> 6;
  u4 kr[KCH], vr0, vr1;
  bf16x8 pf[2][2];
  f32x16 s[2];
#define F2_GLOAD(kt_) { const int t_ = min((kt_), nt - 1); _Pragma("unroll") for (int i_ = 0; i_ < KCH; ++i_) { int cc_ = tid + 512 * i_; \
      kr[i_] = *(const u4*)(Kp + (long)(t_ * 64 + cc_ / CPR) * ldk + (cc_ % CPR) * 8); } \
    vr0 = *(const u4*)(vg0 + t_ * 64); vr1 = *(const u4*)(vg1 + t_ * 64); }
#define F2_LSTORE(buf_) { char* bb = smem + (buf_) * BUFB; \
    _Pragma("unroll") for (int i_ = 0; i_ < KCH; ++i_) { int cc_ = tid + 512 * i_; *(u4*)(bb + (cc_ / CPR) * KROW + (cc_ % CPR) * 16) = kr[i_]; } \
    *(u2*)(bb + vso0) = u2{vr0.x, vr0.y}; *(u2*)(bb + vso0 + 8) = u2{vr0.z, vr0.w}; \
    *(u2*)(bb + vso1) = u2{vr1.x, vr1.y}; *(u2*)(bb + vso1 + 8) = u2{vr1.z, vr1.w}; }
#define SEC_STAGE(kt_, nxt_) { F2_LSTORE(nxt_) F2_GLOAD((kt_) + 2) __builtin_amdgcn_sched_barrier(0); }
#define SEC_QK(cur_) { const char* Ks_ = smem + (cur_) * BUFB; \
    _Pragma("unroll") for (int kb = 0; kb < 2; ++kb) _Pragma("unroll") for (int j = 0; j < 16; ++j) s[kb][j] = 0.f; \
    __builtin_amdgcn_s_setprio(1); \
    _Pragma("unroll") for (int kg = 0; kg < DQK / 16 / KG; ++kg) { \
      bf16x8 kf[KG][2]; \
      _Pragma("unroll") for (int k4 = 0; k4 < KG; ++k4) _Pragma("unroll") for (int kb = 0; kb < 2; ++kb) \
        kf[k4][kb] = *(const bf16x8*)(Ks_ + (32 * kb + r) * KROW + (16 * (kg * KG + k4) + 8 * h) * 2); \
      _Pragma("unroll") for (int k4 = 0; k4 < KG; ++k4) _Pragma("unroll") for (int kb = 0; kb < 2; ++kb) \
        s[kb] = __builtin_amdgcn_mfma_f32_32x32x16_bf16(kf[k4][kb], qf[kg * KG + k4], s[kb], 0, 0, 0); \
      __builtin_amdgcn_sched_group_barrier(0x100, 2 * KG, 0); \
      __builtin_amdgcn_sched_group_barrier(0x008, 2 * KG, 0); \
      __builtin_amdgcn_sched_barrier(0); \
    } \
    __builtin_amdgcn_s_setprio(0); }
#define SEC_SOFTMAX() { \
    float mx = s[0][0]; \
    _Pragma("unroll") for (int kb = 0; kb < 2; ++kb) _Pragma("unroll") for (int j = 0; j < 16; ++j) mx = fmaxf(mx, s[kb][j]); \
    mx = half_swap_max(mx); \
    const float mxs = mx * c; \
    if (__builtin_amdgcn_ballot_w64(mxs > m_run + 8.f) != 0ull) { \
      const float m_new = fmaxf(m_run, mxs); \
      const float alpha = __builtin_amdgcn_exp2f(m_run - m_new); \
      m_run = m_new; l_run *= alpha; \
      _Pragma("unroll") for (int i = 0; i < 4; ++i) _Pragma("unroll") for (int j = 0; j < 16; ++j) o[i][j] *= alpha; \
    } \
    float ps = 0.f; \
    _Pragma("unroll") for (int kb = 0; kb < 2; ++kb) _Pragma("unroll") for (int j = 0; j < 16; ++j) { \
        float pv = __builtin_amdgcn_exp2f(s[kb][j] * c - m_run); s[kb][j] = pv; ps += pv; } \
    l_run += ps; \
    _Pragma("unroll") for (int kb = 0; kb < 2; ++kb) _Pragma("unroll") for (int st = 0; st < 2; ++st) { \
        u4 pu; \
        pu.x = pk2(s[kb][8 * st + 0], s[kb][8 * st + 1]); pu.y = pk2(s[kb][8 * st + 2], s[kb][8 * st + 3]); \
        pu.z = pk2(s[kb][8 * st + 4], s[kb][8 * st + 5]); pu.w = pk2(s[kb][8 * st + 6], s[kb][8 * st + 7]); \
        pf[kb][st] = __builtin_bit_cast(bf16x8, pu); } \
    __builtin_amdgcn_sched_barrier(0); }
#define SEC_PV(vb_) { const char* Vs_ = smem + (vb_) * BUFB + 64 * KROW; \
    constexpr int SB_ = (DQK == 64) ? 2 : 1;     \
    __builtin_amdgcn_s_setprio(1); \
    _Pragma("unroll") for (int kbs = 0; kbs < 4 / SB_; ++kbs) { \
      bf16x8 vf[SB_][4]; \
      _Pragma("unroll") for (int sb = 0; sb < SB_; ++sb) _Pragma("unroll") for (int dvb = 0; dvb < 4; ++dvb) { \
          const char* vp = Vs_ + (32 * dvb + r) * VROW + (16 * (kbs * SB_ + sb) + 4 * h) * 2; \
          bf16x4 lo = *(const bf16x4*)vp; bf16x4 hi = *(const bf16x4*)(vp + 16); \
          vf[sb][dvb] = __builtin_shufflevector(lo, hi, 0, 1, 2, 3, 4, 5, 6, 7); } \
      _Pragma("unroll") for (int sb = 0; sb < SB_; ++sb) _Pragma("unroll") for (int dvb = 0; dvb < 4; ++dvb) \
          o[dvb] = __builtin_amdgcn_mfma_f32_32x32x16_bf16(vf[sb][dvb], pf[(kbs * SB_ + sb) >> 1][(kbs * SB_ + sb) & 1], o[dvb], 0, 0, 0); \
      __builtin_amdgcn_sched_group_barrier(0x100, 8 * SB_, 0); \
      __builtin_amdgcn_sched_group_barrier(0x008, 4 * SB_, 0); \
      __builtin_amdgcn_sched_barrier(0); \
    } \
    __builtin_amdgcn_s_setprio(0); }
  F2_GLOAD(0)
  __syncthreads();
  F2_LSTORE(0)
  F2_GLOAD(1)
  __syncthreads();
  int cur = 0, prv = 0;
  if (!skew) {
    for (int kt = 0; kt < nt; ++kt) {
      const int nxt = cur == NBUF - 1 ? 0 : cur + 1;
      SEC_QK(cur)
      SEC_SOFTMAX()
      SEC_STAGE(kt, nxt)
      SEC_PV(cur)
      __syncthreads();
      cur = nxt;
    }
  } else {
    for (int kt = 0; kt < nt; ++kt) {
      const int nxt = cur == NBUF - 1 ? 0 : cur + 1;
      if (kt > 0) SEC_PV(prv)
      SEC_STAGE(kt, nxt)
      SEC_QK(cur)
      SEC_SOFTMAX()
      __syncthreads();
      prv = cur; cur = nxt;
    }
    SEC_PV(prv)
  }
  float l = half_swap_sum(l_run);
  float inv = 1.f / l;
  bf16_t* orow = O + (long)(w * 32 + r) * ldo;
#pragma unroll
  for (int dvb = 0; dvb < 4; ++dvb)
#pragma unroll
    for (int g = 0; g < 4; g += 2) {
      unsigned p0 = pk2(o[dvb][4 * g + 0] * inv, o[dvb][4 * g + 1] * inv), p1 = pk2(o[dvb][4 * g + 2] * inv, o[dvb][4 * g + 3] * inv);
      unsigned q0 = pk2(o[dvb][4 * g + 4] * inv, o[dvb][4 * g + 5] * inv), q1 = pk2(o[dvb][4 * g + 6] * inv, o[dvb][4 * g + 7] * inv);
      auto s0 = __builtin_amdgcn_permlane32_swap(p0, q0, false, false);
      auto s1 = __builtin_amdgcn_permlane32_swap(p1, q1, false, false);
      *(u4*)(orow + 32 * dvb + 8 * (g + h)) = u4{s0[0], s1[0], s0[1], s1[1]};
    }
#undef F2_GLOAD
#undef F2_LSTORE
#undef SEC_STAGE
#undef SEC_QK
#undef SEC_SOFTMAX
#undef SEC_PV
}

constexpr int GL_GS = 0;
constexpr int GL_TOT = 8192;
constexpr int GL_B1 = 10240;
constexpr int GL_B2 = 19456;
constexpr int GL_VT = 28672;
constexpr int GL_AS = 47104;

DI float fexp(float x) { return __builtin_amdgcn_exp2f(x * LOG2E); }
DI float log_sigmoid(float z) { return fminf(z, 0.f) - __logf(1.f + fexp(-fabsf(z))); }

DI void gla_gates(const P& p, int t0, int hh, char* smem, float (&bfv)[16], float (&bbv)[16], float& totf, float& totb) {
  const int tid = VT, d = tid & 63, tg = tid >> 6;
  float* gs = (float*)(smem + GL_GS);
  float* tots = (float*)(smem + GL_TOT);
  const float* gates = (const float*)(p.ws + OFF_GATES) + (long)t0 * 32;
  __syncthreads();
  ((f4*)gs)[tid * 2] = ((const f4*)gates)[tid * 2];
  ((f4*)gs)[tid * 2 + 1] = ((const f4*)gates)[tid * 2 + 1];
  float wf[16], wb[16];
#pragma unroll
  for (int r = 0; r < 16; ++r) {
    wf[r] = p.w_gu_f[r * 256 + hh * 64 + d];
    wb[r] = p.w_gu_b[r * 256 + hh * 64 + d];
  }
  const float biasf = p.b_g_f[hh * 64 + d], biasb = p.b_g_b[hh * 64 + d];
  __syncthreads();
#pragma unroll
  for (int j = 0; j < 16; ++j) {
    const float* gr = gs + (tg * 16 + j) * 32;
    float zf = biasf, zb = biasb;
#pragma unroll
    for (int r = 0; r < 16; ++r) { zf += gr[r] * wf[r]; zb += gr[16 + r] * wb[r]; }
    bfv[j] = log_sigmoid(zf) * (1.f / 16.f);
    bbv[j] = log_sigmoid(zb) * (1.f / 16.f);
  }
  float run = 0.f;
#pragma unroll
  for (int j = 0; j < 16; ++j) { run += bfv[j]; bfv[j] = run; }
  tots[(0 * 4 + tg) * 64 + d] = run;
  run = 0.f;
#pragma unroll
  for (int j = 15; j >= 0; --j) { run += bbv[j]; bbv[j] = run; }
  tots[(1 * 4 + tg) * 64 + d] = run;
  __syncthreads();
  float offf = 0.f, offb = 0.f;
  totf = 0.f; totb = 0.f;
#pragma unroll
  for (int g = 0; g < 4; ++g) {
    float a = tots[(0 * 4 + g) * 64 + d], b = tots[(1 * 4 + g) * 64 + d];
    totf += a; totb += b;
    if (g < tg) offf += a;
    if (g > tg) offb += b;
  }
#pragma unroll
  for (int j = 0; j < 16; ++j) { bfv[j] += offf; bbv[j] += offb; }
}

DI void gla_g1_item(const P& p, int cgi, int hh, char* smem) {
  const int tid = VT, lane = tid & 63, w = tid >> 6, d = tid & 63, tg = tid >> 6;
  const int r16 = lane & 15, q4 = lane >> 4;
  const int t0 = cgi * 64;
  float bfv[16], bbv[16], totf, totb;
  gla_gates(p, t0, hh, smem, bfv, bbv, totf, totb);
  {
    const long rowoff = (long)(t0 + tg * 16) * 256 + hh * 64 + d;
    const bf16_t* gq = (const bf16_t*)(p.ws + OFF_GQ) + rowoff;
    const bf16_t* gk = (const bf16_t*)(p.ws + OFF_GK) + rowoff;
    bf16_t* qef = (bf16_t*)((char*)p.out + OUT_QEF) + rowoff;
    bf16_t* kef = (bf16_t*)((char*)p.out + OUT_KEF) + rowoff;
    bf16_t* qeb = (bf16_t*)((char*)p.out + OUT_QEB) + rowoff;
    bf16_t* keb = (bf16_t*)((char*)p.out + OUT_KEB) + rowoff;
    float qv[16], kv[16];
#pragma unroll
    for (int j = 0; j < 16; ++j) { qv[j] = b2f(gq[(long)j * 256]) * 0.125f; kv[j] = b2f(gk[(long)j * 256]); }
    unsigned pf[8], pb[8];
#pragma unroll
    for (int j = 0; j < 16; ++j) {
      float ef = fexp(bfv[j]), eb = fexp(bbv[j]);
      qef[(long)j * 256] = f2b(qv[j] * ef);
      qeb[(long)j * 256] = f2b(qv[j] * eb);
      kef[(long)j * 256] = f2b(kv[j] * fexp(-bfv[j]));
      keb[(long)j * 256] = f2b(kv[j] * fexp(-bbv[j]));
    }
#pragma unroll
    for (int j = 0; j < 8; ++j) {
      pf[j] = pk2(kv[2 * j] * fexp(totf - bfv[2 * j]), kv[2 * j + 1] * fexp(totf - bfv[2 * j + 1]));
      pb[j] = pk2(kv[2 * j] * fexp(totb - bbv[2 * j]), kv[2 * j + 1] * fexp(totb - bbv[2 * j + 1]));
    }
    char* d1 = smem + GL_B1 + d * GROW + tg * 32;
    char* d2 = smem + GL_B2 + d * GROW + tg * 32;
    *(u4*)(d1) = u4{pf[0], pf[1], pf[2], pf[3]};
    *(u4*)(d1 + 16) = u4{pf[4], pf[5], pf[6], pf[7]};
    *(u4*)(d2) = u4{pb[0], pb[1], pb[2], pb[3]};
    *(u4*)(d2 + 16) = u4{pb[4], pb[5], pb[6], pb[7]};
  }
  if (tg == 0) {
    float* dec = (float*)(p.ws + OFF_DEC) + (long)((cgi * 4 + hh) * 2) * 64;
    dec[d] = fexp(totf);
    dec[64 + d] = fexp(totb);
  }
  const bf16_t* gvt = (const bf16_t*)(p.ws + OFF_GV) + (long)(hh * 128 + 32 * w + r16) * T + t0 + q4 * 8;
  bf16x8 af[2][2];
#pragma unroll
  for (int i = 0; i < 2; ++i)
#pragma unroll
    for (int ks = 0; ks < 2; ++ks) af[i][ks] = *(const bf16x8*)(gvt + (long)(16 * i) * T + ks * 32);
  __syncthreads();
#pragma unroll
  for (int dir = 0; dir < 2; ++dir) {
    const char* kb = smem + (dir ? GL_B2 : GL_B1);
    f32x4 acc[2][4];
#pragma unroll
    for (int i = 0; i < 2; ++i)
#pragma unroll
      for (int j = 0; j < 4; ++j) acc[i][j] = f32x4{0.f, 0.f, 0.f, 0.f};
#pragma unroll
    for (int ks = 0; ks < 2; ++ks) {
      bf16x8 bfr[4];
#pragma unroll
      for (int j = 0; j < 4; ++j) bfr[j] = *(const bf16x8*)(kb + (16 * j + r16) * GROW + (ks * 32 + q4 * 8) * 2);
#pragma unroll
      for (int i = 0; i < 2; ++i)
#pragma unroll
        for (int j = 0; j < 4; ++j) acc[i][j] = __builtin_amdgcn_mfma_f32_16x16x32_bf16(af[i][ks], bfr[j], acc[i][j], 0, 0, 0);
    }
    bf16_t* U = (bf16_t*)(p.ws + OFF_UBUF) + (long)((cgi * 4 + hh) * 2 + dir) * 8192;
#pragma unroll
    for (int i = 0; i < 2; ++i)
#pragma unroll
      for (int j = 0; j < 4; ++j)
#pragma unroll
        for (int r = 0; r < 4; ++r) {
          int v = 32 * w + 16 * i + 4 * q4 + r, dd = 16 * j + r16;
          U[v * 64 + dd] = f2b(acc[i][j][r]);
        }
  }
}

DI void gla_g3_wave(const P& p, int cgi, int hh, int slab, char* wsm) {
  const int lane = VT & 63, r16 = lane & 15, q4 = lane >> 4;
  const int t0 = cgi * 64;
  f32x4 o[8];
#pragma unroll
  for (int j = 0; j < 8; ++j) o[j] = f32x4{0.f, 0.f, 0.f, 0.f};
  const bf16_t* gvt = (const bf16_t*)(p.ws + OFF_GV) + (long)(hh * 128 + r16) * T + t0 + q4 * 8;
  const bf16_t* og = (const bf16_t*)(p.ws + OFF_OG);
#pragma unroll
  for (int dir = 0; dir < 2; ++dir) {
    const bf16_t* QE = (const bf16_t*)((const char*)p.out + (dir ? OUT_QEB : OUT_QEF)) + (long)t0 * 256 + hh * 64 + q4 * 8;
    const bf16_t* KE = (const bf16_t*)((const char*)p.out + (dir ? OUT_KEB : OUT_KEF)) + (long)t0 * 256 + hh * 64 + q4 * 8;
    const bf16_t* S = (const bf16_t*)(p.ws + OFF_UBUF) + (long)((cgi * 4 + hh) * 2 + dir) * 8192;
    bf16x8 qf[2], kf[2][4], vf[8], sf[8];
#pragma unroll
    for (int ks = 0; ks < 2; ++ks) qf[ks] = *(const bf16x8*)(QE + (long)(16 * slab + r16) * 256 + ks * 32);
#pragma unroll
    for (int ks = 0; ks < 2; ++ks)
#pragma unroll
      for (int j = 0; j < 4; ++j) kf[ks][j] = *(const bf16x8*)(KE + (long)(16 * j + r16) * 256 + ks * 32);
#pragma unroll
    for (int j = 0; j < 8; ++j) {
      vf[j] = *(const bf16x8*)(gvt + (long)(16 * j) * T);
      sf[j] = *(const bf16x8*)(S + (16 * j + r16) * 64 + q4 * 8);
    }
    __builtin_amdgcn_sched_barrier(0);
    f32x4 a[4];
#pragma unroll
    for (int j = 0; j < 4; ++j) a[j] = f32x4{0.f, 0.f, 0.f, 0.f};
#pragma unroll
    for (int ks = 0; ks < 2; ++ks)
#pragma unroll
      for (int j = 0; j < 4; ++j) a[j] = __builtin_amdgcn_mfma_f32_16x16x32_bf16(qf[ks], kf[ks][j], a[j], 0, 0, 0);
    __builtin_amdgcn_wave_barrier();
    bf16_t* As = (bf16_t*)wsm;
#pragma unroll
    for (int j = 0; j < 4; ++j)
#pragma unroll
      for (int r = 0; r < 4; ++r) {
        int il = 4 * q4 + r, i = 16 * slab + il, jj = 16 * j + r16;
        bool keep = dir ? (jj >= i) : (jj <= i);
        As[il * 72 + jj] = f2b(keep ? a[j][r] : 0.f);
      }
    __builtin_amdgcn_wave_barrier();
    asm volatile("s_waitcnt lgkmcnt(0)" ::: "memory");
    bf16x8 af[2];
#pragma unroll
    for (int ks = 0; ks < 2; ++ks) af[ks] = *(const bf16x8*)(wsm + r16 * GROW + (ks * 32 + q4 * 8) * 2);
    bf16x8 vf2[8], sf2[8];
#pragma unroll
    for (int j = 0; j < 8; ++j) {
      vf2[j] = *(const bf16x8*)(gvt + (long)(16 * j) * T + 32);
      sf2[j] = *(const bf16x8*)(S + (16 * j + r16) * 64 + 32 + q4 * 8);
    }
    __builtin_amdgcn_sched_barrier(0);
#pragma unroll
    for (int j = 0; j < 8; ++j) {
      o[j] = __builtin_amdgcn_mfma_f32_16x16x32_bf16(af[0], vf[j], o[j], 0, 0, 0);
      o[j] = __builtin_amdgcn_mfma_f32_16x16x32_bf16(qf[0], sf[j], o[j], 0, 0, 0);
    }
    __builtin_amdgcn_sched_barrier(0);
#pragma unroll
    for (int j = 0; j < 8; ++j) {
      o[j] = __builtin_amdgcn_mfma_f32_16x16x32_bf16(af[1], vf2[j], o[j], 0, 0, 0);
      o[j] = __builtin_amdgcn_mfma_f32_16x16x32_bf16(qf[1], sf2[j], o[j], 0, 0, 0);
    }
    __builtin_amdgcn_sched_barrier(0);
  }
  float gv[8][4];
#pragma unroll
  for (int j = 0; j < 8; ++j)
#pragma unroll
    for (int r = 0; r < 4; ++r) gv[j][r] = b2f(og[(long)(t0 + 16 * slab + 4 * q4 + r) * 512 + hh * 128 + 16 * j + r16]);
  __builtin_amdgcn_sched_barrier(0);
  float ss[4];
#pragma unroll
  for (int r = 0; r < 4; ++r) {
    float sq = 0.f;
#pragma unroll
    for (int j = 0; j < 8; ++j) sq += o[j][r] * o[j][r];
    sq += __shfl_xor(sq, 1); sq += __shfl_xor(sq, 2); sq += __shfl_xor(sq, 4); sq += __shfl_xor(sq, 8);
    ss[r] = rsqrtf(sq * (1.f / 128.f) + EPS);
  }
  bf16_t* mixin = (bf16_t*)(p.ws + OFF_MIXIN);
#pragma unroll
  for (int j = 0; j < 8; ++j) {
    const int v = 16 * j + r16;
    const float gw = p.gla_norm_w[v];
#pragma unroll
    for (int r = 0; r < 4; ++r) {
      const int tok = t0 + 16 * slab + 4 * q4 + r;
      float g = gv[j][r];
      float val = o[j][r] * ss[r] * gw * (g / (1.f + fexp(-g)));
      mixin[(long)tok * 1024 + hh * 128 + v] = f2b(val);
    }
  }
}

DI void gla_g3_block(const P& p, int cgi, int hh, char* smem) {
  constexpr int O_QE = 0, O_KE = 9216, O_S = 18432, DIRB = 36864, O_VT = 73728, O_AS = 92160;
  const int tid = threadIdx.x, lane = tid & 63, w = __builtin_amdgcn_readfirstlane(tid >> 6), dir = w >> 2, slab = w & 3;
  const int r16 = lane & 15, q4 = lane >> 4;
  const int t0 = cgi * 64;
  const int row8 = tid >> 3, kc = tid & 7;
  const bf16_t* outb = (const bf16_t*)p.out;
  u4 ld[10];
  {
    const long qoff = (long)(t0 + row8) * 256 + hh * 64 + kc * 8;
    ld[0] = *(const u4*)((const bf16_t*)((const char*)outb + OUT_QEF) + qoff);
    ld[1] = *(const u4*)((const bf16_t*)((const char*)outb + OUT_KEF) + qoff);
    ld[4] = *(const u4*)((const bf16_t*)((const char*)outb + OUT_QEB) + qoff);
    ld[5] = *(const u4*)((const bf16_t*)((const char*)outb + OUT_KEB) + qoff);
    const bf16_t* S0 = (const bf16_t*)(p.ws + OFF_UBUF) + (long)((cgi * 4 + hh) * 2) * 8192 + row8 * 64 + kc * 8;
    ld[2] = *(const u4*)(S0);
    ld[3] = *(const u4*)(S0 + 64 * 64);
    ld[6] = *(const u4*)(S0 + 8192);
    ld[7] = *(const u4*)(S0 + 8192 + 64 * 64);
    const bf16_t* gvt = (const bf16_t*)(p.ws + OFF_GV) + (long)(hh * 128 + row8) * T + t0 + kc * 8;
    ld[8] = *(const u4*)(gvt);
    ld[9] = *(const u4*)(gvt + (long)64 * T);
  }
  __syncthreads();
  {
    const int so = row8 * GROW + kc * 16;
    *(u4*)(smem + O_QE + so) = ld[0];
    *(u4*)(smem + O_KE + so) = ld[1];
    *(u4*)(smem + O_S + so) = ld[2];
    *(u4*)(smem + O_S + 64 * GROW + so) = ld[3];
    *(u4*)(smem + DIRB + O_QE + so) = ld[4];
    *(u4*)(smem + DIRB + O_KE + so) = ld[5];
    *(u4*)(smem + DIRB + O_S + so) = ld[6];
    *(u4*)(smem + DIRB + O_S + 64 * GROW + so) = ld[7];
    *(u4*)(smem + O_VT + so) = ld[8];
    *(u4*)(smem + O_VT + 64 * GROW + so) = ld[9];
  }
  __syncthreads();
  const char* base = smem + dir * DIRB;
  f32x4 o[8];
#pragma unroll
  for (int j = 0; j < 8; ++j) o[j] = f32x4{0.f, 0.f, 0.f, 0.f};
  bf16x8 qf[2];
#pragma unroll
  for (int ks = 0; ks < 2; ++ks) qf[ks] = *(const bf16x8*)(base + O_QE + (16 * slab + r16) * GROW + (ks * 32 + q4 * 8) * 2);
  {
    f32x4 a[4];
#pragma unroll
    for (int j = 0; j < 4; ++j) a[j] = f32x4{0.f, 0.f, 0.f, 0.f};
#pragma unroll
    for (int ks = 0; ks < 2; ++ks)
#pragma unroll
      for (int j = 0; j < 4; ++j) {
        bf16x8 kf = *(const bf16x8*)(base + O_KE + (16 * j + r16) * GROW + (ks * 32 + q4 * 8) * 2);
        a[j] = __builtin_amdgcn_mfma_f32_16x16x32_bf16(qf[ks], kf, a[j], 0, 0, 0);
      }
    bf16_t* As = (bf16_t*)(smem + O_AS + dir * 9216);
#pragma unroll
    for (int j = 0; j < 4; ++j)
#pragma unroll
      for (int r = 0; r < 4; ++r) {
        int i = 16 * slab + 4 * q4 + r, jj = 16 * j + r16;
        bool keep = dir ? (jj >= i) : (jj <= i);
        As[i * 72 + jj] = f2b(keep ? a[j][r] : 0.f);
      }
  }
  __builtin_amdgcn_wave_barrier();
  asm volatile("s_waitcnt lgkmcnt(0)" ::: "memory");
#pragma unroll
  for (int ks = 0; ks < 2; ++ks) {
    bf16x8 af = *(const bf16x8*)(smem + O_AS + dir * 9216 + (16 * slab + r16) * GROW + (ks * 32 + q4 * 8) * 2);
#pragma unroll
    for (int j = 0; j < 8; ++j) {
      bf16x8 vf = *(const bf16x8*)(smem + O_VT + (16 * j + r16) * GROW + (ks * 32 + q4 * 8) * 2);
      o[j] = __builtin_amdgcn_mfma_f32_16x16x32_bf16(af, vf, o[j], 0, 0, 0);
      bf16x8 sf = *(const bf16x8*)(base + O_S + (16 * j + r16) * GROW + (ks * 32 + q4 * 8) * 2);
      o[j] = __builtin_amdgcn_mfma_f32_16x16x32_bf16(qf[ks], sf, o[j], 0, 0, 0);
    }
  }
  __syncthreads();
  float* ob = (float*)smem;
  if (dir == 1) {
#pragma unroll
    for (int j = 0; j < 8; ++j)
#pragma unroll
      for (int r = 0; r < 4; ++r) ob[(16 * slab + 4 * q4 + r) * 132 + 16 * j + r16] = o[j][r];
  }
  float gv[8][4];
  if (dir == 0) {
    const bf16_t* og = (const bf16_t*)(p.ws + OFF_OG);
#pragma unroll
    for (int j = 0; j < 8; ++j)
#pragma unroll
      for (int r = 0; r < 4; ++r) gv[j][r] = b2f(og[(long)(t0 + 16 * slab + 4 * q4 + r) * 512 + hh * 128 + 16 * j + r16]);
  }
  __syncthreads();
  if (dir == 0) {
#pragma unroll
    for (int j = 0; j < 8; ++j)
#pragma unroll
      for (int r = 0; r < 4; ++r) o[j][r] += ob[(16 * slab + 4 * q4 + r) * 132 + 16 * j + r16];
    float ss[4];
#pragma unroll
    for (int r = 0; r < 4; ++r) {
      float sq = 0.f;
#pragma unroll
      for (int j = 0; j < 8; ++j) sq += o[j][r] * o[j][r];
      sq += __shfl_xor(sq, 1); sq += __shfl_xor(sq, 2); sq += __shfl_xor(sq, 4); sq += __shfl_xor(sq, 8);
      ss[r] = rsqrtf(sq * (1.f / 128.f) + EPS);
    }
    bf16_t* mixin = (bf16_t*)(p.ws + OFF_MIXIN);
#pragma unroll
    for (int j = 0; j < 8; ++j) {
      const int v = 16 * j + r16;
      const float gw = p.gla_norm_w[v];
#pragma unroll
      for (int r = 0; r < 4; ++r) {
        const int tok = t0 + 16 * slab + 4 * q4 + r;
        float g = gv[j][r];
        float val = o[j][r] * ss[r] * gw * (g / (1.f + fexp(-g)));
        mixin[(long)tok * 1024 + hh * 128 + v] = f2b(val);
      }
    }
  }
}

DI void gla_scan_item(const P& p, int cbase, int nch, int hh, int dir, int sub) {
  const int e = (sub * 256 + VT) * 2;
  const int d = e & 63;
  bf16_t* U = (bf16_t*)(p.ws + OFF_UBUF);
  const float* dec = (const float*)(p.ws + OFF_DEC);
  float st0 = 0.f, st1 = 0.f;
  for (int n0 = 0; n0 < nch; n0 += 32) {
    unsigned u[32]; u2 dc[32];
#pragma unroll
    for (int j = 0; j < 32; ++j) {
      int n = n0 + j;
      int cgi = cbase + (dir ? nch - 1 - n : n);
      long base = (long)((cgi * 4 + hh) * 2 + dir);
      u[j] = *(const unsigned*)(U + base * 8192 + e);
      dc[j] = *(const u2*)(dec + base * 64 + d);
    }
#pragma unroll
    for (int j = 0; j < 32; ++j) {
      int n = n0 + j;
      int cgi = cbase + (dir ? nch - 1 - n : n);
      long base = (long)((cgi * 4 + hh) * 2 + dir);
      *(unsigned*)(U + base * 8192 + e) = pk2(st0, st1);
      st0 = __uint_as_float(dc[j].x) * st0 + blo(u[j]);
      st1 = __uint_as_float(dc[j].y) * st1 + bhi(u[j]);
    }
  }
}

DI void phase_rope_g1(const P& p, char* smem) {
  _Pragma("nounroll") for (int rp = 0; rp < REPG1; ++rp)
  for (int b0 = 0; b0 < NCHUNK * 4; b0 += VN) { int it = min(b0 + VB, NCHUNK * 4 - 1); gla_g1_item(p, it >> 2, it & 3, smem); }
}

DI void phase_attn_scan(const P& p, char* smem_block, int rep) {
  const int NSCAN_P = 128, NSCAN_S = 4096, NATT_P = 512, NATT_S = 2048;
  const float c = 0.125f * LOG2E;
  if (!rep) {
    for (int it = VB; it < NSCAN_P + NSCAN_S; it += VN) {
      if (it < NSCAN_P) {
        int sub = it & 15, ch = it >> 4;
        gla_scan_item(p, 0, 256, ch >> 1, ch & 1, sub);
      } else {
        int i2 = it - NSCAN_P;
        int sub = i2 & 15, ch = i2 >> 4;
        int sq = ch >> 3;
        gla_scan_item(p, 256 + sq * 32, 32, (ch >> 1) & 3, ch & 1, sub);
      }
    }
  }
  for (int i3 = blockIdx.x; i3 < NATT_P + NATT_S; i3 += gridDim.x) {
    int vh, qb, sq, nkeys;
    if (i3 < NATT_P) { vh = i3 & 7; qb = i3 >> 3; sq = 0; nkeys = TP; }
    else { int i4 = i3 - NATT_P; vh = i4 & 7; int rest = i4 >> 3; qb = rest & 7; sq = 1 + (rest >> 3); nkeys = SS; }
    const int ts = seq_start(sq);
    const int tq = ts + qb * 256;
    const bf16_t* Q = (const bf16_t*)(p.ws + OFF_DQ) + (long)tq * 512 + vh * 64;
    const bf16_t* K = (const bf16_t*)(p.ws + OFF_DK) + (long)ts * 512 + vh * 64;
    const bf16_t* Vt = (const bf16_t*)(p.ws + OFF_DVT) + (long)((vh >> 1) * 128) * T + ts;
    bf16_t* O = (bf16_t*)(p.ws + OFF_ODIFF) + (long)tq * 1024 + vh * 128;
    flash256_item<64>(Q, 512, K, 512, Vt, (long)T, nkeys, c, O, 1024, smem_block);
  }
}

DI void phase_g3_combine(const P& p, char* smem_block) {
  _Pragma("nounroll") for (int rp = 0; rp < REPG3; ++rp)
  for (int it = blockIdx.x; it < NCHUNK * 4; it += gridDim.x) gla_g3_block(p, it >> 2, it & 3, smem_block);
  const int lane = VT & 63;
  float lam;
  {
    float a = p.lq1[lane] * p.lk1[lane], b = p.lq2[lane] * p.lk2[lane];
    a = wave_sum(a); b = wave_sum(b);
    lam = expf(a) - expf(b) + 0.2f;
  }
  const float post = 1.f - 0.2f;
  const bf16_t* od = (const bf16_t*)(p.ws + OFF_ODIFF);
  bf16_t* mixin = (bf16_t*)(p.ws + OFF_MIXIN);
  const int hh = lane >> 4, c8 = (lane & 15) * 8;
  float sw[8];
#pragma unroll
  for (int j = 0; j < 8; ++j) sw[j] = p.subln_w[c8 + j] * post;
  _Pragma("nounroll") for (int rp = 0; rp < REPCMB; ++rp)
  for (int t = VB * 4 + (VT >> 6); t < T; t += VN * 4) {
    u4 a = *(const u4*)(od + (long)t * 1024 + (hh * 2) * 128 + c8);
    u4 b = *(const u4*)(od + (long)t * 1024 + (hh * 2 + 1) * 128 + c8);
    float v[8];
    v[0] = blo(a.x) - lam * blo(b.x); v[1] = bhi(a.x) - lam * bhi(b.x);
    v[2] = blo(a.y) - lam * blo(b.y); v[3] = bhi(a.y) - lam * bhi(b.y);
    v[4] = blo(a.z) - lam * blo(b.z); v[5] = bhi(a.z) - lam * bhi(b.z);
    v[6] = blo(a.w) - lam * blo(b.w); v[7] = bhi(a.w) - lam * bhi(b.w);
    float s = 0.f;
#pragma unroll
    for (int j = 0; j < 8; ++j) s += v[j] * v[j];
    s += __shfl_xor(s, 1); s += __shfl_xor(s, 2); s += __shfl_xor(s, 4); s += __shfl_xor(s, 8);
    float rs = rsqrtf(s * (1.f / 128.f) + EPS);
    u4 pk;
    pk.x = pk2(v[0] * rs * sw[0], v[1] * rs * sw[1]);
    pk.y = pk2(v[2] * rs * sw[2], v[3] * rs * sw[3]);
    pk.z = pk2(v[4] * rs * sw[4], v[5] * rs * sw[5]);
    pk.w = pk2(v[6] * rs * sw[6], v[7] * rs * sw[7]);
    *(u4*)(mixin + (long)t * 1024 + 512 + hh * 128 + c8) = pk;
  }
}

template <int WHICH>
DI void phase_rows(const P& p) {
  const int lane = VT & 63;
  const bf16_t* mix = (const bf16_t*)(p.ws + OFF_MIX);
  bf16_t* hb = (bf16_t*)(p.ws + OFF_HBUF);
  for (int tg = VB * 4 + (VT >> 6); tg < T / NR; tg += VN * 4) {
    const int t = tg * NR;
    char* xo = (char*)(p.out + (long)t * 1024);
    char* xres = xo + NR * 2048;
    const bf16_t* m = mix + (long)t * 1024;
    bf16_t* h = hb + (long)t * 1024;
    if (WHICH == 0) {
      const float* xin = t < TP ? p.xp + (long)t * 1024 : p.xs + (long)(t - TP) * 1024;
      row_resid_xn<true, false>((const char*)xin, 4096, m, p.norm_mix_post, p.norm_x_pre, xres, 2048, h, lane);
    } else if (WHICH == 1) {
      row_resid_xn<false, false>(xres, 2048, m, p.norm_x_post, p.norm_f_pre, xres, 2048, h, lane);
    } else {
      row_resid_xn<false, true>(xres, 2048, m, p.norm_f_post, nullptr, xo, 4096, nullptr, lane);
    }
  }
}

DI void phase_xq_xattn(const P& p, char* smem) {
  char* ws = p.ws;
  const bf16_t* A = (const bf16_t*)(ws + OFF_HBUF);
  const bf16_t* B = (const bf16_t*)(ws + OFF_WXQ);
  const float c = 0.0625f * LOG2E;
  for (int L = blockIdx.x; L < (T / 256) * 4; L += gridDim.x) {
    int tidx = threadIdx.x;
    asm volatile("" : "+v"(tidx));
    const int wid = __builtin_amdgcn_readfirstlane(tidx >> 6), lane = tidx & 63, wr = wid >> 2, wc = wid & 3;
    int fr = lane & 15, fq = lane >> 4;
    int pm, pn;
    g8_unit(L, T / 256, 4, pm, pn);
    const int m0 = pm * 256;
    bf16x8 qf[16];
    {
      f32x4 acc[2][2][4][2];
      g8_tile<true>(A, B, 1024, m0, pn * 256, (bf16_t*)smem, acc, tidx, false);
      asm volatile("" : "+v"(fr), "+v"(fq));
#pragma unroll
      for (int ai = 0; ai < 2; ++ai)
#pragma unroll
        for (int bj = 0; bj < 2; ++bj)
#pragma unroll
          for (int m = 0; m < 4; ++m)
#pragma unroll
            for (int n = 0; n < 2; ++n) {
              const int row = ai * 128 + wr * 64 + m * 16 + fr;
              f32x4 v = acc[ai][bj][m][n];
              u2 pk; pk.x = pk2(v[0], v[1]); pk.y = pk2(v[2], v[3]);
              const int chunk = bj * 16 + wc * 4 + n * 2 + (fq >> 1);
              *(u2*)(smem + row * 512 + ((chunk ^ (row & 31)) << 4) + (fq & 1) * 8) = pk;
            }
    }
    __syncthreads();
    {
      const int row = wid * 32 + (lane & 31), hh = lane >> 5;
#pragma unroll
      for (int ks = 0; ks < 16; ++ks) qf[ks] = *(const bf16x8*)(smem + row * 512 + (((2 * ks + hh) ^ (row & 31)) << 4));
    }
    __syncthreads();
    const int sq = seq_of_token(m0);
    const bf16_t* K = (const bf16_t*)(ws + OFF_KX) + (long)(sq * 256) * 1024 + pn * 256;
#pragma unroll
    for (int half = 0; half < 2; ++half) {
      const bf16_t* Vt = (const bf16_t*)(ws + OFF_VXT) + (long)(pn * 256 + half * 128) * MT + sq * 256;
      bf16_t* O = (bf16_t*)(ws + OFF_XOIN) + (long)m0 * 1024 + pn * 256 + half * 128;
      flash256x_core<256>(qf, K, 1024, Vt, (long)MT, 256, c, O, 1024, smem);
    }
  }
}

constexpr int NPH = 14;

#define XB_TMO      128
#define XB_XCNT(j)  (256  + 64 * (j))
#define XB_XSUB(j)  (1280 + 64 * (j))
#define XB_XGEN(j)  (2304 + 64 * (j))
#define XB_TOP      3328
#define XB_TOPGEN   3392
#define XCD_BAR_WORDS 3456
#define XB_SPIN_CAP (1u << 18)
#define LAS __attribute__((address_space(3)))

__device__ __forceinline__ unsigned xb_ld(unsigned* p)              { return __hip_atomic_load(p, __ATOMIC_RELAXED, __HIP_MEMORY_SCOPE_AGENT); }
__device__ __forceinline__ unsigned xb_add(unsigned* p, unsigned v) { return __hip_atomic_fetch_add(p, v, __ATOMIC_RELAXED, __HIP_MEMORY_SCOPE_AGENT); }
__device__ __forceinline__ unsigned xb_xcc_id() { return (unsigned)__builtin_amdgcn_s_getreg((3 << 11) | 20) & 0xFu; }
#define XB_SPIN(cond, bar) do { unsigned _sp = 0; while (cond) { __builtin_amdgcn_s_sleep(1); \
    if ((++_sp & 255u) == 0u) { if (xb_ld(&(bar)[XB_TMO])) break; if (_sp > XB_SPIN_CAP) { atomicAdd(&(bar)[XB_TMO], 1u); break; } } } } while (0)

struct XcdBarrier {
    unsigned* bar; unsigned x;
    volatile LAS unsigned* st;
};

__device__ __forceinline__ XcdBarrier xcd_barrier_post(unsigned* bar, volatile LAS unsigned* st) {
    XcdBarrier b; b.bar = bar; b.x = xb_xcc_id(); b.st = st;
    if (threadIdx.x == 0) (void)xb_add(&bar[XB_XCNT(b.x)], 1u);
    return b;
}
__device__ __forceinline__ void xcd_barrier_complete(unsigned* bar, unsigned x, unsigned& nloc, unsigned& nx) {
    const unsigned G = gridDim.x * gridDim.y * gridDim.z;
    unsigned sum, cnt, mine, sp = 0u;
    for (;;) {
        sum = 0u; cnt = 0u; mine = 0u;
#pragma unroll
        for (unsigned j = 0; j < 16; ++j) { const unsigned c = xb_ld(&bar[XB_XCNT(j)]); sum += c; cnt += (c > 0u) ? 1u : 0u; mine = (j == x) ? c : mine; }
        if (sum == G) break;
        __builtin_amdgcn_s_sleep(1);
        if ((++sp & 255u) == 0u) { if (xb_ld(&bar[XB_TMO])) break; if (sp > XB_SPIN_CAP) { atomicAdd(&bar[XB_TMO], 1u); break; } }
    }
    nloc = mine > 0u ? mine : 1u; nx = cnt > 0u ? cnt : 1u;
}

__device__ __forceinline__ void xcd_barrier(const XcdBarrier& b) {
    asm volatile("s_waitcnt vmcnt(0)" ::: "memory");
    __syncthreads();
    if (threadIdx.x == 0) {
        unsigned* bar = b.bar;
        __builtin_amdgcn_s_waitcnt(0);
        unsigned nloc = b.st[0], nx = b.st[1];
        if (nloc == 0u) { xcd_barrier_complete(bar, b.x, nloc, nx); b.st[0] = nloc; b.st[1] = nx; }
        const unsigned old = xb_add(&bar[XB_XSUB(b.x)], 1u);
        const unsigned gen = old / nloc;
        if (old + 1u == (gen + 1u) * nloc) {
            __builtin_amdgcn_fence(__ATOMIC_RELEASE, "agent");
            asm volatile("s_waitcnt vmcnt(0)" ::: "memory");
            const unsigned og = xb_add(&bar[XB_TOP], 1u);
            const unsigned tg = og / nx;
            if (og + 1u == (tg + 1u) * nx) xb_add(&bar[XB_TOPGEN], 1u);
            else XB_SPIN(xb_ld(&bar[XB_TOPGEN]) == tg, bar);
            __builtin_amdgcn_fence(__ATOMIC_ACQUIRE, "agent");
            xb_add(&bar[XB_XGEN(b.x)], 1u);
            asm volatile("s_waitcnt vmcnt(0)" ::: "memory");
        } else {
            XB_SPIN(xb_ld(&bar[XB_XGEN(b.x)]) == gen, bar);
            __builtin_amdgcn_fence(__ATOMIC_ACQUIRE, "agent");
            asm volatile("s_waitcnt vmcnt(0)" ::: "memory");
        }
    }
    __syncthreads();
}


DI unsigned long long uni64(unsigned long long v) {
  unsigned lo = __builtin_amdgcn_readfirstlane((unsigned)v), hi = __builtin_amdgcn_readfirstlane((unsigned)(v >> 32));
  return ((unsigned long long)hi << 32) | lo;
}
#define UNI_F(field) lp.field = (const float*)(const __attribute__((address_space(1))) float*)uni64((unsigned long long)lp.field);
DI void uniformize(P& lp) {
  UNI_F(xp) UNI_F(xs) UNI_F(memp) UNI_F(mems)
  UNI_F(norm_mix_pre) UNI_F(w_in) UNI_F(w_gu_f) UNI_F(b_g_f) UNI_F(w_gu_b) UNI_F(b_g_b) UNI_F(gla_norm_w)
  UNI_F(lq1) UNI_F(lk1) UNI_F(lq2) UNI_F(lk2) UNI_F(subln_w) UNI_F(w_out) UNI_F(norm_mix_post) UNI_F(norm_x_pre) UNI_F(norm_mem)
  UNI_F(w_xq) UNI_F(w_xkv) UNI_F(w_xo) UNI_F(norm_x_post) UNI_F(norm_f_pre) UNI_F(w_fg) UNI_F(w_fu) UNI_F(w_fd) UNI_F(norm_f_post)
  lp.out = (float*)(__attribute__((address_space(1))) float*)uni64((unsigned long long)lp.out);
  lp.ws = (char*)(__attribute__((address_space(1))) char*)uni64((unsigned long long)lp.ws);
}

template <int PH>
DI void run_phase(const P& p, char* smem, int rep) {
  char* ws = p.ws;
  if constexpr (PH == 0) phase_prep(p, smem + (threadIdx.x >> 8) * 65536);
  else if constexpr (PH == 2) phase_rope_g1(p, smem + (threadIdx.x >> 8) * 65536);
  else if constexpr (PH == 3) phase_attn_scan(p, smem, rep);
  else if constexpr (PH == 4) phase_g3_combine(p, smem);
  else if constexpr (PH == 6) phase_rows<0>(p);
  else if constexpr (PH == 8) {   }
  else if constexpr (PH == 10) phase_rows<1>(p);
  else if constexpr (PH == 13) phase_rows<2>(p);
  else if constexpr (PH == 1) {
    const Job j0{(const bf16_t*)(ws + OFF_HBUF), (const bf16_t*)(ws + OFF_WIN), nullptr, 1024, T / 256, NIN / 256, 0};
    const Job j1{(const bf16_t*)(ws + OFF_MBUF), (const bf16_t*)(ws + OFF_WXKV), nullptr, 1024, MT / 256, 8, 1};
    const int n0 = j0.mtiles * j0.ntiles, n1 = j1.mtiles * j1.ntiles;
    const int G = gridDim.x;
    bool pre = false;
    for (int L = blockIdx.x; L < n0 + n1; L += G) {
      const bool first = L < n0;
      Job jb;
      jb.A = first ? j0.A : j1.A; jb.B = first ? j0.B : j1.B; jb.dst = nullptr; jb.K = 1024;
      jb.mtiles = first ? j0.mtiles : j1.mtiles; jb.ntiles = first ? j0.ntiles : j1.ntiles; jb.mode = first ? 0 : 1;
      const int L2 = L + G;
      const bool hn = L2 < n0 + n1;
      const bool first2 = L2 < n0;
      Job jn;
      jn.A = first2 ? j0.A : j1.A; jn.B = first2 ? j0.B : j1.B; jn.dst = nullptr; jn.K = 1024;
      jn.mtiles = first2 ? j0.mtiles : j1.mtiles; jn.ntiles = first2 ? j0.ntiles : j1.ntiles; jn.mode = first2 ? 0 : 1;
      run_gemm_unit(p, jb, first ? L : L - n0, smem, pre, hn, jn, first2 ? L2 : L2 - n0);
      pre = hn;
    }
  }
  else if constexpr (PH == 5) run_gemm_job(p, Job{(const bf16_t*)(ws + OFF_MIXIN), (const bf16_t*)(ws + OFF_WOUT), (bf16_t*)(ws + OFF_MIX), 1024, T / 256, 4, 2}, smem);
  else if constexpr (PH == 7) phase_xq_xattn(p, smem);
  else if constexpr (PH == 9) run_gemm_job(p, Job{(const bf16_t*)(ws + OFF_XOIN), (const bf16_t*)(ws + OFF_WXO), (bf16_t*)(ws + OFF_MIX), 1024, T / 256, 4, 2}, smem);
  else if constexpr (PH == 11) run_gemm_job(p, Job{(const bf16_t*)(ws + OFF_HBUF), (const bf16_t*)(ws + OFF_WGU), (bf16_t*)(ws + OFF_ACT), 1024, T / 256, 22, 3}, smem);
  else if constexpr (PH == 12) run_gemm_job(p, Job{(const bf16_t*)(ws + OFF_ACT), (const bf16_t*)(ws + OFF_WDN), (bf16_t*)(ws + OFF_MIX), DFF, T / 256, 4, 2}, smem);
}

constexpr int LDS_BYTES = 131072;
__global__ void __launch_bounds__(512, 2) mega(P p, int ph_lo, int ph_hi) {
  extern __shared__ __attribute__((aligned(16))) char smem[];
  __shared__ u4 xb_words;
  if (threadIdx.x == 0) xb_words = u4{0u, 0u, 0u, 0u};
  __syncthreads();
  XcdBarrier xb = xcd_barrier_post((unsigned*)(p.ws + OFF_BAR), (volatile LAS unsigned*)&xb_words);
  if (ph_lo < 0) cg::this_grid().sync();
#define PHASE(n)                                          \
  if (PHSEL < 0 || PHSEL == n) {                          \
    if (ph_lo <= n && n < ph_hi) {                        \
      if (n > ph_lo) xcd_barrier(xb);                     \
      if (n == 1) { _Pragma("nounroll") for (int xs = 0; xs < XSYNC; ++xs) xcd_barrier(xb); } \
      const __attribute__((address_space(4))) char* kp = (const __attribute__((address_space(4))) char*)__builtin_amdgcn_kernarg_segment_ptr(); \
      asm volatile("" : "+s"(kp));                        \
      P lp;                                               \
      __builtin_memcpy(&lp, kp, sizeof(P));               \
      uniformize(lp);                                     \
      _Pragma("nounroll") for (int rep = 0; rep < (((REPMASK >> n) & 1) ? 2 : 1); ++rep) run_phase<n>(lp, smem, rep); \
    }                                                     \
  }
  PHASE(0) PHASE(1) PHASE(2) PHASE(3) PHASE(4) PHASE(5) PHASE(6) PHASE(7) PHASE(9) PHASE(10) PHASE(11) PHASE(12) PHASE(13)
}

extern "C" void kernel_launch(void* const* d_in, const int* in_sizes, int n_in, void* d_out, int out_size, void* d_ws,
                              size_t ws_size, hipStream_t stream) {
  static int grid_blocks = 0;
  if (!grid_blocks) {
    int dev = 0, cus = 0, per_cu = 0;
    hipGetDevice(&dev);
    hipDeviceGetAttribute(&cus, hipDeviceAttributeMultiprocessorCount, dev);
    hipFuncSetAttribute((const void*)mega, hipFuncAttributeMaxDynamicSharedMemorySize, LDS_BYTES);
    hipOccupancyMaxActiveBlocksPerMultiprocessor(&per_cu, mega, 512, LDS_BYTES);
    if (per_cu < 1) per_cu = 1;
    grid_blocks = cus * per_cu;
  }
  P p{};
  const float** f = (const float**)&p;
  for (int i = 0; i < 29; ++i) f[i] = (const float*)d_in[i];
  p.out = (float*)d_out;
  p.ws = (char*)d_ws;
#if MEGA
  hipMemsetAsync((char*)d_ws + OFF_BAR, 0, 16384, stream);
  int lo = 0, hi = NPH;
  void* args[] = {&p, &lo, &hi};
  hipError_t e = hipLaunchCooperativeKernel((void*)mega, dim3(grid_blocks), dim3(512), args, LDS_BYTES, stream);
  if (e != hipSuccess) fprintf(stderr, "cooperative launch failed: %s (grid %d)\n", hipGetErrorString(e), grid_blocks);
#else
  for (int ph = 0; ph < NPH; ++ph) hipLaunchKernelGGL(mega, dim3(grid_blocks), dim3(512), LDS_BYTES, stream, p, ph, ph + 1);
#endif
}
```

```cpp
#include <hip/hip_runtime.h>
#include <hip/hip_cooperative_groups.h>
#include <stdint.h>
#include <cstdio>
namespace cg = cooperative_groups;

#ifndef MEGA
#define MEGA 1
#endif
#ifndef PHSEL
#define PHSEL -1
#endif
#ifndef REPMASK
#define REPMASK 0
#endif
#ifndef REPG3
#define REPG3 1
#endif
#ifndef REPG1
#define REPG1 1
#endif
#ifndef XSYNC
#define XSYNC 0
#endif
#ifndef REPCMB
#define REPCMB 1
#endif

typedef unsigned short bf16_t;
using bf16x8 = __attribute__((ext_vector_type(8))) short;
using bf16x4 = __attribute__((ext_vector_type(4))) short;
using f32x4 = __attribute__((ext_vector_type(4))) float;
using u4 = __attribute__((ext_vector_type(4))) unsigned;
using u2 = __attribute__((ext_vector_type(2))) unsigned;
using f4 = __attribute__((ext_vector_type(4))) float;
using f32x16 = __attribute__((ext_vector_type(16))) float;
typedef __attribute__((ext_vector_type(2))) __bf16 bf2_t;
#define DI __device__ __forceinline__
#define VT ((int)(threadIdx.x & 255))
#define VB ((int)(blockIdx.x * 2 + (threadIdx.x >> 8)))
#define VN ((int)(gridDim.x * 2))

DI unsigned pk2(float a, float b) { bf2_t v; v[0] = (__bf16)a; v[1] = (__bf16)b; return __builtin_bit_cast(unsigned, v); }
DI bf16_t f2b(float a) { return __builtin_bit_cast(unsigned short, (__bf16)a); }
DI float b2f(unsigned b) { return __uint_as_float(b << 16); }
DI float blo(unsigned u) { return __uint_as_float(u << 16); }
DI float bhi(unsigned u) { return __uint_as_float(u & 0xffff0000u); }
DI float half_swap_max(float x) {
  auto rr = __builtin_amdgcn_permlane32_swap(__float_as_uint(x), __float_as_uint(x), false, false);
  return fmaxf(__uint_as_float(rr[0]), __uint_as_float(rr[1]));
}
DI float half_swap_sum(float x) {
  auto rr = __builtin_amdgcn_permlane32_swap(__float_as_uint(x), __float_as_uint(x), false, false);
  return __uint_as_float(rr[0]) + __uint_as_float(rr[1]);
}
DI float wave_sum(float v) {
#pragma unroll
  for (int o = 32; o > 0; o >>= 1) v += __shfl_xor(v, o);
  return v;
}

constexpr int T = 81920, TP = 16384, SS = 2048, D = 1024, MT = 8448, DFF = 2816;
constexpr int NCHUNK = T / 64;
constexpr int NIN = 3328;
constexpr float EPS = 1e-6f;
constexpr float LOG2E = 1.4426950408889634f;

constexpr size_t OFF_WIN = 0;
constexpr size_t OFF_WOUT = OFF_WIN + (size_t)NIN * 1024 * 2;
constexpr size_t OFF_WXQ = OFF_WOUT + 1024 * 1024 * 2;
constexpr size_t OFF_WXO = OFF_WXQ + 1024 * 1024 * 2;
constexpr size_t OFF_WXKV = OFF_WXO + 1024 * 1024 * 2;
constexpr size_t OFF_WGU = OFF_WXKV + 2048 * 1024 * 2;
constexpr size_t OFF_WDN = OFF_WGU + (size_t)5632 * 1024 * 2;
constexpr size_t OFF_HBUF = OFF_WDN + (size_t)1024 * 2816 * 2;
constexpr size_t OFF_GQ = OFF_HBUF + (size_t)T * 1024 * 2;
constexpr size_t OFF_GK = OFF_GQ + (size_t)T * 256 * 2;
constexpr size_t OFF_GV = OFF_GK + (size_t)T * 256 * 2;
constexpr size_t OFF_OG = OFF_GV + (size_t)T * 512 * 2;
constexpr size_t OFF_DQ = OFF_OG + (size_t)T * 512 * 2;
constexpr size_t OFF_DK = OFF_DQ + (size_t)T * 512 * 2;
constexpr size_t OFF_DVT = OFF_DK + (size_t)T * 512 * 2;
constexpr size_t OFF_GATES = OFF_DVT + (size_t)T * 512 * 2;
constexpr size_t OFF_UBUF = OFF_GATES + (size_t)T * 32 * 4;
constexpr size_t OFF_DEC = OFF_UBUF + (size_t)NCHUNK * 4 * 2 * 8192 * 2;
constexpr size_t OFF_MBUF = OFF_DEC + (size_t)NCHUNK * 4 * 2 * 64 * 4;
constexpr size_t OFF_KX = OFF_MBUF + (size_t)MT * 1024 * 2;
constexpr size_t OFF_VXT = OFF_KX + (size_t)MT * 1024 * 2;
constexpr size_t OFF_BAR = OFF_VXT + (size_t)MT * 1024 * 2;
constexpr size_t WS_END = OFF_BAR + 16384;
constexpr size_t OUT_QEF = 0;
constexpr size_t OUT_KEF = OUT_QEF + (size_t)T * 256 * 2;
constexpr size_t OUT_QEB = OUT_KEF + (size_t)T * 256 * 2;
constexpr size_t OUT_KEB = OUT_QEB + (size_t)T * 256 * 2;
constexpr size_t OFF_ODIFF = OFF_HBUF;
constexpr size_t OFF_MIXIN = OFF_DQ;
constexpr size_t OFF_MIX = OFF_UBUF;
constexpr size_t OFF_QX = OFF_MIXIN;
constexpr size_t OFF_XOIN = OFF_GQ;
constexpr size_t OFF_ACT = OFF_GQ;

struct P {
  const float *xp, *xs, *memp, *mems;
  const float *norm_mix_pre, *w_in, *w_gu_f, *b_g_f, *w_gu_b, *b_g_b, *gla_norm_w;
  const float *lq1, *lk1, *lq2, *lk2, *subln_w, *w_out, *norm_mix_post, *norm_x_pre, *norm_mem;
  const float *w_xq, *w_xkv, *w_xo, *norm_x_post, *norm_f_pre, *w_fg, *w_fu, *w_fd, *norm_f_post;
  float* out;
  char* ws;
};

DI int seq_start(int s) { return s == 0 ? 0 : TP + (s - 1) * SS; }
DI int seq_of_token(int t) { return t < TP ? 0 : 1 + (t - TP) / SS; }

DI void row_norm_bf16(const float* __restrict__ x, const float* __restrict__ w, bf16_t* __restrict__ out, int lane) {
  f4 v[4];
  float ss = 0.f;
#pragma unroll
  for (int i = 0; i < 4; ++i) {
    v[i] = ((const f4*)x)[i * 64 + lane];
    ss += v[i].x * v[i].x + v[i].y * v[i].y + v[i].z * v[i].z + v[i].w * v[i].w;
  }
  ss = wave_sum(ss);
  float rs = rsqrtf(ss * (1.f / 1024.f) + EPS);
#pragma unroll
  for (int i = 0; i < 4; ++i) {
    f4 ww = ((const f4*)w)[i * 64 + lane];
    u2 pk;
    pk.x = pk2(v[i].x * rs * ww.x, v[i].y * rs * ww.y);
    pk.y = pk2(v[i].z * rs * ww.z, v[i].w * rs * ww.w);
    ((u2*)out)[i * 64 + lane] = pk;
  }
}

template <bool XIN_F32, bool LAST>
DI void row_resid(const void* xin, const bf16_t* __restrict__ mix, const float* __restrict__ wpost,
                  const float* __restrict__ wnext, void* xout, bf16_t* __restrict__ hout, int lane) {
  f4 x[4], m[4];
  float ss = 0.f;
#pragma unroll
  for (int i = 0; i < 4; ++i) {
    if (XIN_F32) x[i] = ((const f4*)xin)[i * 64 + lane];
    else { u2 xu = ((const u2*)xin)[i * 64 + lane]; x[i].x = blo(xu.x); x[i].y = bhi(xu.x); x[i].z = blo(xu.y); x[i].w = bhi(xu.y); }
    u2 u = ((const u2*)mix)[i * 64 + lane];
    m[i].x = blo(u.x); m[i].y = bhi(u.x); m[i].z = blo(u.y); m[i].w = bhi(u.y);
    ss += m[i].x * m[i].x + m[i].y * m[i].y + m[i].z * m[i].z + m[i].w * m[i].w;
  }
  ss = wave_sum(ss);
  float rs = rsqrtf(ss * (1.f / 1024.f) + EPS);
  float ss1 = 0.f;
#pragma unroll
  for (int i = 0; i < 4; ++i) {
    f4 ww = ((const f4*)wpost)[i * 64 + lane];
    x[i].x += m[i].x * rs * ww.x; x[i].y += m[i].y * rs * ww.y;
    x[i].z += m[i].z * rs * ww.z; x[i].w += m[i].w * rs * ww.w;
    ss1 += x[i].x * x[i].x + x[i].y * x[i].y + x[i].z * x[i].z + x[i].w * x[i].w;
  }
  if (LAST) {
#pragma unroll
    for (int i = 0; i < 4; ++i) ((f4*)xout)[i * 64 + lane] = x[i];
  } else {
#pragma unroll
    for (int i = 0; i < 4; ++i) {
      u2 pk; pk.x = pk2(x[i].x, x[i].y); pk.y = pk2(x[i].z, x[i].w);
      ((u2*)xout)[i * 64 + lane] = pk;
    }
    ss1 = wave_sum(ss1);
    float rs1 = rsqrtf(ss1 * (1.f / 1024.f) + EPS);
#pragma unroll
    for (int i = 0; i < 4; ++i) {
      f4 ww = ((const f4*)wnext)[i * 64 + lane];
      u2 pk;
      pk.x = pk2(x[i].x * rs1 * ww.x, x[i].y * rs1 * ww.y);
      pk.y = pk2(x[i].z * rs1 * ww.z, x[i].w * rs1 * ww.w);
      ((u2*)hout)[i * 64 + lane] = pk;
    }
  }
}

constexpr int NR = 4;
DI void row_norm_bf16_xn(const float* __restrict__ x, const float* __restrict__ w, bf16_t* __restrict__ out, int lane) {
  f4 v[NR][4];
#pragma unroll
  for (int q = 0; q < NR; ++q)
#pragma unroll
    for (int i = 0; i < 4; ++i) v[q][i] = ((const f4*)(x + q * 1024))[i * 64 + lane];
  __builtin_amdgcn_sched_barrier(0);
#pragma unroll
  for (int q = 0; q < NR; ++q) {
    float ss = 0.f;
#pragma unroll
    for (int i = 0; i < 4; ++i) ss += v[q][i].x * v[q][i].x + v[q][i].y * v[q][i].y + v[q][i].z * v[q][i].z + v[q][i].w * v[q][i].w;
    ss = wave_sum(ss);
    float rs = rsqrtf(ss * (1.f / 1024.f) + EPS);
#pragma unroll
    for (int i = 0; i < 4; ++i) {
      f4 ww = ((const f4*)w)[i * 64 + lane];
      u2 pk;
      pk.x = pk2(v[q][i].x * rs * ww.x, v[q][i].y * rs * ww.y);
      pk.y = pk2(v[q][i].z * rs * ww.z, v[q][i].w * rs * ww.w);
      ((u2*)(out + q * 1024))[i * 64 + lane] = pk;
    }
  }
}

template <bool XIN_F32, bool LAST>
DI void row_resid_xn(const char* xin, int xin_stride, const bf16_t* __restrict__ mix, const float* __restrict__ wpost,
                     const float* __restrict__ wnext, char* xout, int xout_stride, bf16_t* __restrict__ hout, int lane) {
  f4 x[NR][4]; u2 mu[NR][4];
#pragma unroll
  for (int q = 0; q < NR; ++q) {
#pragma unroll
    for (int i = 0; i < 4; ++i) {
      if (XIN_F32) x[q][i] = ((const f4*)(xin + (long)q * xin_stride))[i * 64 + lane];
      else { u2 xu = ((const u2*)(xin + (long)q * xin_stride))[i * 64 + lane]; x[q][i].x = blo(xu.x); x[q][i].y = bhi(xu.x); x[q][i].z = blo(xu.y); x[q][i].w = bhi(xu.y); }
      mu[q][i] = ((const u2*)(mix + q * 1024))[i * 64 + lane];
    }
  }
  __builtin_amdgcn_sched_barrier(0);
#pragma unroll
  for (int q = 0; q < NR; ++q) {
    f4 m[4];
    float ss = 0.f;
#pragma unroll
    for (int i = 0; i < 4; ++i) {
      m[i].x = blo(mu[q][i].x); m[i].y = bhi(mu[q][i].x); m[i].z = blo(mu[q][i].y); m[i].w = bhi(mu[q][i].y);
      ss += m[i].x * m[i].x + m[i].y * m[i].y + m[i].z * m[i].z + m[i].w * m[i].w;
    }
    ss = wave_sum(ss);
    float rs = rsqrtf(ss * (1.f / 1024.f) + EPS);
    float ss1 = 0.f;
#pragma unroll
    for (int i = 0; i < 4; ++i) {
      f4 ww = ((const f4*)wpost)[i * 64 + lane];
      x[q][i].x += m[i].x * rs * ww.x; x[q][i].y += m[i].y * rs * ww.y;
      x[q][i].z += m[i].z * rs * ww.z; x[q][i].w += m[i].w * rs * ww.w;
      ss1 += x[q][i].x * x[q][i].x + x[q][i].y * x[q][i].y + x[q][i].z * x[q][i].z + x[q][i].w * x[q][i].w;
    }
    if (LAST) {
#pragma unroll
      for (int i = 0; i < 4; ++i) ((f4*)(xout + (long)q * xout_stride))[i * 64 + lane] = x[q][i];
    } else {
#pragma unroll
      for (int i = 0; i < 4; ++i) {
        u2 pk; pk.x = pk2(x[q][i].x, x[q][i].y); pk.y = pk2(x[q][i].z, x[q][i].w);
        ((u2*)(xout + (long)q * xout_stride))[i * 64 + lane] = pk;
      }
      ss1 = wave_sum(ss1);
      float rs1 = rsqrtf(ss1 * (1.f / 1024.f) + EPS);
#pragma unroll
      for (int i = 0; i < 4; ++i) {
        f4 ww = ((const f4*)wnext)[i * 64 + lane];
        u2 pk;
        pk.x = pk2(x[q][i].x * rs1 * ww.x, x[q][i].y * rs1 * ww.y);
        pk.y = pk2(x[q][i].z * rs1 * ww.z, x[q][i].w * rs1 * ww.w);
        ((u2*)(hout + q * 1024))[i * 64 + lane] = pk;
      }
    }
  }
}

template <class F>
DI void wt_conv(bf16_t* __restrict__ dst, int K, int N, int tile0, int& tile_base, char* smem, F src4) {
  float* tl = (float*)smem;
  const int tid = VT;
  const int ntn = N >> 6, ntk = K >> 6, nt = ntn * ntk;
  int first = (tile0 & ~1) - tile_base;
  const int stride = VN;
  if (first < 0) first += ((-first + stride - 1) / stride) * stride;
  for (int te = first; te < nt; te += stride) {
    const int t = te + (tile0 & 1);
    const bool live = t < nt;
    const int tn = live ? t % ntn : 0, tk = live ? t / ntn : 0;
    const int n0 = tn * 64, k0 = tk * 64;
    __syncthreads();
    if (live) {
      const int kk = tid >> 4, n4 = (tid & 15) * 4;
#pragma unroll
      for (int it = 0; it < 4; ++it) {
        const int k = kk + 16 * it;
        const float* sp = src4(k0 + k, n0 + n4);
        f4 v = sp ? *(const f4*)sp : f4{0.f, 0.f, 0.f, 0.f};
        tl[k * 65 + n4 + 0] = v.x; tl[k * 65 + n4 + 1] = v.y; tl[k * 65 + n4 + 2] = v.z; tl[k * 65 + n4 + 3] = v.w;
      }
    }
    __syncthreads();
    if (live) {
      const int n = tid >> 2, kq = (tid & 3) * 16;
      unsigned pk[8];
#pragma unroll
      for (int j = 0; j < 8; ++j) pk[j] = pk2(tl[(kq + 2 * j) * 65 + n], tl[(kq + 2 * j + 1) * 65 + n]);
      bf16_t* d = dst + (long)(n0 + n) * K + k0 + kq;
      *(u4*)d = u4{pk[0], pk[1], pk[2], pk[3]};
      *(u4*)(d + 8) = u4{pk[4], pk[5], pk[6], pk[7]};
    }
  }
  tile_base += nt;
}

DI void phase_prep(const P& p, char* smem) {
  char* ws = p.ws;
  int tb = 0;
  const int vb = VB;
  {
    const float* w = p.w_in;
    wt_conv((bf16_t*)(ws + OFF_WIN), 1024, NIN, vb, tb, smem, [=](int k, int n) -> const float* {
      int sc = n < 1024 ? n : (n < 3072 ? n + 32 : (n < 3104 ? n - 3072 + 1024 : -1));
      return sc < 0 ? nullptr : w + (long)k * 3104 + sc;
    });
  }
  { const float* w = p.w_out; wt_conv((bf16_t*)(ws + OFF_WOUT), 1024, 1024, vb, tb, smem, [=](int k, int n) -> const float* { return w + (long)k * 1024 + n; }); }
  { const float* w = p.w_xq;  wt_conv((bf16_t*)(ws + OFF_WXQ), 1024, 1024, vb, tb, smem, [=](int k, int n) -> const float* { return w + (long)k * 1024 + n; }); }
  { const float* w = p.w_xo;  wt_conv((bf16_t*)(ws + OFF_WXO), 1024, 1024, vb, tb, smem, [=](int k, int n) -> const float* { return w + (long)k * 1024 + n; }); }
  { const float* w = p.w_xkv; wt_conv((bf16_t*)(ws + OFF_WXKV), 1024, 2048, vb, tb, smem, [=](int k, int n) -> const float* { return w + (long)k * 2048 + n; }); }
  {
    const float* wg = p.w_fg; const float* wu = p.w_fu;
    wt_conv((bf16_t*)(ws + OFF_WGU), 1024, 5632, vb, tb, smem, [=](int k, int n) -> const float* {
      int pr = n >> 5, which = (n >> 4) & 1, j = n & 15;
      int sc = pr * 16 + j;
      return (which ? wu : wg) + (long)k * DFF + sc;
    });
  }
  { const float* w = p.w_fd; wt_conv((bf16_t*)(ws + OFF_WDN), DFF, 1024, vb, tb, smem, [=](int k, int n) -> const float* { return w + (long)k * 1024 + n; }); }
  const long gtid = (long)VB * 256 + VT;
  (void)gtid;
  const int lane = VT & 63;
  const int gw = VB * 4 + (VT >> 6);
  const int nw = VN * 4;
  for (int rg = gw; rg < MT / NR; rg += nw) {
    const int r = rg * NR;
    const float* src = r < 256 ? p.memp + (long)r * 1024 : p.mems + (long)(r - 256) * 1024;
    row_norm_bf16_xn(src, p.norm_mem, (bf16_t*)(ws + OFF_MBUF) + (long)r * 1024, lane);
  }
  for (int rg = gw; rg < T / NR; rg += nw) {
    const int r = rg * NR;
    const float* src = r < TP ? p.xp + (long)r * 1024 : p.xs + (long)(r - TP) * 1024;
    row_norm_bf16_xn(src, p.norm_mix_pre, (bf16_t*)(ws + OFF_HBUF) + (long)r * 1024, lane);
  }
}

constexpr int GROW = 144;
constexpr int G8_BM = 256, G8_BK = 64, G8_HALF = 128, G8_HT = G8_HALF * G8_BK;

DI int g8_lds_byte(int r, int c) {
  int st = (r >> 4) * 2 + (c >> 5), rr = r & 15, cc = c & 31, ob = rr * 64 + cc * 2;
  return st * 1024 + (ob ^ (((ob >> 9) & 1) << 5));
}
DI void g8_stage_rc(int b, int& R, int& C) {
  int st = b / 1024, sb = b % 1024, swz = sb ^ (((sb >> 9) & 1) << 5);
  R = (st >> 1) * 16 + swz / 64; C = (st & 1) * 32 + (swz % 64) / 2;
}

template <bool SWAP>
DI void g8_tile(const bf16_t* __restrict__ Ag, const bf16_t* __restrict__ Bg, int K, int brow, int bcol, bf16_t* shm,
                f32x4 (&acc)[2][2][4][2], const int tidx, const bool prestaged, const bool halfn = false) {
#define SA(b, h) (shm + ((b) * 2 + (h)) * G8_HT)
#define SB(b, h) (shm + (4 + (b) * 2 + (h)) * G8_HT)
#define STAGE(Pp, BASE, br, kt) do { const char* _gb = (const char*)(BASE + (long)(br) * K + (long)(kt) * G8_BK); \
    __builtin_amdgcn_global_load_lds((const unsigned*)(_gb + voff0), \
        (__attribute__((address_space(3))) unsigned*)((char*)(Pp) + tidx * 16), 16, 0, 0); \
    __builtin_amdgcn_global_load_lds((const unsigned*)(_gb + (long)K * 128 + voff0), \
        (__attribute__((address_space(3))) unsigned*)((char*)(Pp) + tidx * 16 + 8192), 16, 0, 0); } while (0)
#define LDA(dst, b, h) for (int m = 0; m < 4; ++m) for (int k = 0; k < 2; ++k) \
    dst[m][k] = *reinterpret_cast<const bf16x8*>((char*)SA(b, h) + g8_lds_byte(wr * 64 + m * 16 + fr, k * 32 + fq * 8))
#define LDB(dst, b, h) for (int n = 0; n < 2; ++n) for (int k = 0; k < 2; ++k) \
    dst[n][k] = *reinterpret_cast<const bf16x8*>((char*)SB(b, h) + g8_lds_byte(wc * 32 + n * 16 + fr, k * 32 + fq * 8))
#define MMA(ai, bj, Af, Bf) do { __builtin_amdgcn_s_setprio(1); \
    for (int m = 0; m < 4; ++m) for (int n = 0; n < 2; ++n) for (int k = 0; k < 2; ++k) \
      acc[ai][bj][m][n] = SWAP ? __builtin_amdgcn_mfma_f32_16x16x32_bf16(Bf[n][k], Af[m][k], acc[ai][bj][m][n], 0, 0, 0) \
                               : __builtin_amdgcn_mfma_f32_16x16x32_bf16(Af[m][k], Bf[n][k], acc[ai][bj][m][n], 0, 0, 0); \
    __builtin_amdgcn_s_setprio(0); } while (0)
#define WAIT_V(n) asm volatile("s_waitcnt vmcnt(" #n ")" ::: "memory")
#define WAIT_L(n) asm volatile("s_waitcnt lgkmcnt(" #n ")" ::: "memory")
#define BAR __builtin_amdgcn_s_barrier()
#define SCHED __builtin_amdgcn_sched_barrier(0)
  const int wid = __builtin_amdgcn_readfirstlane(tidx >> 6), lane = tidx & 63, wr = wid >> 2, wc = wid & 3, fr = lane & 15, fq = lane >> 4;
#pragma unroll
  for (int a = 0; a < 2; ++a)
#pragma unroll
    for (int b = 0; b < 2; ++b)
#pragma unroll
      for (int m = 0; m < 4; ++m)
#pragma unroll
        for (int n = 0; n < 2; ++n) acc[a][b][m][n] = f32x4{0.f, 0.f, 0.f, 0.f};
  bf16x8 At[4][2], B0[2][2], B1[2][2];
  const int nt = K / G8_BK;
  unsigned voff0;
  { int _r, _c; g8_stage_rc(tidx * 16, _r, _c); voff0 = (unsigned)(_r * K + _c) * 2u; }
  if (!prestaged) {
    STAGE(SB(0, 0), Bg, bcol, 0); STAGE(SA(0, 0), Ag, brow, 0);
    STAGE(SB(0, 1), Bg, bcol + G8_HALF, 0); STAGE(SA(0, 1), Ag, brow + G8_HALF, 0);
    if (wr == 1) BAR;
    WAIT_V(4); BAR;
  } else {
    if (wr == 1) BAR;
    WAIT_V(0); BAR;
  }
  STAGE(SB(1, 0), Bg, bcol, 1); STAGE(SA(1, 0), Ag, brow, 1); STAGE(SB(1, 1), Bg, bcol + G8_HALF, 1);
  WAIT_V(6); BAR;
  for (int t = 0; t < nt - 2; t += 2) {
    LDB(B0, 0, 0); SCHED; LDA(At, 0, 0); STAGE(SA(1, 1), Ag, brow + G8_HALF, t + 1);
    WAIT_L(8); BAR; WAIT_L(0); MMA(0, 0, At, B0); BAR; SCHED;
    LDB(B1, 0, 1); STAGE(SB(0, 0), Bg, bcol, t + 2);
    BAR; WAIT_L(0); if (!halfn) MMA(0, 1, At, B1); BAR;
    LDA(At, 0, 1); STAGE(SA(0, 0), Ag, brow, t + 2);
    BAR; WAIT_L(0); MMA(1, 0, At, B0); BAR; SCHED;
    STAGE(SB(0, 1), Bg, bcol + G8_HALF, t + 2);
    WAIT_V(6); BAR; if (!halfn) MMA(1, 1, At, B1); BAR;
    LDB(B0, 1, 0); SCHED; LDA(At, 1, 0); STAGE(SA(0, 1), Ag, brow + G8_HALF, t + 2);
    WAIT_L(8); BAR; WAIT_L(0); MMA(0, 0, At, B0); BAR; SCHED;
    LDB(B1, 1, 1); STAGE(SB(1, 0), Bg, bcol, t + 3);
    BAR; WAIT_L(0); if (!halfn) MMA(0, 1, At, B1); BAR;
    LDA(At, 1, 1); STAGE(SA(1, 0), Ag, brow, t + 3);
    BAR; WAIT_L(0); MMA(1, 0, At, B0); BAR; SCHED;
    STAGE(SB(1, 1), Bg, bcol + G8_HALF, t + 3);
    WAIT_V(6); BAR; if (!halfn) MMA(1, 1, At, B1); BAR;
  }
  { LDB(B0, 0, 0); LDA(At, 0, 0); STAGE(SA(1, 1), Ag, brow + G8_HALF, nt - 1);
    BAR; WAIT_L(0); MMA(0, 0, At, B0); BAR;
    LDB(B1, 0, 1); BAR; WAIT_L(0); if (!halfn) MMA(0, 1, At, B1); BAR;
    LDA(At, 0, 1); WAIT_V(4); BAR; WAIT_L(0); MMA(1, 0, At, B0); if (!halfn) MMA(1, 1, At, B1); BAR; }
  { LDB(B0, 1, 0); LDA(At, 1, 0); WAIT_V(2); BAR; WAIT_L(0); MMA(0, 0, At, B0); BAR;
    LDB(B1, 1, 1); WAIT_V(0); BAR; WAIT_L(0); if (!halfn) MMA(0, 1, At, B1); BAR;
    LDA(At, 1, 1); BAR; WAIT_L(0); MMA(1, 0, At, B0); if (!halfn) MMA(1, 1, At, B1); BAR; }
  if (wr == 0) BAR;
#undef SA
#undef SB
#undef STAGE
#undef LDA
#undef LDB
#undef MMA
}

DI void g8_stage0(const bf16_t* __restrict__ Ag, const bf16_t* __restrict__ Bg, int K, int brow, int bcol, bf16_t* shm, const int tidx) {
  unsigned voff0;
  { int _r, _c; g8_stage_rc(tidx * 16, _r, _c); voff0 = (unsigned)(_r * K + _c) * 2u; }
#define SA(b, h) (shm + ((b) * 2 + (h)) * G8_HT)
#define SB(b, h) (shm + (4 + (b) * 2 + (h)) * G8_HT)
#define STAGE(Pp, BASE, br, kt) do { const char* _gb = (const char*)(BASE + (long)(br) * K + (long)(kt) * G8_BK); \
    __builtin_amdgcn_global_load_lds((const unsigned*)(_gb + voff0), \
        (__attribute__((address_space(3))) unsigned*)((char*)(Pp) + tidx * 16), 16, 0, 0); \
    __builtin_amdgcn_global_load_lds((const unsigned*)(_gb + (long)K * 128 + voff0), \
        (__attribute__((address_space(3))) unsigned*)((char*)(Pp) + tidx * 16 + 8192), 16, 0, 0); } while (0)
  STAGE(SB(0, 0), Bg, bcol, 0); STAGE(SA(0, 0), Ag, brow, 0);
  STAGE(SB(0, 1), Bg, bcol + G8_HALF, 0); STAGE(SA(0, 1), Ag, brow + G8_HALF, 0);
#undef SA
#undef SB
#undef STAGE
}

struct Job {
  const bf16_t* A; const bf16_t* B; bf16_t* dst;
  int K, mtiles, ntiles, mode;
  int nofs;
};

DI void g8_unit(int L, int nM, int nN, int& pm, int& pn) {
  const int nwg = nM * nN;
  int wgid = L;
  { const int q = nwg / 8, r = nwg % 8, xcd = wgid % 8, off = wgid / 8; wgid = (xcd < r ? xcd * (q + 1) : r * (q + 1) + (xcd - r) * q) + off; }
  const int nig = 8 * nN, gid = wgid / nig, fm = gid * 8, gsz = (nM - fm) < 8 ? (nM - fm) : 8;
  pm = fm + ((wgid % nig) % gsz); pn = (wgid % nig) / gsz;
}

DI void run_gemm_unit(const P& p, const Job& jb, int L, char* smem, const bool prestaged, const bool hasnext, const Job& jn, int Ln) {
  char* ws = p.ws;
  int tidx = threadIdx.x;
  asm volatile("" : "+v"(tidx));
  const int wid = __builtin_amdgcn_readfirstlane(tidx >> 6), lane = tidx & 63, wr = wid >> 2, wc = wid & 3;
  int fr = lane & 15, fq = lane >> 4;
  int pm, pn;
  g8_unit(L, jb.mtiles, jb.ntiles, pm, pn);
  const int m0 = pm * 256, ncol = pn * 256, n0 = ncol + jb.nofs;
  f32x4 acc[2][2][4][2];
  const bool transposed = (jb.mode == 0 && ((n0 >= 2560 && n0 < 3072) || (n0 >= 512 && n0 < 1024))) || (jb.mode == 1 && n0 >= 1024);
  g8_tile<true>(jb.A, jb.B, jb.K, m0, ncol, (bf16_t*)smem, acc, tidx, prestaged, jb.mode == 0 && n0 >= 3072);
  const bool early = hasnext && (jb.mode == 3);
  if (early) {
    int pm2, pn2;
    g8_unit(Ln, jn.mtiles, jn.ntiles, pm2, pn2);
    g8_stage0(jn.A, jn.B, jn.K, pm2 * 256, pn2 * 256, (bf16_t*)smem, tidx);
  }
  asm volatile("" : "+v"(fr), "+v"(fq));
  const bool gates = (jb.mode == 0 && n0 >= 3072);
  u4 outv[16];
  bf16_t* gdst = nullptr;
  long istride = 0;
  int nch = 16;
  if (gates) {
    if (wc == 0) {
      float* g = (float*)(ws + OFF_GATES);
#pragma unroll
      for (int ai = 0; ai < 2; ++ai)
#pragma unroll
        for (int m = 0; m < 4; ++m)
#pragma unroll
          for (int n = 0; n < 2; ++n) {
            int row = m0 + ai * 128 + wr * 64 + m * 16 + fr;
            *(f32x4*)(g + (long)row * 32 + n * 16 + fq * 4) = acc[ai][0][m][n];
          }
    }
    nch = 0;
  } else if (transposed) {
    bf16_t* dstT; long ldT; int nb;
    if (jb.mode == 0 && n0 < 1024) { dstT = (bf16_t*)(ws + OFF_GV); ldT = T; nb = 512; }
    else if (jb.mode == 0) { dstT = (bf16_t*)(ws + OFF_DVT); ldT = T; nb = 2560; }
    else { dstT = (bf16_t*)(ws + OFF_VXT); ldT = MT; nb = 1024; }
#pragma unroll
    for (int ai = 0; ai < 2; ++ai)
#pragma unroll
      for (int bj = 0; bj < 2; ++bj)
#pragma unroll
        for (int m = 0; m < 4; ++m)
#pragma unroll
          for (int n = 0; n < 2; ++n) {
            const int rowm = ai * 128 + wr * 64 + m * 16 + fr;
            f32x4 v = acc[ai][bj][m][n];
#pragma unroll
            for (int j = 0; j < 4; ++j) {
              const int colL = bj * 128 + wc * 32 + n * 16 + fq * 4 + j;
              *(bf16_t*)(smem + colL * 512 + (((rowm >> 3) ^ (colL & 31)) << 4) + (rowm & 7) * 2) = f2b(v[j]);
            }
          }
    __syncthreads();
#pragma unroll
    for (int i = 0; i < 16; ++i) {
      const int colL = (tidx >> 5) + 16 * i, c = tidx & 31;
      outv[i] = *(const u4*)(smem + colL * 512 + ((c ^ (colL & 31)) << 4));
    }
    gdst = dstT + (long)(n0 - nb + (tidx >> 5)) * ldT + m0 + (tidx & 31) * 8;
    istride = 16 * ldT;
  } else if (jb.mode == 3) {
#pragma unroll
    for (int ai = 0; ai < 2; ++ai)
#pragma unroll
      for (int bj = 0; bj < 2; ++bj)
#pragma unroll
        for (int m = 0; m < 4; ++m) {
          const int row = ai * 128 + wr * 64 + m * 16 + fr;
          f32x4 g = acc[ai][bj][m][0], u = acc[ai][bj][m][1];
          float o[4];
#pragma unroll
          for (int r = 0; r < 4; ++r) o[r] = g[r] * u[r] * __builtin_amdgcn_rcpf(1.f + __builtin_amdgcn_exp2f(-g[r] * LOG2E));
          u2 pk; pk.x = pk2(o[0], o[1]); pk.y = pk2(o[2], o[3]);
          const int chunk = bj * 8 + wc * 2 + (fq >> 1);
          *(u2*)(smem + row * 256 + (row >= 128 ? 65536 : 32768) + ((chunk ^ (row & 15)) << 4) + (fq & 1) * 8) = pk;
        }
    __syncthreads();
#pragma unroll
    for (int i = 0; i < 8; ++i) {
      const int row = (tidx >> 4) + 32 * i, c = tidx & 15;
      outv[i] = *(const u4*)(smem + row * 256 + (row >= 128 ? 65536 : 32768) + ((c ^ (row & 15)) << 4));
    }
    gdst = jb.dst + (long)(m0 + (tidx >> 4)) * DFF + (n0 >> 1) + (tidx & 15) * 8;
    istride = 32L * DFF;
    nch = 8;
  } else {
    bf16_t* dst; int ld; int nb;
    if (jb.mode == 2) { dst = jb.dst; ld = 1024; nb = 0; }
    else if (jb.mode == 1) { dst = (bf16_t*)(ws + OFF_KX); ld = 1024; nb = 0; }
    else {
      if (n0 < 256) { dst = (bf16_t*)(ws + OFF_GQ); ld = 256; nb = 0; }
      else if (n0 < 512) { dst = (bf16_t*)(ws + OFF_GK); ld = 256; nb = 256; }
      else if (n0 < 1536) { dst = (bf16_t*)(ws + OFF_OG); ld = 512; nb = 1024; }
      else if (n0 < 2048) { dst = (bf16_t*)(ws + OFF_DQ); ld = 512; nb = 1536; }
      else { dst = (bf16_t*)(ws + OFF_DK); ld = 512; nb = 2048; }
    }
    const bool rope = (jb.mode == 0) && (n0 >= 1536) && (n0 < 2560) && ((wc & 1) == 0);
    const float l2t = log2f(500000.f) * (1.f / 8.f);
#pragma unroll
    for (int ai = 0; ai < 2; ++ai)
#pragma unroll
      for (int bj = 0; bj < 2; ++bj)
#pragma unroll
        for (int m = 0; m < 4; ++m)
#pragma unroll
          for (int n = 0; n < 2; ++n) {
            const int row = ai * 128 + wr * 64 + m * 16 + fr;
            f32x4 v = acc[ai][bj][m][n];
            if (rope && n == 0) {
              const int grow = m0 + row;
              const int pos = grow < TP ? grow : ((grow - TP) & (SS - 1));
#pragma unroll
              for (int j = 0; j < 4; ++j) {
                auto rr = __builtin_amdgcn_permlane32_swap(__float_as_uint(v[j]), __float_as_uint(v[j]), false, false);
                const float pv = __uint_as_float(fq < 2 ? rr[1] : rr[0]);
                const int i = (fq & 1) * 4 + j;
                const float inv = exp2f(-(float)i * l2t);
                const float ang = (float)pos * inv;
                const float kk = rintf(ang * 0.15915494309189535f);
                const float frv = fmaf(ang, 0.15915494309189535f, -kk) + ang * 6.4206383e-9f;
                const float sn = __builtin_amdgcn_sinf(frv), cs = __builtin_amdgcn_cosf(frv);
                v[j] = fq < 2 ? v[j] * cs - pv * sn : v[j] * cs + pv * sn;
              }
            }
            u2 pk; pk.x = pk2(v[0], v[1]); pk.y = pk2(v[2], v[3]);
            const int chunk = bj * 16 + wc * 4 + n * 2 + (fq >> 1);
            *(u2*)(smem + row * 512 + ((chunk ^ (row & 31)) << 4) + (fq & 1) * 8) = pk;
          }
    __syncthreads();
#pragma unroll
    for (int i = 0; i < 16; ++i) {
      const int row = (tidx >> 5) + 16 * i, c = tidx & 31;
      outv[i] = *(const u4*)(smem + row * 512 + ((c ^ (row & 31)) << 4));
    }
    gdst = dst + (long)(m0 + (tidx >> 5)) * ld + (n0 - nb) + (tidx & 31) * 8;
    istride = 16L * ld;
  }
  __syncthreads();
  if (hasnext && !early) {
    int pm2, pn2;
    g8_unit(Ln, jn.mtiles, jn.ntiles, pm2, pn2);
    g8_stage0(jn.A, jn.B, jn.K, pm2 * 256, pn2 * 256, (bf16_t*)smem, tidx);
  }
#pragma unroll
  for (int i = 0; i < 16; ++i)
    if (i < nch) *(u4*)(gdst + (long)i * istride) = outv[i];
  if (!hasnext) asm volatile("s_waitcnt vmcnt(0)" ::: "memory");
}

DI void run_gemm_job(const P& p, const Job& jb, char* smem) {
  const int nu = jb.mtiles * jb.ntiles;
  const int G = gridDim.x;
  bool pre = false;
  for (int L = blockIdx.x; L < nu; L += G) {
    const bool hn = L + G < nu;
    run_gemm_unit(p, jb, L, smem, pre, hn, jb, L + G);
    pre = hn;
  }
}

constexpr int VROW = 136;

template <int DQK, bool PF>
DI void flash_item(const bf16_t* __restrict__ Q, int ldq, const bf16_t* __restrict__ Kp, int ldk,
                   const bf16_t* __restrict__ Vt, long ldvt, int nkeys, float c, bf16_t* __restrict__ O, int ldo,
                   char* smem) {
  constexpr int KROW = (DQK + 8) * 2;
  constexpr int KCH = 64 * DQK * 2 / 16 / 256;
  constexpr int CPR = DQK / 8;
  char* Ks = smem;
  char* Vs = smem + 64 * KROW;
  const int tid = VT, lane = tid & 63, w = tid >> 6, r = lane & 31, h = lane >> 5;
  bf16x8 qf[DQK / 16];
  {
    const bf16_t* qrow = Q + (long)(w * 32 + r) * ldq + 8 * h;
#pragma unroll
    for (int ks = 0; ks < DQK / 16; ++ks) qf[ks] = *(const bf16x8*)(qrow + 16 * ks);
  }
  f32x16 o[4];
#pragma unroll
  for (int i = 0; i < 4; ++i)
#pragma unroll
    for (int j = 0; j < 16; ++j) o[i][j] = 0.f;
  float m_run = -1e30f, l_run = 0.f;
  u4 kreg[KCH], vreg[4];
#define FL_GLOAD(kt_) \
  _Pragma("unroll") for (int i = 0; i < KCH; ++i) { \
    int cc = tid + 256 * i, row = cc / CPR, kc = cc % CPR; \
    kreg[i] = *(const u4*)(Kp + (long)((kt_) * 64 + row) * ldk + kc * 8); \
  } \
  _Pragma("unroll") for (int i = 0; i < 4; ++i) { \
    int cc = tid + 256 * i, row = cc >> 3, kc = cc & 7; \
    vreg[i] = *(const u4*)(Vt + (long)row * ldvt + (kt_) * 64 + kc * 8); \
  }
#define FL_LSTORE() \
  _Pragma("unroll") for (int i = 0; i < KCH; ++i) { \
    int cc = tid + 256 * i, row = cc / CPR, kc = cc % CPR; \
    *(u4*)(Ks + row * KROW + kc * 16) = kreg[i]; \
  } \
  _Pragma("unroll") for (int i = 0; i < 4; ++i) { \
    int cc = tid + 256 * i, row = cc >> 3, kc = cc & 7; \
    *(u2*)(Vs + row * VROW + kc * 16) = u2{vreg[i].x, vreg[i].y}; \
    *(u2*)(Vs + row * VROW + kc * 16 + 8) = u2{vreg[i].z, vreg[i].w}; \
  }
  const int nt = nkeys >> 6;
  if (PF) { FL_GLOAD(0) }
  for (int kt = 0; kt < nt; ++kt) {
    __syncthreads();
    if (PF) {
      FL_LSTORE()
    } else {
#pragma unroll
      for (int g = 0; g < KCH / 4; ++g) {
        u4 tmp[4];
#pragma unroll
        for (int i = 0; i < 4; ++i) {
          int cc = tid + 256 * (g * 4 + i), row = cc / CPR, kc = cc % CPR;
          tmp[i] = *(const u4*)(Kp + (long)(kt * 64 + row) * ldk + kc * 8);
        }
#pragma unroll
        for (int i = 0; i < 4; ++i) {
          int cc = tid + 256 * (g * 4 + i), row = cc / CPR, kc = cc % CPR;
          *(u4*)(Ks + row * KROW + kc * 16) = tmp[i];
        }
        __builtin_amdgcn_sched_barrier(0);
      }
      {
        u4 tmp[4];
#pragma unroll
        for (int i = 0; i < 4; ++i) {
          int cc = tid + 256 * i, row = cc >> 3, kc = cc & 7;
          tmp[i] = *(const u4*)(Vt + (long)row * ldvt + kt * 64 + kc * 8);
        }
#pragma unroll
        for (int i = 0; i < 4; ++i) {
          int cc = tid + 256 * i, row = cc >> 3, kc = cc & 7;
          *(u2*)(Vs + row * VROW + kc * 16) = u2{tmp[i].x, tmp[i].y};
          *(u2*)(Vs + row * VROW + kc * 16 + 8) = u2{tmp[i].z, tmp[i].w};
        }
      }
    }
    __syncthreads();
    if (PF && kt + 1 < nt) { FL_GLOAD(kt + 1) }
    f32x16 s[2];
#pragma unroll
    for (int kb = 0; kb < 2; ++kb)
#pragma unroll
      for (int j = 0; j < 16; ++j) s[kb][j] = 0.f;
#pragma unroll
    for (int kg = 0; kg < DQK / 64; ++kg) {
      bf16x8 kf[4][2];
#pragma unroll
      for (int k4 = 0; k4 < 4; ++k4)
#pragma unroll
        for (int kb = 0; kb < 2; ++kb)
          kf[k4][kb] = *(const bf16x8*)(Ks + (32 * kb + r) * KROW + (16 * (kg * 4 + k4) + 8 * h) * 2);
#pragma unroll
      for (int k4 = 0; k4 < 4; ++k4)
#pragma unroll
        for (int kb = 0; kb < 2; ++kb)
          s[kb] = __builtin_amdgcn_mfma_f32_32x32x16_bf16(kf[k4][kb], qf[kg * 4 + k4], s[kb], 0, 0, 0);
      __builtin_amdgcn_sched_group_barrier(0x100, 8, 0);
      __builtin_amdgcn_sched_group_barrier(0x008, 8, 0);
      __builtin_amdgcn_sched_barrier(0);
    }
    bf16x8 vf0[2][4];
#pragma unroll
    for (int st = 0; st < 2; ++st)
#pragma unroll
      for (int dvb = 0; dvb < 4; ++dvb) {
        const char* vp = Vs + (32 * dvb + r) * VROW + (16 * st + 4 * h) * 2;
        bf16x4 lo = *(const bf16x4*)vp;
        bf16x4 hi = *(const bf16x4*)(vp + 16);
        vf0[st][dvb] = __builtin_shufflevector(lo, hi, 0, 1, 2, 3, 4, 5, 6, 7);
      }
    __builtin_amdgcn_sched_barrier(0);
    float mx = s[0][0];
#pragma unroll
    for (int kb = 0; kb < 2; ++kb)
#pragma unroll
      for (int j = 0; j < 16; ++j) mx = fmaxf(mx, s[kb][j]);
    mx = half_swap_max(mx);
    const float m_new = fmaxf(m_run, mx * c);
    if (__builtin_amdgcn_ballot_w64(m_new > m_run) != 0ull) {
      const float alpha = __builtin_amdgcn_exp2f(m_run - m_new);
      m_run = m_new;
      l_run *= alpha;
#pragma unroll
      for (int i = 0; i < 4; ++i)
#pragma unroll
        for (int j = 0; j < 16; ++j) o[i][j] *= alpha;
    }
    float ps = 0.f;
#pragma unroll
    for (int kb = 0; kb < 2; ++kb)
#pragma unroll
      for (int j = 0; j < 16; ++j) {
        float pv = __builtin_amdgcn_exp2f(s[kb][j] * c - m_run);
        s[kb][j] = pv;
        ps += pv;
      }
    l_run += ps;
    bf16x8 pf[2][2];
#pragma unroll
    for (int kb = 0; kb < 2; ++kb)
#pragma unroll
      for (int st = 0; st < 2; ++st) {
        u4 pu;
        pu.x = pk2(s[kb][8 * st + 0], s[kb][8 * st + 1]);
        pu.y = pk2(s[kb][8 * st + 2], s[kb][8 * st + 3]);
        pu.z = pk2(s[kb][8 * st + 4], s[kb][8 * st + 5]);
        pu.w = pk2(s[kb][8 * st + 6], s[kb][8 * st + 7]);
        pf[kb][st] = __builtin_bit_cast(bf16x8, pu);
      }
    __builtin_amdgcn_sched_barrier(0);
    bf16x8 vf1[2][4];
#pragma unroll
    for (int st = 0; st < 2; ++st)
#pragma unroll
      for (int dvb = 0; dvb < 4; ++dvb) {
        const char* vp = Vs + (32 * dvb + r) * VROW + (32 + 16 * st + 4 * h) * 2;
        bf16x4 lo = *(const bf16x4*)vp;
        bf16x4 hi = *(const bf16x4*)(vp + 16);
        vf1[st][dvb] = __builtin_shufflevector(lo, hi, 0, 1, 2, 3, 4, 5, 6, 7);
      }
#pragma unroll
    for (int st = 0; st < 2; ++st)
#pragma unroll
      for (int dvb = 0; dvb < 4; ++dvb) o[dvb] = __builtin_amdgcn_mfma_f32_32x32x16_bf16(vf0[st][dvb], pf[0][st], o[dvb], 0, 0, 0);
    __builtin_amdgcn_sched_group_barrier(0x100, 16, 0);
    __builtin_amdgcn_sched_group_barrier(0x008, 8, 0);
    __builtin_amdgcn_sched_barrier(0);
#pragma unroll
    for (int st = 0; st < 2; ++st)
#pragma unroll
      for (int dvb = 0; dvb < 4; ++dvb) o[dvb] = __builtin_amdgcn_mfma_f32_32x32x16_bf16(vf1[st][dvb], pf[1][st], o[dvb], 0, 0, 0);
  }
  float l = half_swap_sum(l_run);
  float inv = 1.f / l;
  bf16_t* orow = O + (long)(w * 32 + r) * ldo;
#pragma unroll
  for (int dvb = 0; dvb < 4; ++dvb)
#pragma unroll
    for (int g = 0; g < 4; g += 2) {
      unsigned p0 = pk2(o[dvb][4 * g + 0] * inv, o[dvb][4 * g + 1] * inv), p1 = pk2(o[dvb][4 * g + 2] * inv, o[dvb][4 * g + 3] * inv);
      unsigned q0 = pk2(o[dvb][4 * g + 4] * inv, o[dvb][4 * g + 5] * inv), q1 = pk2(o[dvb][4 * g + 6] * inv, o[dvb][4 * g + 7] * inv);
      auto s0 = __builtin_amdgcn_permlane32_swap(p0, q0, false, false);
      auto s1 = __builtin_amdgcn_permlane32_swap(p1, q1, false, false);
      *(u4*)(orow + 32 * dvb + 8 * (g + h)) = u4{s0[0], s1[0], s0[1], s1[1]};
    }
  __syncthreads();
}

template <int DQK>
DI void flash256x_core(const bf16x8 (&qf)[DQK / 16], const bf16_t* __restrict__ Kp, int ldk,
                      const bf16_t* __restrict__ Vt, long ldvt, int nkeys, float c, bf16_t* __restrict__ O, int ldo,
                      char* smem) {
  constexpr int KROW = (DQK + 8) * 2;
  constexpr int BUFB = 64 * KROW + 128 * VROW;
  constexpr int KCH = DQK / 64;
  constexpr int CPR = DQK / 8;
  int tid = threadIdx.x;
  asm volatile("" : "+v"(tid));
  const int lane = tid & 63, w = tid >> 6, r = lane & 31, h = lane >> 5;
  f32x16 o[4];
#pragma unroll
  for (int i = 0; i < 4; ++i)
#pragma unroll
    for (int j = 0; j < 16; ++j) o[i][j] = 0.f;
  float m_run = -1e30f, l_run = 0.f;
  const bf16_t* vg0 = Vt + (long)(tid >> 3) * ldvt + (tid & 7) * 8;
  const bf16_t* vg1 = Vt + (long)(64 + (tid >> 3)) * ldvt + (tid & 7) * 8;
  const int vso0 = 64 * KROW + (tid >> 3) * VROW + (tid & 7) * 16;
  const int vso1 = vso0 + 64 * VROW;
  u4 kr[KCH], vr0, vr1;
#define F2_GLOAD(kt_) { _Pragma("unroll") for (int i_ = 0; i_ < KCH; ++i_) { int cc_ = tid + 512 * i_; \
      kr[i_] = *(const u4*)(Kp + (long)((kt_) * 64 + cc_ / CPR) * ldk + (cc_ % CPR) * 8); } \
    vr0 = *(const u4*)(vg0 + (kt_) * 64); vr1 = *(const u4*)(vg1 + (kt_) * 64); }
#define F2_LSTORE(buf_) { char* bb = smem + (buf_) * BUFB; \
    _Pragma("unroll") for (int i_ = 0; i_ < KCH; ++i_) { int cc_ = tid + 512 * i_; *(u4*)(bb + (cc_ / CPR) * KROW + (cc_ % CPR) * 16) = kr[i_]; } \
    *(u2*)(bb + vso0) = u2{vr0.x, vr0.y}; *(u2*)(bb + vso0 + 8) = u2{vr0.z, vr0.w}; \
    *(u2*)(bb + vso1) = u2{vr1.x, vr1.y}; *(u2*)(bb + vso1 + 8) = u2{vr1.z, vr1.w}; }
  const int nt = nkeys >> 6;
  F2_GLOAD(0)
  __syncthreads();
  F2_LSTORE(0)
  if (nt > 1) F2_GLOAD(1)
  __syncthreads();
  for (int kt = 0; kt < nt; ++kt) {
    const char* Ks = smem + (kt & 1) * BUFB;
    const char* Vs = Ks + 64 * KROW;
    f32x16 s[2];
#pragma unroll
    for (int kb = 0; kb < 2; ++kb)
#pragma unroll
      for (int j = 0; j < 16; ++j) s[kb][j] = 0.f;
    constexpr int KG = (DQK == 64) ? 4 : 2;
    __builtin_amdgcn_s_setprio(1);
#pragma unroll
    for (int kg = 0; kg < DQK / 16 / KG; ++kg) {
      bf16x8 kf[KG][2];
#pragma unroll
      for (int k4 = 0; k4 < KG; ++k4)
#pragma unroll
        for (int kb = 0; kb < 2; ++kb) kf[k4][kb] = *(const bf16x8*)(Ks + (32 * kb + r) * KROW + (16 * (kg * KG + k4) + 8 * h) * 2);
#pragma unroll
      for (int k4 = 0; k4 < KG; ++k4)
#pragma unroll
        for (int kb = 0; kb < 2; ++kb) s[kb] = __builtin_amdgcn_mfma_f32_32x32x16_bf16(kf[k4][kb], qf[kg * KG + k4], s[kb], 0, 0, 0);
      __builtin_amdgcn_sched_group_barrier(0x100, 2 * KG, 0);
      __builtin_amdgcn_sched_group_barrier(0x008, 2 * KG, 0);
      __builtin_amdgcn_sched_barrier(0);
    }
    __builtin_amdgcn_s_setprio(0);
    bf16x8 vf0[2][4];
    if constexpr (DQK == 64) {
#pragma unroll
      for (int st = 0; st < 2; ++st)
#pragma unroll
        for (int dvb = 0; dvb < 4; ++dvb) {
          const char* vp = Vs + (32 * dvb + r) * VROW + (16 * st + 4 * h) * 2;
          bf16x4 lo = *(const bf16x4*)vp;
          bf16x4 hi = *(const bf16x4*)(vp + 16);
          vf0[st][dvb] = __builtin_shufflevector(lo, hi, 0, 1, 2, 3, 4, 5, 6, 7);
        }
      __builtin_amdgcn_sched_barrier(0);
    }
    float mx = s[0][0];
#pragma unroll
    for (int kb = 0; kb < 2; ++kb)
#pragma unroll
      for (int j = 0; j < 16; ++j) mx = fmaxf(mx, s[kb][j]);
    mx = half_swap_max(mx);
    const float mxs = mx * c;
    if (__builtin_amdgcn_ballot_w64(mxs > m_run + 8.f) != 0ull) {
      const float m_new = fmaxf(m_run, mxs);
      const float alpha = __builtin_amdgcn_exp2f(m_run - m_new);
      m_run = m_new;
      l_run *= alpha;
#pragma unroll
      for (int i = 0; i < 4; ++i)
#pragma unroll
        for (int j = 0; j < 16; ++j) o[i][j] *= alpha;
    }
    float ps = 0.f;
#pragma unroll
    for (int kb = 0; kb < 2; ++kb)
#pragma unroll
      for (int j = 0; j < 16; ++j) {
        float pv = __builtin_amdgcn_exp2f(s[kb][j] * c - m_run);
        s[kb][j] = pv;
        ps += pv;
      }
    l_run += ps;
    bf16x8 pf[2][2];
#pragma unroll
    for (int kb = 0; kb < 2; ++kb)
#pragma unroll
      for (int st = 0; st < 2; ++st) {
        u4 pu;
        pu.x = pk2(s[kb][8 * st + 0], s[kb][8 * st + 1]);
        pu.y = pk2(s[kb][8 * st + 2], s[kb][8 * st + 3]);
        pu.z = pk2(s[kb][8 * st + 4], s[kb][8 * st + 5]);
        pu.w = pk2(s[kb][8 * st + 6], s[kb][8 * st + 7]);
        pf[kb][st] = __builtin_bit_cast(bf16x8, pu);
      }
    __builtin_amdgcn_sched_barrier(0);
    if (kt + 1 < nt) {
      F2_LSTORE((kt + 1) & 1)
      if (kt + 2 < nt) F2_GLOAD(kt + 2)
    }
    __builtin_amdgcn_sched_barrier(0);
    __builtin_amdgcn_s_setprio(1);
    if constexpr (DQK == 64) {
      bf16x8 vf1[2][4];
#pragma unroll
      for (int st = 0; st < 2; ++st)
#pragma unroll
        for (int dvb = 0; dvb < 4; ++dvb) {
          const char* vp = Vs + (32 * dvb + r) * VROW + (32 + 16 * st + 4 * h) * 2;
          bf16x4 lo = *(const bf16x4*)vp;
          bf16x4 hi = *(const bf16x4*)(vp + 16);
          vf1[st][dvb] = __builtin_shufflevector(lo, hi, 0, 1, 2, 3, 4, 5, 6, 7);
        }
#pragma unroll
      for (int st = 0; st < 2; ++st)
#pragma unroll
        for (int dvb = 0; dvb < 4; ++dvb) o[dvb] = __builtin_amdgcn_mfma_f32_32x32x16_bf16(vf0[st][dvb], pf[0][st], o[dvb], 0, 0, 0);
      __builtin_amdgcn_sched_group_barrier(0x100, 16, 0);
      __builtin_amdgcn_sched_group_barrier(0x008, 8, 0);
      __builtin_amdgcn_sched_barrier(0);
#pragma unroll
      for (int st = 0; st < 2; ++st)
#pragma unroll
        for (int dvb = 0; dvb < 4; ++dvb) o[dvb] = __builtin_amdgcn_mfma_f32_32x32x16_bf16(vf1[st][dvb], pf[1][st], o[dvb], 0, 0, 0);
    } else {
#pragma unroll
      for (int kb = 0; kb < 2; ++kb)
#pragma unroll
        for (int st = 0; st < 2; ++st) {
          bf16x8 vf[4];
#pragma unroll
          for (int dvb = 0; dvb < 4; ++dvb) {
            const char* vp = Vs + (32 * dvb + r) * VROW + (32 * kb + 16 * st + 4 * h) * 2;
            bf16x4 lo = *(const bf16x4*)vp;
            bf16x4 hi = *(const bf16x4*)(vp + 16);
            vf[dvb] = __builtin_shufflevector(lo, hi, 0, 1, 2, 3, 4, 5, 6, 7);
          }
#pragma unroll
          for (int dvb = 0; dvb < 4; ++dvb) o[dvb] = __builtin_amdgcn_mfma_f32_32x32x16_bf16(vf[dvb], pf[kb][st], o[dvb], 0, 0, 0);
          __builtin_amdgcn_sched_group_barrier(0x100, 8, 0);
          __builtin_amdgcn_sched_group_barrier(0x008, 4, 0);
          __builtin_amdgcn_sched_barrier(0);
        }
    }
    __builtin_amdgcn_s_setprio(0);
    __syncthreads();
  }
  float l = half_swap_sum(l_run);
  float inv = 1.f / l;
  bf16_t* orow = O + (long)(w * 32 + r) * ldo;
#pragma unroll
  for (int dvb = 0; dvb < 4; ++dvb)
#pragma unroll
    for (int g = 0; g < 4; g += 2) {
      unsigned p0 = pk2(o[dvb][4 * g + 0] * inv, o[dvb][4 * g + 1] * inv), p1 = pk2(o[dvb][4 * g + 2] * inv, o[dvb][4 * g + 3] * inv);
      unsigned q0 = pk2(o[dvb][4 * g + 4] * inv, o[dvb][4 * g + 5] * inv), q1 = pk2(o[dvb][4 * g + 6] * inv, o[dvb][4 * g + 7] * inv);
      auto s0 = __builtin_amdgcn_permlane32_swap(p0, q0, false, false);
      auto s1 = __builtin_amdgcn_permlane32_swap(p1, q1, false, false);
      *(u4*)(orow + 32 * dvb + 8 * (g + h)) = u4{s0[0], s1[0], s0[1], s1[1]};
    }
#undef F2_GLOAD
#undef F2_LSTORE
}

template <int DQK>
DI void flash256_item(const bf16_t* __restrict__ Q, int ldq, const bf16_t* __restrict__ Kp, int ldk,
                      const bf16_t* __restrict__ Vt, long ldvt, int nkeys, float c, bf16_t* __restrict__ O, int ldo,
                      char* smem) {
  constexpr int KROW = (DQK + 8) * 2;
  constexpr int BUFB = 64 * KROW + 128 * VROW;
  constexpr int NBUF = (DQK == 64) ? 3 : 2;
  constexpr int KCH = DQK / 64;
  constexpr int CPR = DQK / 8;
  constexpr int KG = (DQK == 64) ? 4 : 2;
  const int tid = threadIdx.x, lane = tid & 63, w = __builtin_amdgcn_readfirstlane(tid >> 6), r = lane & 31, h = lane >> 5;
  const bool skew = (DQK == 64) && (w >= 4);
  bf16x8 qf[DQK / 16];
  {
    const bf16_t* qrow = Q + (long)(w * 32 + r) * ldq + 8 * h;
#pragma unroll
    for (int ks = 0; ks < DQK / 16; ++ks) qf[ks] = *(const bf16x8*)(qrow + 16 * ks);
  }
  f32x16 o[4];
#pragma unroll
  for (int i = 0; i < 4; ++i)
#pragma unroll
    for (int j = 0; j < 16; ++j) o[i][j] = 0.f;
  float m_run = -1e30f, l_run = 0.f;
  const bf16_t* vg0 = Vt + (long)(tid >> 3) * ldvt + (tid & 7) * 8;
  const bf16_t* vg1 = Vt + (long)(64 + (tid >> 3)) * ldvt + (tid & 7) * 8;
  const int vso0 = 64 * KROW + (tid >> 3) * VROW + (tid & 7) * 16;
  const int vso1 = vso0 + 64 * VROW;
  const int nt = nkeys >> 6;
  u4 kr[KCH], vr0, vr1;
  bf16x8 pf[2][2];
  f32x16 s[2];
#define F2_GLOAD(kt_) { const int t_ = min((kt_), nt - 1); _Pragma("unroll") for (int i_ = 0; i_ < KCH; ++i_) { int cc_ = tid + 512 * i_; \
      kr[i_] = *(const u4*)(Kp + (long)(t_ * 64 + cc_ / CPR) * ldk + (cc_ % CPR) * 8); } \
    vr0 = *(const u4*)(vg0 + t_ * 64); vr1 = *(const u4*)(vg1 + t_ * 64); }
#define F2_LSTORE(buf_) { char* bb = smem + (buf_) * BUFB; \
    _Pragma("unroll") for (int i_ = 0; i_ < KCH; ++i_) { int cc_ = tid + 512 * i_; *(u4*)(bb + (cc_ / CPR) * KROW + (cc_ % CPR) * 16) = kr[i_]; } \
    *(u2*)(bb + vso0) = u2{vr0.x, vr0.y}; *(u2*)(bb + vso0 + 8) = u2{vr0.z, vr0.w}; \
    *(u2*)(bb + vso1) = u2{vr1.x, vr1.y}; *(u2*)(bb + vso1 + 8) = u2{vr1.z, vr1.w}; }
#define SEC_STAGE(kt_, nxt_) { F2_LSTORE(nxt_) F2_GLOAD((kt_) + 2) __builtin_amdgcn_sched_barrier(0); }
#define SEC_QK(cur_) { const char* Ks_ = smem + (cur_) * BUFB; \
    _Pragma("unroll") for (int kb = 0; kb < 2; ++kb) _Pragma("unroll") for (int j = 0; j < 16; ++j) s[kb][j] = 0.f; \
    __builtin_amdgcn_s_setprio(1); \
    _Pragma("unroll") for (int kg = 0; kg < DQK / 16 / KG; ++kg) { \
      bf16x8 kf[KG][2]; \
      _Pragma("unroll") for (int k4 = 0; k4 < KG; ++k4) _Pragma("unroll") for (int kb = 0; kb < 2; ++kb) \
        kf[k4][kb] = *(const bf16x8*)(Ks_ + (32 * kb + r) * KROW + (16 * (kg * KG + k4) + 8 * h) * 2); \
      _Pragma("unroll") for (int k4 = 0; k4 < KG; ++k4) _Pragma("unroll") for (int kb = 0; kb < 2; ++kb) \
        s[kb] = __builtin_amdgcn_mfma_f32_32x32x16_bf16(kf[k4][kb], qf[kg * KG + k4], s[kb], 0, 0, 0); \
      __builtin_amdgcn_sched_group_barrier(0x100, 2 * KG, 0); \
      __builtin_amdgcn_sched_group_barrier(0x008, 2 * KG, 0); \
      __builtin_amdgcn_sched_barrier(0); \
    } \
    __builtin_amdgcn_s_setprio(0); }
#define SEC_SOFTMAX() { \
    float mx = s[0][0]; \
    _Pragma("unroll") for (int kb = 0; kb < 2; ++kb) _Pragma("unroll") for (int j = 0; j < 16; ++j) mx = fmaxf(mx, s[kb][j]); \
    mx = half_swap_max(mx); \
    const float mxs = mx * c; \
    if (__builtin_amdgcn_ballot_w64(mxs > m_run + 8.f) != 0ull) { \
      const float m_new = fmaxf(m_run, mxs); \
      const float alpha = __builtin_amdgcn_exp2f(m_run - m_new); \
      m_run = m_new; l_run *= alpha; \
      _Pragma("unroll") for (int i = 0; i < 4; ++i) _Pragma("unroll") for (int j = 0; j < 16; ++j) o[i][j] *= alpha; \
    } \
    float ps = 0.f; \
    _Pragma("unroll") for (int kb = 0; kb < 2; ++kb) _Pragma("unroll") for (int j = 0; j < 16; ++j) { \
        float pv = __builtin_amdgcn_exp2f(s[kb][j] * c - m_run); s[kb][j] = pv; ps += pv; } \
    l_run += ps; \
    _Pragma("unroll") for (int kb = 0; kb < 2; ++kb) _Pragma("unroll") for (int st = 0; st < 2; ++st) { \
        u4 pu; \
        pu.x = pk2(s[kb][8 * st + 0], s[kb][8 * st + 1]); pu.y = pk2(s[kb][8 * st + 2], s[kb][8 * st + 3]); \
        pu.z = pk2(s[kb][8 * st + 4], s[kb][8 * st + 5]); pu.w = pk2(s[kb][8 * st + 6], s[kb][8 * st + 7]); \
        pf[kb][st] = __builtin_bit_cast(bf16x8, pu); } \
    __builtin_amdgcn_sched_barrier(0); }
#define SEC_PV(vb_) { const char* Vs_ = smem + (vb_) * BUFB + 64 * KROW; \
    constexpr int SB_ = (DQK == 64) ? 2 : 1;     \
    __builtin_amdgcn_s_setprio(1); \
    _Pragma("unroll") for (int kbs = 0; kbs < 4 / SB_; ++kbs) { \
      bf16x8 vf[SB_][4]; \
      _Pragma("unroll") for (int sb = 0; sb < SB_; ++sb) _Pragma("unroll") for (int dvb = 0; dvb < 4; ++dvb) { \
          const char* vp = Vs_ + (32 * dvb + r) * VROW + (16 * (kbs * SB_ + sb) + 4 * h) * 2; \
          bf16x4 lo = *(const bf16x4*)vp; bf16x4 hi = *(const bf16x4*)(vp + 16); \
          vf[sb][dvb] = __builtin_shufflevector(lo, hi, 0, 1, 2, 3, 4, 5, 6, 7); } \
      _Pragma("unroll") for (int sb = 0; sb < SB_; ++sb) _Pragma("unroll") for (int dvb = 0; dvb < 4; ++dvb) \
          o[dvb] = __builtin_amdgcn_mfma_f32_32x32x16_bf16(vf[sb][dvb], pf[(kbs * SB_ + sb) >> 1][(kbs * SB_ + sb) & 1], o[dvb], 0, 0, 0); \
      __builtin_amdgcn_sched_group_barrier(0x100, 8 * SB_, 0); \
      __builtin_amdgcn_sched_group_barrier(0x008, 4 * SB_, 0); \
      __builtin_amdgcn_sched_barrier(0); \
    } \
    __builtin_amdgcn_s_setprio(0); }
  F2_GLOAD(0)
  __syncthreads();
  F2_LSTORE(0)
  F2_GLOAD(1)
  __syncthreads();
  int cur = 0, prv = 0;
  if (!skew) {
    for (int kt = 0; kt < nt; ++kt) {
      const int nxt = cur == NBUF - 1 ? 0 : cur + 1;
      SEC_QK(cur)
      SEC_SOFTMAX()
      SEC_STAGE(kt, nxt)
      SEC_PV(cur)
      __syncthreads();
      cur = nxt;
    }
  } else {
    for (int kt = 0; kt < nt; ++kt) {
      const int nxt = cur == NBUF - 1 ? 0 : cur + 1;
      if (kt > 0) SEC_PV(prv)
      SEC_STAGE(kt, nxt)
      SEC_QK(cur)
      SEC_SOFTMAX()
      __syncthreads();
      prv = cur; cur = nxt;
    }
    SEC_PV(prv)
  }
  float l = half_swap_sum(l_run);
  float inv = 1.f / l;
  bf16_t* orow = O + (long)(w * 32 + r) * ldo;
#pragma unroll
  for (int dvb = 0; dvb < 4; ++dvb)
#pragma unroll
    for (int g = 0; g < 4; g += 2) {
      unsigned p0 = pk2(o[dvb][4 * g + 0] * inv, o[dvb][4 * g + 1] * inv), p1 = pk2(o[dvb][4 * g + 2] * inv, o[dvb][4 * g + 3] * inv);
      unsigned q0 = pk2(o[dvb][4 * g + 4] * inv, o[dvb][4 * g + 5] * inv), q1 = pk2(o[dvb][4 * g + 6] * inv, o[dvb][4 * g + 7] * inv);
      auto s0 = __builtin_amdgcn_permlane32_swap(p0, q0, false, false);
      auto s1 = __builtin_amdgcn_permlane32_swap(p1, q1, false, false);
      *(u4*)(orow + 32 * dvb + 8 * (g + h)) = u4{s0[0], s1[0], s0[1], s1[1]};
    }
#undef F2_GLOAD
#undef F2_LSTORE
#undef SEC_STAGE
#undef SEC_QK
#undef SEC_SOFTMAX
#undef SEC_PV
}

constexpr int GL_GS = 0;
constexpr int GL_TOT = 8192;
constexpr int GL_B1 = 10240;
constexpr int GL_B2 = 19456;
constexpr int GL_VT = 28672;
constexpr int GL_AS = 47104;

DI float fexp(float x) { return __builtin_amdgcn_exp2f(x * LOG2E); }
DI float log_sigmoid(float z) { return fminf(z, 0.f) - __logf(1.f + fexp(-fabsf(z))); }

DI void gla_gates(const P& p, int t0, int hh, char* smem, float (&bfv)[16], float (&bbv)[16], float& totf, float& totb) {
  const int tid = VT, d = tid & 63, tg = tid >> 6;
  float* gs = (float*)(smem + GL_GS);
  float* tots = (float*)(smem + GL_TOT);
  const float* gates = (const float*)(p.ws + OFF_GATES) + (long)t0 * 32;
  __syncthreads();
  ((f4*)gs)[tid * 2] = ((const f4*)gates)[tid * 2];
  ((f4*)gs)[tid * 2 + 1] = ((const f4*)gates)[tid * 2 + 1];
  float wf[16], wb[16];
#pragma unroll
  for (int r = 0; r < 16; ++r) {
    wf[r] = p.w_gu_f[r * 256 + hh * 64 + d];
    wb[r] = p.w_gu_b[r * 256 + hh * 64 + d];
  }
  const float biasf = p.b_g_f[hh * 64 + d], biasb = p.b_g_b[hh * 64 + d];
  __syncthreads();
#pragma unroll
  for (int j = 0; j < 16; ++j) {
    const float* gr = gs + (tg * 16 + j) * 32;
    float zf = biasf, zb = biasb;
#pragma unroll
    for (int r = 0; r < 16; ++r) { zf += gr[r] * wf[r]; zb += gr[16 + r] * wb[r]; }
    bfv[j] = log_sigmoid(zf) * (1.f / 16.f);
    bbv[j] = log_sigmoid(zb) * (1.f / 16.f);
  }
  float run = 0.f;
#pragma unroll
  for (int j = 0; j < 16; ++j) { run += bfv[j]; bfv[j] = run; }
  tots[(0 * 4 + tg) * 64 + d] = run;
  run = 0.f;
#pragma unroll
  for (int j = 15; j >= 0; --j) { run += bbv[j]; bbv[j] = run; }
  tots[(1 * 4 + tg) * 64 + d] = run;
  __syncthreads();
  float offf = 0.f, offb = 0.f;
  totf = 0.f; totb = 0.f;
#pragma unroll
  for (int g = 0; g < 4; ++g) {
    float a = tots[(0 * 4 + g) * 64 + d], b = tots[(1 * 4 + g) * 64 + d];
    totf += a; totb += b;
    if (g < tg) offf += a;
    if (g > tg) offb += b;
  }
#pragma unroll
  for (int j = 0; j < 16; ++j) { bfv[j] += offf; bbv[j] += offb; }
}

DI void gla_g1_item(const P& p, int cgi, int hh, char* smem) {
  const int tid = VT, lane = tid & 63, w = tid >> 6, d = tid & 63, tg = tid >> 6;
  const int r16 = lane & 15, q4 = lane >> 4;
  const int t0 = cgi * 64;
  float bfv[16], bbv[16], totf, totb;
  gla_gates(p, t0, hh, smem, bfv, bbv, totf, totb);
  {
    const long rowoff = (long)(t0 + tg * 16) * 256 + hh * 64 + d;
    const bf16_t* gq = (const bf16_t*)(p.ws + OFF_GQ) + rowoff;
    const bf16_t* gk = (const bf16_t*)(p.ws + OFF_GK) + rowoff;
    bf16_t* qef = (bf16_t*)((char*)p.out + OUT_QEF) + rowoff;
    bf16_t* kef = (bf16_t*)((char*)p.out + OUT_KEF) + rowoff;
    bf16_t* qeb = (bf16_t*)((char*)p.out + OUT_QEB) + rowoff;
    bf16_t* keb = (bf16_t*)((char*)p.out + OUT_KEB) + rowoff;
    float qv[16], kv[16];
#pragma unroll
    for (int j = 0; j < 16; ++j) { qv[j] = b2f(gq[(long)j * 256]) * 0.125f; kv[j] = b2f(gk[(long)j * 256]); }
    unsigned pf[8], pb[8];
#pragma unroll
    for (int j = 0; j < 16; ++j) {
      float ef = fexp(bfv[j]), eb = fexp(bbv[j]);
      qef[(long)j * 256] = f2b(qv[j] * ef);
      qeb[(long)j * 256] = f2b(qv[j] * eb);
      kef[(long)j * 256] = f2b(kv[j] * fexp(-bfv[j]));
      keb[(long)j * 256] = f2b(kv[j] * fexp(-bbv[j]));
    }
#pragma unroll
    for (int j = 0; j < 8; ++j) {
      pf[j] = pk2(kv[2 * j] * fexp(totf - bfv[2 * j]), kv[2 * j + 1] * fexp(totf - bfv[2 * j + 1]));
      pb[j] = pk2(kv[2 * j] * fexp(totb - bbv[2 * j]), kv[2 * j + 1] * fexp(totb - bbv[2 * j + 1]));
    }
    char* d1 = smem + GL_B1 + d * GROW + tg * 32;
    char* d2 = smem + GL_B2 + d * GROW + tg * 32;
    *(u4*)(d1) = u4{pf[0], pf[1], pf[2], pf[3]};
    *(u4*)(d1 + 16) = u4{pf[4], pf[5], pf[6], pf[7]};
    *(u4*)(d2) = u4{pb[0], pb[1], pb[2], pb[3]};
    *(u4*)(d2 + 16) = u4{pb[4], pb[5], pb[6], pb[7]};
  }
  if (tg == 0) {
    float* dec = (float*)(p.ws + OFF_DEC) + (long)((cgi * 4 + hh) * 2) * 64;
    dec[d] = fexp(totf);
    dec[64 + d] = fexp(totb);
  }
  const bf16_t* gvt = (const bf16_t*)(p.ws + OFF_GV) + (long)(hh * 128 + 32 * w + r16) * T + t0 + q4 * 8;
  bf16x8 af[2][2];
#pragma unroll
  for (int i = 0; i < 2; ++i)
#pragma unroll
    for (int ks = 0; ks < 2; ++ks) af[i][ks] = *(const bf16x8*)(gvt + (long)(16 * i) * T + ks * 32);
  __syncthreads();
#pragma unroll
  for (int dir = 0; dir < 2; ++dir) {
    const char* kb = smem + (dir ? GL_B2 : GL_B1);
    f32x4 acc[2][4];
#pragma unroll
    for (int i = 0; i < 2; ++i)
#pragma unroll
      for (int j = 0; j < 4; ++j) acc[i][j] = f32x4{0.f, 0.f, 0.f, 0.f};
#pragma unroll
    for (int ks = 0; ks < 2; ++ks) {
      bf16x8 bfr[4];
#pragma unroll
      for (int j = 0; j < 4; ++j) bfr[j] = *(const bf16x8*)(kb + (16 * j + r16) * GROW + (ks * 32 + q4 * 8) * 2);
#pragma unroll
      for (int i = 0; i < 2; ++i)
#pragma unroll
        for (int j = 0; j < 4; ++j) acc[i][j] = __builtin_amdgcn_mfma_f32_16x16x32_bf16(af[i][ks], bfr[j], acc[i][j], 0, 0, 0);
    }
    bf16_t* U = (bf16_t*)(p.ws + OFF_UBUF) + (long)((cgi * 4 + hh) * 2 + dir) * 8192;
#pragma unroll
    for (int i = 0; i < 2; ++i)
#pragma unroll
      for (int j = 0; j < 4; ++j)
#pragma unroll
        for (int r = 0; r < 4; ++r) {
          int v = 32 * w + 16 * i + 4 * q4 + r, dd = 16 * j + r16;
          U[v * 64 + dd] = f2b(acc[i][j][r]);
        }
  }
}

DI void gla_g3_wave(const P& p, int cgi, int hh, int slab, char* wsm) {
  const int lane = VT & 63, r16 = lane & 15, q4 = lane >> 4;
  const int t0 = cgi * 64;
  f32x4 o[8];
#pragma unroll
  for (int j = 0; j < 8; ++j) o[j] = f32x4{0.f, 0.f, 0.f, 0.f};
  const bf16_t* gvt = (const bf16_t*)(p.ws + OFF_GV) + (long)(hh * 128 + r16) * T + t0 + q4 * 8;
  const bf16_t* og = (const bf16_t*)(p.ws + OFF_OG);
#pragma unroll
  for (int dir = 0; dir < 2; ++dir) {
    const bf16_t* QE = (const bf16_t*)((const char*)p.out + (dir ? OUT_QEB : OUT_QEF)) + (long)t0 * 256 + hh * 64 + q4 * 8;
    const bf16_t* KE = (const bf16_t*)((const char*)p.out + (dir ? OUT_KEB : OUT_KEF)) + (long)t0 * 256 + hh * 64 + q4 * 8;
    const bf16_t* S = (const bf16_t*)(p.ws + OFF_UBUF) + (long)((cgi * 4 + hh) * 2 + dir) * 8192;
    bf16x8 qf[2], kf[2][4], vf[8], sf[8];
#pragma unroll
    for (int ks = 0; ks < 2; ++ks) qf[ks] = *(const bf16x8*)(QE + (long)(16 * slab + r16) * 256 + ks * 32);
#pragma unroll
    for (int ks = 0; ks < 2; ++ks)
#pragma unroll
      for (int j = 0; j < 4; ++j) kf[ks][j] = *(const bf16x8*)(KE + (long)(16 * j + r16) * 256 + ks * 32);
#pragma unroll
    for (int j = 0; j < 8; ++j) {
      vf[j] = *(const bf16x8*)(gvt + (long)(16 * j) * T);
      sf[j] = *(const bf16x8*)(S + (16 * j + r16) * 64 + q4 * 8);
    }
    __builtin_amdgcn_sched_barrier(0);
    f32x4 a[4];
#pragma unroll
    for (int j = 0; j < 4; ++j) a[j] = f32x4{0.f, 0.f, 0.f, 0.f};
#pragma unroll
    for (int ks = 0; ks < 2; ++ks)
#pragma unroll
      for (int j = 0; j < 4; ++j) a[j] = __builtin_amdgcn_mfma_f32_16x16x32_bf16(qf[ks], kf[ks][j], a[j], 0, 0, 0);
    __builtin_amdgcn_wave_barrier();
    bf16_t* As = (bf16_t*)wsm;
#pragma unroll
    for (int j = 0; j < 4; ++j)
#pragma unroll
      for (int r = 0; r < 4; ++r) {
        int il = 4 * q4 + r, i = 16 * slab + il, jj = 16 * j + r16;
        bool keep = dir ? (jj >= i) : (jj <= i);
        As[il * 72 + jj] = f2b(keep ? a[j][r] : 0.f);
      }
    __builtin_amdgcn_wave_barrier();
    asm volatile("s_waitcnt lgkmcnt(0)" ::: "memory");
    bf16x8 af[2];
#pragma unroll
    for (int ks = 0; ks < 2; ++ks) af[ks] = *(const bf16x8*)(wsm + r16 * GROW + (ks * 32 + q4 * 8) * 2);
    bf16x8 vf2[8], sf2[8];
#pragma unroll
    for (int j = 0; j < 8; ++j) {
      vf2[j] = *(const bf16x8*)(gvt + (long)(16 * j) * T + 32);
      sf2[j] = *(const bf16x8*)(S + (16 * j + r16) * 64 + 32 + q4 * 8);
    }
    __builtin_amdgcn_sched_barrier(0);
#pragma unroll
    for (int j = 0; j < 8; ++j) {
      o[j] = __builtin_amdgcn_mfma_f32_16x16x32_bf16(af[0], vf[j], o[j], 0, 0, 0);
      o[j] = __builtin_amdgcn_mfma_f32_16x16x32_bf16(qf[0], sf[j], o[j], 0, 0, 0);
    }
    __builtin_amdgcn_sched_barrier(0);
#pragma unroll
    for (int j = 0; j < 8; ++j) {
      o[j] = __builtin_amdgcn_mfma_f32_16x16x32_bf16(af[1], vf2[j], o[j], 0, 0, 0);
      o[j] = __builtin_amdgcn_mfma_f32_16x16x32_bf16(qf[1], sf2[j], o[j], 0, 0, 0);
    }
    __builtin_amdgcn_sched_barrier(0);
  }
  float gv[8][4];
#pragma unroll
  for (int j = 0; j < 8; ++j)
#pragma unroll
    for (int r = 0; r < 4; ++r) gv[j][r] = b2f(og[(long)(t0 + 16 * slab + 4 * q4 + r) * 512 + hh * 128 + 16 * j + r16]);
  __builtin_amdgcn_sched_barrier(0);
  float ss[4];
#pragma unroll
  for (int r = 0; r < 4; ++r) {
    float sq = 0.f;
#pragma unroll
    for (int j = 0; j < 8; ++j) sq += o[j][r] * o[j][r];
    sq += __shfl_xor(sq, 1); sq += __shfl_xor(sq, 2); sq += __shfl_xor(sq, 4); sq += __shfl_xor(sq, 8);
    ss[r] = rsqrtf(sq * (1.f / 128.f) + EPS);
  }
  bf16_t* mixin = (bf16_t*)(p.ws + OFF_MIXIN);
#pragma unroll
  for (int j = 0; j < 8; ++j) {
    const int v = 16 * j + r16;
    const float gw = p.gla_norm_w[v];
#pragma unroll
    for (int r = 0; r < 4; ++r) {
      const int tok = t0 + 16 * slab + 4 * q4 + r;
      float g = gv[j][r];
      float val = o[j][r] * ss[r] * gw * (g / (1.f + fexp(-g)));
      mixin[(long)tok * 1024 + hh * 128 + v] = f2b(val);
    }
  }
}

DI void gla_g3_block(const P& p, int cgi, int hh, char* smem) {
  constexpr int O_QE = 0, O_KE = 9216, O_S = 18432, DIRB = 36864, O_VT = 73728, O_AS = 92160;
  const int tid = threadIdx.x, lane = tid & 63, w = __builtin_amdgcn_readfirstlane(tid >> 6), dir = w >> 2, slab = w & 3;
  const int r16 = lane & 15, q4 = lane >> 4;
  const int t0 = cgi * 64;
  const int row8 = tid >> 3, kc = tid & 7;
  const bf16_t* outb = (const bf16_t*)p.out;
  u4 ld[10];
  {
    const long qoff = (long)(t0 + row8) * 256 + hh * 64 + kc * 8;
    ld[0] = *(const u4*)((const bf16_t*)((const char*)outb + OUT_QEF) + qoff);
    ld[1] = *(const u4*)((const bf16_t*)((const char*)outb + OUT_KEF) + qoff);
    ld[4] = *(const u4*)((const bf16_t*)((const char*)outb + OUT_QEB) + qoff);
    ld[5] = *(const u4*)((const bf16_t*)((const char*)outb + OUT_KEB) + qoff);
    const bf16_t* S0 = (const bf16_t*)(p.ws + OFF_UBUF) + (long)((cgi * 4 + hh) * 2) * 8192 + row8 * 64 + kc * 8;
    ld[2] = *(const u4*)(S0);
    ld[3] = *(const u4*)(S0 + 64 * 64);
    ld[6] = *(const u4*)(S0 + 8192);
    ld[7] = *(const u4*)(S0 + 8192 + 64 * 64);
    const bf16_t* gvt = (const bf16_t*)(p.ws + OFF_GV) + (long)(hh * 128 + row8) * T + t0 + kc * 8;
    ld[8] = *(const u4*)(gvt);
    ld[9] = *(const u4*)(gvt + (long)64 * T);
  }
  __syncthreads();
  {
    const int so = row8 * GROW + kc * 16;
    *(u4*)(smem + O_QE + so) = ld[0];
    *(u4*)(smem + O_KE + so) = ld[1];
    *(u4*)(smem + O_S + so) = ld[2];
    *(u4*)(smem + O_S + 64 * GROW + so) = ld[3];
    *(u4*)(smem + DIRB + O_QE + so) = ld[4];
    *(u4*)(smem + DIRB + O_KE + so) = ld[5];
    *(u4*)(smem + DIRB + O_S + so) = ld[6];
    *(u4*)(smem + DIRB + O_S + 64 * GROW + so) = ld[7];
    *(u4*)(smem + O_VT + so) = ld[8];
    *(u4*)(smem + O_VT + 64 * GROW + so) = ld[9];
  }
  __syncthreads();
  const char* base = smem + dir * DIRB;
  f32x4 o[8];
#pragma unroll
  for (int j = 0; j < 8; ++j) o[j] = f32x4{0.f, 0.f, 0.f, 0.f};
  bf16x8 qf[2];
#pragma unroll
  for (int ks = 0; ks < 2; ++ks) qf[ks] = *(const bf16x8*)(base + O_QE + (16 * slab + r16) * GROW + (ks * 32 + q4 * 8) * 2);
  {
    f32x4 a[4];
#pragma unroll
    for (int j = 0; j < 4; ++j) a[j] = f32x4{0.f, 0.f, 0.f, 0.f};
#pragma unroll
    for (int ks = 0; ks < 2; ++ks)
#pragma unroll
      for (int j = 0; j < 4; ++j) {
        bf16x8 kf = *(const bf16x8*)(base + O_KE + (16 * j + r16) * GROW + (ks * 32 + q4 * 8) * 2);
        a[j] = __builtin_amdgcn_mfma_f32_16x16x32_bf16(qf[ks], kf, a[j], 0, 0, 0);
      }
    bf16_t* As = (bf16_t*)(smem + O_AS + dir * 9216);
#pragma unroll
    for (int j = 0; j < 4; ++j)
#pragma unroll
      for (int r = 0; r < 4; ++r) {
        int i = 16 * slab + 4 * q4 + r, jj = 16 * j + r16;
        bool keep = dir ? (jj >= i) : (jj <= i);
        As[i * 72 + jj] = f2b(keep ? a[j][r] : 0.f);
      }
  }
  __builtin_amdgcn_wave_barrier();
  asm volatile("s_waitcnt lgkmcnt(0)" ::: "memory");
#pragma unroll
  for (int ks = 0; ks < 2; ++ks) {
    bf16x8 af = *(const bf16x8*)(smem + O_AS + dir * 9216 + (16 * slab + r16) * GROW + (ks * 32 + q4 * 8) * 2);
#pragma unroll
    for (int j = 0; j < 8; ++j) {
      bf16x8 vf = *(const bf16x8*)(smem + O_VT + (16 * j + r16) * GROW + (ks * 32 + q4 * 8) * 2);
      o[j] = __builtin_amdgcn_mfma_f32_16x16x32_bf16(af, vf, o[j], 0, 0, 0);
      bf16x8 sf = *(const bf16x8*)(base + O_S + (16 * j + r16) * GROW + (ks * 32 + q4 * 8) * 2);
      o[j] = __builtin_amdgcn_mfma_f32_16x16x32_bf16(qf[ks], sf, o[j], 0, 0, 0);
    }
  }
  __syncthreads();
  float* ob = (float*)smem;
  if (dir == 1) {
#pragma unroll
    for (int j = 0; j < 8; ++j)
#pragma unroll
      for (int r = 0; r < 4; ++r) ob[(16 * slab + 4 * q4 + r) * 132 + 16 * j + r16] = o[j][r];
  }
  float gv[8][4];
  if (dir == 0) {
    const bf16_t* og = (const bf16_t*)(p.ws + OFF_OG);
#pragma unroll
    for (int j = 0; j < 8; ++j)
#pragma unroll
      for (int r = 0; r < 4; ++r) gv[j][r] = b2f(og[(long)(t0 + 16 * slab + 4 * q4 + r) * 512 + hh * 128 + 16 * j + r16]);
  }
  __syncthreads();
  if (dir == 0) {
#pragma unroll
    for (int j = 0; j < 8; ++j)
#pragma unroll
      for (int r = 0; r < 4; ++r) o[j][r] += ob[(16 * slab + 4 * q4 + r) * 132 + 16 * j + r16];
    float ss[4];
#pragma unroll
    for (int r = 0; r < 4; ++r) {
      float sq = 0.f;
#pragma unroll
      for (int j = 0; j < 8; ++j) sq += o[j][r] * o[j][r];
      sq += __shfl_xor(sq, 1); sq += __shfl_xor(sq, 2); sq += __shfl_xor(sq, 4); sq += __shfl_xor(sq, 8);
      ss[r] = rsqrtf(sq * (1.f / 128.f) + EPS);
    }
    bf16_t* mixin = (bf16_t*)(p.ws + OFF_MIXIN);
#pragma unroll
    for (int j = 0; j < 8; ++j) {
      const int v = 16 * j + r16;
      const float gw = p.gla_norm_w[v];
#pragma unroll
      for (int r = 0; r < 4; ++r) {
        const int tok = t0 + 16 * slab + 4 * q4 + r;
        float g = gv[j][r];
        float val = o[j][r] * ss[r] * gw * (g / (1.f + fexp(-g)));
        mixin[(long)tok * 1024 + hh * 128 + v] = f2b(val);
      }
    }
  }
}

DI void gla_scan_item(const P& p, int cbase, int nch, int hh, int dir, int sub) {
  const int e = (sub * 256 + VT) * 2;
  const int d = e & 63;
  bf16_t* U = (bf16_t*)(p.ws + OFF_UBUF);
  const float* dec = (const float*)(p.ws + OFF_DEC);
  float st0 = 0.f, st1 = 0.f;
  for (int n0 = 0; n0 < nch; n0 += 32) {
    unsigned u[32]; u2 dc[32];
#pragma unroll
    for (int j = 0; j < 32; ++j) {
      int n = n0 + j;
      int cgi = cbase + (dir ? nch - 1 - n : n);
      long base = (long)((cgi * 4 + hh) * 2 + dir);
      u[j] = *(const unsigned*)(U + base * 8192 + e);
      dc[j] = *(const u2*)(dec + base * 64 + d);
    }
#pragma unroll
    for (int j = 0; j < 32; ++j) {
      int n = n0 + j;
      int cgi = cbase + (dir ? nch - 1 - n : n);
      long base = (long)((cgi * 4 + hh) * 2 + dir);
      *(unsigned*)(U + base * 8192 + e) = pk2(st0, st1);
      st0 = __uint_as_float(dc[j].x) * st0 + blo(u[j]);
      st1 = __uint_as_float(dc[j].y) * st1 + bhi(u[j]);
    }
  }
}

DI void phase_rope_g1(const P& p, char* smem) {
  _Pragma("nounroll") for (int rp = 0; rp < REPG1; ++rp)
  for (int b0 = 0; b0 < NCHUNK * 4; b0 += VN) { int it = min(b0 + VB, NCHUNK * 4 - 1); gla_g1_item(p, it >> 2, it & 3, smem); }
}

DI void phase_attn_scan(const P& p, char* smem_block, int rep) {
  const int NSCAN_P = 128, NSCAN_S = 4096, NATT_P = 512, NATT_S = 2048;
  const float c = 0.125f * LOG2E;
  if (!rep) {
    for (int it = VB; it < NSCAN_P + NSCAN_S; it += VN) {
      if (it < NSCAN_P) {
        int sub = it & 15, ch = it >> 4;
        gla_scan_item(p, 0, 256, ch >> 1, ch & 1, sub);
      } else {
        int i2 = it - NSCAN_P;
        int sub = i2 & 15, ch = i2 >> 4;
        int sq = ch >> 3;
        gla_scan_item(p, 256 + sq * 32, 32, (ch >> 1) & 3, ch & 1, sub);
      }
    }
  }
  for (int i3 = blockIdx.x; i3 < NATT_P + NATT_S; i3 += gridDim.x) {
    int vh, qb, sq, nkeys;
    if (i3 < NATT_P) { vh = i3 & 7; qb = i3 >> 3; sq = 0; nkeys = TP; }
    else { int i4 = i3 - NATT_P; vh = i4 & 7; int rest = i4 >> 3; qb = rest & 7; sq = 1 + (rest >> 3); nkeys = SS; }
    const int ts = seq_start(sq);
    const int tq = ts + qb * 256;
    const bf16_t* Q = (const bf16_t*)(p.ws + OFF_DQ) + (long)tq * 512 + vh * 64;
    const bf16_t* K = (const bf16_t*)(p.ws + OFF_DK) + (long)ts * 512 + vh * 64;
    const bf16_t* Vt = (const bf16_t*)(p.ws + OFF_DVT) + (long)((vh >> 1) * 128) * T + ts;
    bf16_t* O = (bf16_t*)(p.ws + OFF_ODIFF) + (long)tq * 1024 + vh * 128;
    flash256_item<64>(Q, 512, K, 512, Vt, (long)T, nkeys, c, O, 1024, smem_block);
  }
}

DI void phase_g3_combine(const P& p, char* smem_block) {
  _Pragma("nounroll") for (int rp = 0; rp < REPG3; ++rp)
  for (int it = blockIdx.x; it < NCHUNK * 4; it += gridDim.x) gla_g3_block(p, it >> 2, it & 3, smem_block);
  const int lane = VT & 63;
  float lam;
  {
    float a = p.lq1[lane] * p.lk1[lane], b = p.lq2[lane] * p.lk2[lane];
    a = wave_sum(a); b = wave_sum(b);
    lam = expf(a) - expf(b) + 0.2f;
  }
  const float post = 1.f - 0.2f;
  const bf16_t* od = (const bf16_t*)(p.ws + OFF_ODIFF);
  bf16_t* mixin = (bf16_t*)(p.ws + OFF_MIXIN);
  const int hh = lane >> 4, c8 = (lane & 15) * 8;
  float sw[8];
#pragma unroll
  for (int j = 0; j < 8; ++j) sw[j] = p.subln_w[c8 + j] * post;
  _Pragma("nounroll") for (int rp = 0; rp < REPCMB; ++rp)
  for (int t = VB * 4 + (VT >> 6); t < T; t += VN * 4) {
    u4 a = *(const u4*)(od + (long)t * 1024 + (hh * 2) * 128 + c8);
    u4 b = *(const u4*)(od + (long)t * 1024 + (hh * 2 + 1) * 128 + c8);
    float v[8];
    v[0] = blo(a.x) - lam * blo(b.x); v[1] = bhi(a.x) - lam * bhi(b.x);
    v[2] = blo(a.y) - lam * blo(b.y); v[3] = bhi(a.y) - lam * bhi(b.y);
    v[4] = blo(a.z) - lam * blo(b.z); v[5] = bhi(a.z) - lam * bhi(b.z);
    v[6] = blo(a.w) - lam * blo(b.w); v[7] = bhi(a.w) - lam * bhi(b.w);
    float s = 0.f;
#pragma unroll
    for (int j = 0; j < 8; ++j) s += v[j] * v[j];
    s += __shfl_xor(s, 1); s += __shfl_xor(s, 2); s += __shfl_xor(s, 4); s += __shfl_xor(s, 8);
    float rs = rsqrtf(s * (1.f / 128.f) + EPS);
    u4 pk;
    pk.x = pk2(v[0] * rs * sw[0], v[1] * rs * sw[1]);
    pk.y = pk2(v[2] * rs * sw[2], v[3] * rs * sw[3]);
    pk.z = pk2(v[4] * rs * sw[4], v[5] * rs * sw[5]);
    pk.w = pk2(v[6] * rs * sw[6], v[7] * rs * sw[7]);
    *(u4*)(mixin + (long)t * 1024 + 512 + hh * 128 + c8) = pk;
  }
}

template <int WHICH>
DI void phase_rows(const P& p) {
  const int lane = VT & 63;
  const bf16_t* mix = (const bf16_t*)(p.ws + OFF_MIX);
  bf16_t* hb = (bf16_t*)(p.ws + OFF_HBUF);
  for (int tg = VB * 4 + (VT >> 6); tg < T / NR; tg += VN * 4) {
    const int t = tg * NR;
    char* xo = (char*)(p.out + (long)t * 1024);
    char* xres = xo + NR * 2048;
    const bf16_t* m = mix + (long)t * 1024;
    bf16_t* h = hb + (long)t * 1024;
    if (WHICH == 0) {
      const float* xin = t < TP ? p.xp + (long)t * 1024 : p.xs + (long)(t - TP) * 1024;
      row_resid_xn<true, false>((const char*)xin, 4096, m, p.norm_mix_post, p.norm_x_pre, xres, 2048, h, lane);
    } else if (WHICH == 1) {
      row_resid_xn<false, false>(xres, 2048, m, p.norm_x_post, p.norm_f_pre, xres, 2048, h, lane);
    } else {
      row_resid_xn<false, true>(xres, 2048, m, p.norm_f_post, nullptr, xo, 4096, nullptr, lane);
    }
  }
}

DI void phase_xq_xattn(const P& p, char* smem) {
  char* ws = p.ws;
  const bf16_t* A = (const bf16_t*)(ws + OFF_HBUF);
  const bf16_t* B = (const bf16_t*)(ws + OFF_WXQ);
  const float c = 0.0625f * LOG2E;
  for (int L = blockIdx.x; L < (T / 256) * 4; L += gridDim.x) {
    int tidx = threadIdx.x;
    asm volatile("" : "+v"(tidx));
    const int wid = __builtin_amdgcn_readfirstlane(tidx >> 6), lane = tidx & 63, wr = wid >> 2, wc = wid & 3;
    int fr = lane & 15, fq = lane >> 4;
    int pm, pn;
    g8_unit(L, T / 256, 4, pm, pn);
    const int m0 = pm * 256;
    bf16x8 qf[16];
    {
      f32x4 acc[2][2][4][2];
      g8_tile<true>(A, B, 1024, m0, pn * 256, (bf16_t*)smem, acc, tidx, false);
      asm volatile("" : "+v"(fr), "+v"(fq));
#pragma unroll
      for (int ai = 0; ai < 2; ++ai)
#pragma unroll
        for (int bj = 0; bj < 2; ++bj)
#pragma unroll
          for (int m = 0; m < 4; ++m)
#pragma unroll
            for (int n = 0; n < 2; ++n) {
              const int row = ai * 128 + wr * 64 + m * 16 + fr;
              f32x4 v = acc[ai][bj][m][n];
              u2 pk; pk.x = pk2(v[0], v[1]); pk.y = pk2(v[2], v[3]);
              const int chunk = bj * 16 + wc * 4 + n * 2 + (fq >> 1);
              *(u2*)(smem + row * 512 + ((chunk ^ (row & 31)) << 4) + (fq & 1) * 8) = pk;
            }
    }
    __syncthreads();
    {
      const int row = wid * 32 + (lane & 31), hh = lane >> 5;
#pragma unroll
      for (int ks = 0; ks < 16; ++ks) qf[ks] = *(const bf16x8*)(smem + row * 512 + (((2 * ks + hh) ^ (row & 31)) << 4));
    }
    __syncthreads();
    const int sq = seq_of_token(m0);
    const bf16_t* K = (const bf16_t*)(ws + OFF_KX) + (long)(sq * 256) * 1024 + pn * 256;
#pragma unroll
    for (int half = 0; half < 2; ++half) {
      const bf16_t* Vt = (const bf16_t*)(ws + OFF_VXT) + (long)(pn * 256 + half * 128) * MT + sq * 256;
      bf16_t* O = (bf16_t*)(ws + OFF_XOIN) + (long)m0 * 1024 + pn * 256 + half * 128;
      flash256x_core<256>(qf, K, 1024, Vt, (long)MT, 256, c, O, 1024, smem);
    }
  }
}

constexpr int NPH = 14;

#define XB_TMO      128
#define XB_XCNT(j)  (256  + 64 * (j))
#define XB_XSUB(j)  (1280 + 64 * (j))
#define XB_XGEN(j)  (2304 + 64 * (j))
#define XB_TOP      3328
#define XB_TOPGEN   3392
#define XCD_BAR_WORDS 3456
#define XB_SPIN_CAP (1u << 18)
#define LAS __attribute__((address_space(3)))

__device__ __forceinline__ unsigned xb_ld(unsigned* p)              { return __hip_atomic_load(p, __ATOMIC_RELAXED, __HIP_MEMORY_SCOPE_AGENT); }
__device__ __forceinline__ unsigned xb_add(unsigned* p, unsigned v) { return __hip_atomic_fetch_add(p, v, __ATOMIC_RELAXED, __HIP_MEMORY_SCOPE_AGENT); }
__device__ __forceinline__ unsigned xb_xcc_id() { return (unsigned)__builtin_amdgcn_s_getreg((3 << 11) | 20) & 0xFu; }
#define XB_SPIN(cond, bar) do { unsigned _sp = 0; while (cond) { __builtin_amdgcn_s_sleep(1); \
    if ((++_sp & 255u) == 0u) { if (xb_ld(&(bar)[XB_TMO])) break; if (_sp > XB_SPIN_CAP) { atomicAdd(&(bar)[XB_TMO], 1u); break; } } } } while (0)

struct XcdBarrier {
    unsigned* bar; unsigned x;
    volatile LAS unsigned* st;
};

__device__ __forceinline__ XcdBarrier xcd_barrier_post(unsigned* bar, volatile LAS unsigned* st) {
    XcdBarrier b; b.bar = bar; b.x = xb_xcc_id(); b.st = st;
    if (threadIdx.x == 0) (void)xb_add(&bar[XB_XCNT(b.x)], 1u);
    return b;
}
__device__ __forceinline__ void xcd_barrier_complete(unsigned* bar, unsigned x, unsigned& nloc, unsigned& nx) {
    const unsigned G = gridDim.x * gridDim.y * gridDim.z;
    unsigned sum, cnt, mine, sp = 0u;
    for (;;) {
        sum = 0u; cnt = 0u; mine = 0u;
#pragma unroll
        for (unsigned j = 0; j < 16; ++j) { const unsigned c = xb_ld(&bar[XB_XCNT(j)]); sum += c; cnt += (c > 0u) ? 1u : 0u; mine = (j == x) ? c : mine; }
        if (sum == G) break;
        __builtin_amdgcn_s_sleep(1);
        if ((++sp & 255u) == 0u) { if (xb_ld(&bar[XB_TMO])) break; if (sp > XB_SPIN_CAP) { atomicAdd(&bar[XB_TMO], 1u); break; } }
    }
    nloc = mine > 0u ? mine : 1u; nx = cnt > 0u ? cnt : 1u;
}

__device__ __forceinline__ void xcd_barrier(const XcdBarrier& b) {
    asm volatile("s_waitcnt vmcnt(0)" ::: "memory");
    __syncthreads();
    if (threadIdx.x == 0) {
        unsigned* bar = b.bar;
        __builtin_amdgcn_s_waitcnt(0);
        unsigned nloc = b.st[0], nx = b.st[1];
        if (nloc == 0u) { xcd_barrier_complete(bar, b.x, nloc, nx); b.st[0] = nloc; b.st[1] = nx; }
        const unsigned old = xb_add(&bar[XB_XSUB(b.x)], 1u);
        const unsigned gen = old / nloc;
        if (old + 1u == (gen + 1u) * nloc) {
            __builtin_amdgcn_fence(__ATOMIC_RELEASE, "agent");
            asm volatile("s_waitcnt vmcnt(0)" ::: "memory");
            const unsigned og = xb_add(&bar[XB_TOP], 1u);
            const unsigned tg = og / nx;
            if (og + 1u == (tg + 1u) * nx) xb_add(&bar[XB_TOPGEN], 1u);
            else XB_SPIN(xb_ld(&bar[XB_TOPGEN]) == tg, bar);
            __builtin_amdgcn_fence(__ATOMIC_ACQUIRE, "agent");
            xb_add(&bar[XB_XGEN(b.x)], 1u);
            asm volatile("s_waitcnt vmcnt(0)" ::: "memory");
        } else {
            XB_SPIN(xb_ld(&bar[XB_XGEN(b.x)]) == gen, bar);
            __builtin_amdgcn_fence(__ATOMIC_ACQUIRE, "agent");
            asm volatile("s_waitcnt vmcnt(0)" ::: "memory");
        }
    }
    __syncthreads();
}


DI unsigned long long uni64(unsigned long long v) {
  unsigned lo = __builtin_amdgcn_readfirstlane((unsigned)v), hi = __builtin_amdgcn_readfirstlane((unsigned)(v >> 32));
  return ((unsigned long long)hi << 32) | lo;
}
#define UNI_F(field) lp.field = (const float*)(const __attribute__((address_space(1))) float*)uni64((unsigned long long)lp.field);
DI void uniformize(P& lp) {
  UNI_F(xp) UNI_F(xs) UNI_F(memp) UNI_F(mems)
  UNI_F(norm_mix_pre) UNI_F(w_in) UNI_F(w_gu_f) UNI_F(b_g_f) UNI_F(w_gu_b) UNI_F(b_g_b) UNI_F(gla_norm_w)
  UNI_F(lq1) UNI_F(lk1) UNI_F(lq2) UNI_F(lk2) UNI_F(subln_w) UNI_F(w_out) UNI_F(norm_mix_post) UNI_F(norm_x_pre) UNI_F(norm_mem)
  UNI_F(w_xq) UNI_F(w_xkv) UNI_F(w_xo) UNI_F(norm_x_post) UNI_F(norm_f_pre) UNI_F(w_fg) UNI_F(w_fu) UNI_F(w_fd) UNI_F(norm_f_post)
  lp.out = (float*)(__attribute__((address_space(1))) float*)uni64((unsigned long long)lp.out);
  lp.ws = (char*)(__attribute__((address_space(1))) char*)uni64((unsigned long long)lp.ws);
}

template <int PH>
DI void run_phase(const P& p, char* smem, int rep) {
  char* ws = p.ws;
  if constexpr (PH == 0) phase_prep(p, smem + (threadIdx.x >> 8) * 65536);
  else if constexpr (PH == 2) phase_rope_g1(p, smem + (threadIdx.x >> 8) * 65536);
  else if constexpr (PH == 3) phase_attn_scan(p, smem, rep);
  else if constexpr (PH == 4) phase_g3_combine(p, smem);
  else if constexpr (PH == 6) phase_rows<0>(p);
  else if constexpr (PH == 8) {   }
  else if constexpr (PH == 10) phase_rows<1>(p);
  else if constexpr (PH == 13) phase_rows<2>(p);
  else if constexpr (PH == 1) {
    const bf16_t* A0 = (const bf16_t*)(ws + OFF_HBUF); const bf16_t* B0 = (const bf16_t*)(ws + OFF_WIN);
    const bf16_t* A1 = (const bf16_t*)(ws + OFF_MBUF); const bf16_t* B1 = (const bf16_t*)(ws + OFF_WXKV);
    const int n0u = (T / 256) * 12, n1u = (MT / 256) * 8, n2u = T / 256;
    const int total = n0u + n1u + n2u;
    const int G = gridDim.x;
    bool pre = false;
    auto pick = [&](int L, Job& jb, int& Lu) {
      const int k = L < n0u ? 0 : (L < n0u + n1u ? 1 : 2);
      jb.A = k == 1 ? A1 : A0;
      jb.B = k == 0 ? B0 : (k == 1 ? B1 : B0 + (long)3072 * 1024);
      jb.dst = nullptr; jb.K = 1024;
      jb.mtiles = k == 1 ? MT / 256 : T / 256;
      jb.ntiles = k == 0 ? 12 : (k == 1 ? 8 : 1);
      jb.mode = k == 1 ? 1 : 0;
      jb.nofs = k == 2 ? 3072 : 0;
      Lu = k == 0 ? L : (k == 1 ? L - n0u : L - n0u - n1u);
    };
    for (int L = blockIdx.x; L < total; L += G) {
      Job jb, jn; int Lu, Lun;
      pick(L, jb, Lu);
      const int L2 = L + G;
      const bool hn = L2 < total;
      pick(hn ? L2 : L, jn, Lun);
      run_gemm_unit(p, jb, Lu, smem, pre, hn, jn, Lun);
      pre = hn;
    }
  }
  else if constexpr (PH == 5) run_gemm_job(p, Job{(const bf16_t*)(ws + OFF_MIXIN), (const bf16_t*)(ws + OFF_WOUT), (bf16_t*)(ws + OFF_MIX), 1024, T / 256, 4, 2}, smem);
  else if constexpr (PH == 7) phase_xq_xattn(p, smem);
  else if constexpr (PH == 9) run_gemm_job(p, Job{(const bf16_t*)(ws + OFF_XOIN), (const bf16_t*)(ws + OFF_WXO), (bf16_t*)(ws + OFF_MIX), 1024, T / 256, 4, 2}, smem);
  else if constexpr (PH == 11) run_gemm_job(p, Job{(const bf16_t*)(ws + OFF_HBUF), (const bf16_t*)(ws + OFF_WGU), (bf16_t*)(ws + OFF_ACT), 1024, T / 256, 22, 3}, smem);
  else if constexpr (PH == 12) run_gemm_job(p, Job{(const bf16_t*)(ws + OFF_ACT), (const bf16_t*)(ws + OFF_WDN), (bf16_t*)(ws + OFF_MIX), DFF, T / 256, 4, 2}, smem);
}

constexpr int LDS_BYTES = 131072;
__global__ void __launch_bounds__(512, 2) mega(P p, int ph_lo, int ph_hi) {
  extern __shared__ __attribute__((aligned(16))) char smem[];
  __shared__ u4 xb_words;
  if (threadIdx.x == 0) xb_words = u4{0u, 0u, 0u, 0u};
  __syncthreads();
  XcdBarrier xb = xcd_barrier_post((unsigned*)(p.ws + OFF_BAR), (volatile LAS unsigned*)&xb_words);
  if (ph_lo < 0) cg::this_grid().sync();
#define PHASE(n)                                          \
  if (PHSEL < 0 || PHSEL == n) {                          \
    if (ph_lo <= n && n < ph_hi) {                        \
      if (n > ph_lo) xcd_barrier(xb);                     \
      if (n == 1) { _Pragma("nounroll") for (int xs = 0; xs < XSYNC; ++xs) xcd_barrier(xb); } \
      const __attribute__((address_space(4))) char* kp = (const __attribute__((address_space(4))) char*)__builtin_amdgcn_kernarg_segment_ptr(); \
      asm volatile("" : "+s"(kp));                        \
      P lp;                                               \
      __builtin_memcpy(&lp, kp, sizeof(P));               \
      uniformize(lp);                                     \
      _Pragma("nounroll") for (int rep = 0; rep < (((REPMASK >> n) & 1) ? 2 : 1); ++rep) run_phase<n>(lp, smem, rep); \
    }                                                     \
  }
  PHASE(0) PHASE(1) PHASE(2) PHASE(3) PHASE(4) PHASE(5) PHASE(6) PHASE(7) PHASE(9) PHASE(10) PHASE(11) PHASE(12) PHASE(13)
}

extern "C" void kernel_launch(void* const* d_in, const int* in_sizes, int n_in, void* d_out, int out_size, void* d_ws,
                              size_t ws_size, hipStream_t stream) {
  static int grid_blocks = 0;
  if (!grid_blocks) {
    int dev = 0, cus = 0, per_cu = 0;
    hipGetDevice(&dev);
    hipDeviceGetAttribute(&cus, hipDeviceAttributeMultiprocessorCount, dev);
    hipFuncSetAttribute((const void*)mega, hipFuncAttributeMaxDynamicSharedMemorySize, LDS_BYTES);
    hipOccupancyMaxActiveBlocksPerMultiprocessor(&per_cu, mega, 512, LDS_BYTES);
    if (per_cu < 1) per_cu = 1;
    grid_blocks = cus * per_cu;
  }
  P p{};
  const float** f = (const float**)&p;
  for (int i = 0; i < 29; ++i) f[i] = (const float*)d_in[i];
  p.out = (float*)d_out;
  p.ws = (char*)d_ws;
#if MEGA
  hipMemsetAsync((char*)d_ws + OFF_BAR, 0, 16384, stream);
  int lo = 0, hi = NPH;
  void* args[] = {&p, &lo, &hi};
  hipError_t e = hipLaunchCooperativeKernel((void*)mega, dim3(grid_blocks), dim3(512), args, LDS_BYTES, stream);
  if (e != hipSuccess) fprintf(stderr, "cooperative launch failed: %s (grid %d)\n", hipGetErrorString(e), grid_blocks);
#else
  for (int ph = 0; ph < NPH; ++ph) hipLaunchKernelGGL(mega, dim3(grid_blocks), dim3(512), LDS_BYTES, stream, p, ph, ph + 1);
#endif
}
```
